# Optimizing an MI355X kernel written in HIP

```python
import jax, jax.numpy as jnp
from jax import lax
import numpy as np

D_MODEL = 1024
BATCH = 8
SEQ = 4096
DEPTH = 2

CHUNK = 64
Q_BLOCK = 2 * CHUNK
CONV_WIDTH = 3
D_CONV = D_MODEL // 2
N_HEADS = 8
HEAD_DIM = 64
D_ATTN = N_HEADS * HEAD_DIM
D_FF = 2816
N_EXPERTS = 8
TOP_K = 2
D_FF_EXPERT = 2048
N_DENSE = (DEPTH + 1) // 2
N_MOE = DEPTH // 2
EPS = 1e-6
SPLITS = np.cumsum([D_CONV, D_CONV, D_CONV, D_ATTN, D_ATTN, D_ATTN, D_MODEL]).tolist()
D_IN_PROJ = 3 * D_CONV + 3 * D_ATTN + 2 * D_MODEL

kernel_name = "hybrid_shortconv_stickbreaking_moe_block"


def rmsnorm(x, g):
    xf = x.astype(jnp.float32)
    xf = xf * lax.rsqrt(jnp.mean(xf * xf, axis=-1, keepdims=True) + EPS)
    return (xf * g.astype(jnp.float32)).astype(x.dtype)


def causal_dwconv(u, w):
    s = u.shape[1]
    up = jnp.pad(u, ((0, 0), (CONV_WIDTH - 1, 0), (0, 0)))
    return sum(w[k] * up[:, k:k + s] for k in range(CONV_WIDTH))


def stick_breaking_attention(q, k, v):
    b, s, h, dh = q.shape
    n_blk = s // Q_BLOCK
    scale = dh ** -0.5
    qb = q.reshape(b, n_blk, Q_BLOCK, h, dh).transpose(1, 0, 3, 2, 4)
    kk = k.transpose(0, 2, 1, 3)
    vv = v.transpose(0, 2, 1, 3)
    key_pos = jnp.arange(s)

    def one_block(args):
        qi, blk = args
        q_pos = blk * Q_BLOCK + jnp.arange(Q_BLOCK)
        mask = key_pos[None, :] < q_pos[:, None]
        z = jnp.einsum('bhqd,bhkd->bhqk', qi, kk).astype(jnp.float32) * scale
        log_beta = jax.nn.log_sigmoid(z)
        log_1m = jnp.where(mask, log_beta - z, 0.0)
        incl = lax.cumsum(log_1m, axis=3, reverse=True)
        excl = jnp.concatenate([incl[..., 1:], jnp.zeros_like(incl[..., :1])], axis=-1)
        a = jnp.where(mask, jnp.exp(log_beta + excl), 0.0)
        return jnp.einsum('bhqk,bhkd->bhqd', a.astype(v.dtype), vv)

    o = lax.map(one_block, (qb, jnp.arange(n_blk)))
    return o.transpose(1, 0, 3, 2, 4).reshape(b, s, h * dh)


def swiglu(h, wg, wu, wd):
    return (jax.nn.silu(h @ wg) * (h @ wu)) @ wd


def moe_swiglu(h, w_router, wg, wu, wd):
    logits = h.astype(jnp.float32) @ w_router.astype(jnp.float32)
    top_vals, top_idx = lax.top_k(logits, TOP_K)
    top_w = jax.nn.softmax(top_vals, axis=-1)
    combine = jnp.sum(jax.nn.one_hot(top_idx, N_EXPERTS, dtype=jnp.float32) * top_w[..., None], axis=-2)
    combine = combine.astype(h.dtype)
    out = jnp.zeros_like(h)
    for e in range(N_EXPERTS):
        out = out + combine[..., e:e + 1] * swiglu(h, wg[e], wu[e], wd[e])
    return out


def setup_inputs(seed: int = 0) -> dict:
    key = jax.random.key(seed)
    ks = jax.random.split(key, 17)

    def nrm(k, shape, fan_in):
        return jax.random.normal(k, shape, jnp.float32) * (fan_in ** -0.5)

    def gain(k, shape):
        return 1.0 + 0.02 * jax.random.normal(k, shape, jnp.float32)

    return {
        "x": jax.random.normal(ks[0], (BATCH, SEQ, D_MODEL), jnp.float32),
        "g_mix": gain(ks[1], (DEPTH, D_MODEL)),
        "w_in": nrm(ks[2], (DEPTH, D_MODEL, D_IN_PROJ), D_MODEL),
        "conv_w": nrm(ks[3], (DEPTH, CONV_WIDTH, D_CONV), CONV_WIDTH),
        "w_branch_conv": nrm(ks[4], (DEPTH, D_CONV, D_MODEL), D_CONV),
        "w_branch_attn": nrm(ks[5], (DEPTH, D_ATTN, D_MODEL), D_ATTN),
        "w_out": nrm(ks[6], (DEPTH, D_MODEL, D_MODEL), D_MODEL),
        "g_ffn": gain(ks[7], (DEPTH, D_MODEL)),
        "w_ffn_gate": nrm(ks[8], (N_DENSE, D_MODEL, D_FF), D_MODEL),
        "w_ffn_up": nrm(ks[9], (N_DENSE, D_MODEL, D_FF), D_MODEL),
        "w_ffn_down": nrm(ks[10], (N_DENSE, D_FF, D_MODEL), D_FF),
        "w_router": nrm(ks[11], (N_MOE, D_MODEL, N_EXPERTS), D_MODEL),
        "w_exp_gate": nrm(ks[12], (N_MOE, N_EXPERTS, D_MODEL, D_FF_EXPERT), D_MODEL),
        "w_exp_up": nrm(ks[13], (N_MOE, N_EXPERTS, D_MODEL, D_FF_EXPERT), D_MODEL),
        "w_exp_down": nrm(ks[14], (N_MOE, N_EXPERTS, D_FF_EXPERT, D_MODEL), D_FF_EXPERT),
        "g_final": gain(ks[15], (D_MODEL,)),
    }


def reference(x, g_mix, w_in, conv_w, w_branch_conv, w_branch_attn, w_out, g_ffn,
              w_ffn_gate, w_ffn_up, w_ffn_down, w_router, w_exp_gate, w_exp_up,
              w_exp_down, g_final):
    b, s, _ = x.shape
    for i in range(DEPTH):
        h = rmsnorm(x, g_mix[i])
        proj = h @ w_in[i]
        xin, bg, cg, q, k, v, ga, gb = jnp.split(proj, SPLITS, axis=-1)
        ua = bg * causal_dwconv(cg * xin, conv_w[i])
        ub = stick_breaking_attention(q.reshape(b, s, N_HEADS, HEAD_DIM),
                                      k.reshape(b, s, N_HEADS, HEAD_DIM),
                                      v.reshape(b, s, N_HEADS, HEAD_DIM))
        mix = jax.nn.sigmoid(ga) * (ua @ w_branch_conv[i]) + jax.nn.sigmoid(gb) * (ub @ w_branch_attn[i])
        x = x + mix @ w_out[i]
        h = rmsnorm(x, g_ffn[i])
        j = i // 2
        if i % 2 == 0:
            x = x + swiglu(h, w_ffn_gate[j], w_ffn_up[j], w_ffn_down[j])
        else:
            x = x + moe_swiglu(h, w_router[j], w_exp_gate[j], w_exp_up[j], w_exp_down[j])
    return rmsnorm(x, g_final)
```

```cpp
#include <hip/hip_runtime.h>
#include <cstdio>
#include <cstdint>
#include <cmath>
namespace pg8 {
#define PG8_LAS __attribute__((address_space(3)))
typedef unsigned short bf16_t;
typedef short bf16x8 __attribute__((ext_vector_type(8)));
typedef float f32x4 __attribute__((ext_vector_type(4)));
typedef unsigned u32x4 __attribute__((ext_vector_type(4)));
constexpr int BM = 256, BK = 64, HALF = 128, HTB = HALF * BK * 2  , STAGE_BYTES = 8 * HTB, NXCD = 8, WGM = 8;

__host__ __device__ __forceinline__ int lds_byte(int r, int c) { const int st = (r >> 4) * 2 + (c >> 5), rr = r & 15, cc = c & 31, ob = rr * 64 + cc * 2; return st * 1024 + (ob ^ (((ob >> 9) & 1) << 5)); }
__host__ __device__ __forceinline__ void stage_rc(int b, int& R, int& C) { const int st = b / 1024, sb = b % 1024, swz = sb ^ (((sb >> 9) & 1) << 5); R = (st >> 1) * 16 + swz / 64; C = (st & 1) * 32 + (swz % 64) / 2; }
__host__ __device__ __forceinline__ int perm32(int rho) { const int n = rho >> 4, i = rho & 15; return 8 * (i >> 2) + 4 * n + (i & 3); }

struct Unit { int pm, pn, pb; };
struct Gemm { const bf16_t* A; const bf16_t* Bt; int M, N, K; };

struct StaticOrder {
    int nM, nN, nwg, G, c;
    __host__ __device__ void init(int M, int N, int G_, int c_) { nM = M / BM; nN = N / BM; nwg = nM * nN; G = G_; c = c_; }
    __host__ __device__ bool next(int i, Unit& u) const {
        const long L = (long)i * G + c; if (L >= nwg) return false;
        int wgid = (int)L; { const int q = nwg / NXCD, r = nwg % NXCD, xcd = wgid % NXCD, off = wgid / NXCD; wgid = (xcd < r ? xcd * (q + 1) : r * (q + 1) + (xcd - r) * q) + off; }
        const int nig = WGM * nN, gid = wgid / nig, fm = gid * WGM, gsz = (nM - fm) < WGM ? (nM - fm) : WGM;
        u.pm = fm + ((wgid % nig) % gsz); u.pn = (wgid % nig) / gsz; u.pb = u.pn; return true;
    }
    __device__ __forceinline__ void a_ready(const Unit&) const {}
    __device__ __forceinline__ void done(const Unit&) const {}
};

__device__ __forceinline__ unsigned cvt_pk_bf16(float lo, float hi) { unsigned r; asm volatile("v_cvt_pk_bf16_f32 %0, %1, %2" : "=v"(r) : "v"(lo), "v"(hi)); return r; }
typedef float f32x2 __attribute__((ext_vector_type(2)));

__device__ __forceinline__ float sigmoidf_fast(float x) { return __builtin_amdgcn_rcpf(1.0f + __builtin_amdgcn_exp2f(-1.4426950408889634f * x)); }
__device__ __forceinline__ float bf_lo(unsigned w) { return __builtin_bit_cast(float, w << 16); }
__device__ __forceinline__ float bf_hi(unsigned w) { return __builtin_bit_cast(float, w & 0xffff0000u); }
__device__ __forceinline__ void unpack8(const u32x4 w, float (&f)[8]) { f[0] = bf_lo(w.x); f[1] = bf_hi(w.x); f[2] = bf_lo(w.y); f[3] = bf_hi(w.y); f[4] = bf_lo(w.z); f[5] = bf_hi(w.z); f[6] = bf_lo(w.w); f[7] = bf_hi(w.w); }
__device__ __forceinline__ u32x4 pack8(const float (&f)[8]) { u32x4 w; w.x = cvt_pk_bf16(f[0], f[1]); w.y = cvt_pk_bf16(f[2], f[3]); w.z = cvt_pk_bf16(f[4], f[5]); w.w = cvt_pk_bf16(f[6], f[7]); return w; }

struct EpiProj {
    static constexpr bool PERM = true, AFTER_DRAIN = false;
    bf16_t* PA; bf16_t* GT; float qscale;
    __device__ __forceinline__ void operator()(const f32x4 (&acc)[2][2][4][2], const Unit& u, int wr, int wc, int fr, int fq) const {
        const int row0 = u.pm * BM + wr * 64 + fr; bf16_t* base; int ldc, colt; float sc = 1.f;
        if (u.pn < 10) { base = PA; ldc = 2560; colt = u.pn * BM; if (u.pn == 6 || u.pn == 7) sc = qscale; } else { base = GT; ldc = 2048; colt = (u.pn - 10) * BM; }
        const int col0 = colt + wc * 32 + 8 * fq;
#pragma unroll
        for (int ai = 0; ai < 2; ++ai)
#pragma unroll
            for (int m = 0; m < 4; ++m) { bf16_t* rowp = base + (size_t)(row0 + ai * HALF + m * 16) * ldc + col0;
#pragma unroll
                for (int bj = 0; bj < 2; ++bj) { const f32x4 v0 = acc[ai][bj][m][0] * sc, v1 = acc[ai][bj][m][1] * sc;
                    u32x4 w; w.x = cvt_pk_bf16(v0[0], v0[1]); w.y = cvt_pk_bf16(v0[2], v0[3]); w.z = cvt_pk_bf16(v1[0], v1[1]); w.w = cvt_pk_bf16(v1[2], v1[3]);
                    *(u32x4*)(rowp + bj * HALF) = w; } }
    }
};
struct EpiPlain {
    static constexpr bool PERM = true, AFTER_DRAIN = false;
    bf16_t* O; int ldc;
    __device__ __forceinline__ void operator()(const f32x4 (&acc)[2][2][4][2], const Unit& u, int wr, int wc, int fr, int fq) const {
        const int row0 = u.pm * BM + wr * 64 + fr, col0 = u.pn * BM + wc * 32 + 8 * fq;
#pragma unroll
        for (int ai = 0; ai < 2; ++ai)
#pragma unroll
            for (int m = 0; m < 4; ++m) { bf16_t* rowp = O + (size_t)(row0 + ai * HALF + m * 16) * ldc + col0;
#pragma unroll
                for (int bj = 0; bj < 2; ++bj) { const f32x4 v0 = acc[ai][bj][m][0], v1 = acc[ai][bj][m][1];
                    u32x4 w; w.x = cvt_pk_bf16(v0[0], v0[1]); w.y = cvt_pk_bf16(v0[2], v0[3]); w.z = cvt_pk_bf16(v1[0], v1[1]); w.w = cvt_pk_bf16(v1[2], v1[3]);
                    *(u32x4*)(rowp + bj * HALF) = w; } }
    }
};
struct EpiSwiGLU {
    static constexpr bool PERM = true, AFTER_DRAIN = false;
    bf16_t* O; int ldc;
    __device__ __forceinline__ void operator()(const f32x4 (&acc)[2][2][4][2], const Unit& u, int wr, int wc, int fr, int fq) const {
        const int row0 = u.pm * BM + wr * 64 + fr, col0 = u.pn * HALF + wc * 32 + 8 * fq;
#pragma unroll
        for (int ai = 0; ai < 2; ++ai)
#pragma unroll
            for (int m = 0; m < 4; ++m) { bf16_t* rowp = O + (size_t)(row0 + ai * HALF + m * 16) * ldc + col0;
                float o[8];
#pragma unroll
                for (int n = 0; n < 2; ++n)
#pragma unroll
                    for (int i = 0; i < 4; ++i) { const float g = acc[ai][0][m][n][i], up = acc[ai][1][m][n][i]; o[4 * n + i] = g * sigmoidf_fast(g) * up; }
                *(u32x4*)rowp = pack8(o); }
    }
};
struct EpiGateA {
    static constexpr bool PERM = true, AFTER_DRAIN = false;
    const bf16_t* GT; bf16_t* TMP;
    __device__ __forceinline__ void operator()(const f32x4 (&acc)[2][2][4][2], const Unit& u, int wr, int wc, int fr, int fq) const {
        const int row0 = u.pm * BM + wr * 64 + fr, col0 = u.pn * BM + wc * 32 + 8 * fq;
#pragma unroll
        for (int ai = 0; ai < 2; ++ai)
#pragma unroll
            for (int m = 0; m < 4; ++m) { const size_t r = (size_t)(row0 + ai * HALF + m * 16);
#pragma unroll
                for (int bj = 0; bj < 2; ++bj) { const int c = col0 + bj * HALF;
                    float g[8], o[8]; unpack8(*(const u32x4*)(GT + r * 2048 + c), g);
#pragma unroll
                    for (int n = 0; n < 2; ++n)
#pragma unroll
                        for (int i = 0; i < 4; ++i) o[4 * n + i] = sigmoidf_fast(g[4 * n + i]) * acc[ai][bj][m][n][i];
                    *(u32x4*)(TMP + r * 1024 + c) = pack8(o); } }
    }
};
struct EpiGateB {
    static constexpr bool PERM = true, AFTER_DRAIN = false;
    const bf16_t* GT; const bf16_t* TMP; bf16_t* MIX;
    __device__ __forceinline__ void operator()(const f32x4 (&acc)[2][2][4][2], const Unit& u, int wr, int wc, int fr, int fq) const {
        const int row0 = u.pm * BM + wr * 64 + fr, col0 = u.pn * BM + wc * 32 + 8 * fq;
#pragma unroll
        for (int ai = 0; ai < 2; ++ai)
#pragma unroll
            for (int m = 0; m < 4; ++m) { const size_t r = (size_t)(row0 + ai * HALF + m * 16);
#pragma unroll
                for (int bj = 0; bj < 2; ++bj) { const int c = col0 + bj * HALF;
                    float g[8], t[8], o[8]; unpack8(*(const u32x4*)(GT + r * 2048 + 1024 + c), g); unpack8(*(const u32x4*)(TMP + r * 1024 + c), t);
#pragma unroll
                    for (int n = 0; n < 2; ++n)
#pragma unroll
                        for (int i = 0; i < 4; ++i) o[4 * n + i] = t[4 * n + i] + sigmoidf_fast(g[4 * n + i]) * acc[ai][bj][m][n][i];
                    *(u32x4*)(MIX + r * 1024 + c) = pack8(o); } }
    }
};
struct EpiRes {
    static constexpr bool PERM = false, AFTER_DRAIN = false;
    const float* base; float* out; int ldc;
    __device__ __forceinline__ void operator()(const f32x4 (&acc)[2][2][4][2], const Unit& u, int wr, int wc, int fr, int fq) const {
        const int row0 = u.pm * BM + wr * 64 + fr, col0 = u.pn * BM + wc * 32 + 4 * fq;
#pragma unroll
        for (int ai = 0; ai < 2; ++ai)
#pragma unroll
            for (int m = 0; m < 4; ++m) { const size_t off = (size_t)(row0 + ai * HALF + m * 16) * ldc + col0;
#pragma unroll
                for (int bj = 0; bj < 2; ++bj)
#pragma unroll
                    for (int n = 0; n < 2; ++n) { const f32x4 b = *(const f32x4*)(base + off + bj * HALF + n * 16); *(f32x4*)(out + off + bj * HALF + n * 16) = b + acc[ai][bj][m][n]; } }
    }
};
struct MoeOrder : StaticOrder {
    const volatile PG8_LAS unsigned* offs; int ntn;
    __device__ __forceinline__ bool next(int i, Unit& u) const {
        if (!StaticOrder::next(i, u)) return false;
        const unsigned row = (unsigned)u.pm * BM; int e = 0;
#pragma unroll
        for (int k = 1; k < 8; ++k) e += (row >= offs[k]) ? 1 : 0;
        u.pb = e * ntn + u.pn; return true;
    }
};
template <class Epi, class Sched, bool ALIGN_EPI = false, bool SP2 = false>
__device__ __forceinline__ void gemm_phase(PG8_LAS unsigned char* lds, const Gemm g, const Sched& S, const Epi& E, const int tid) {
    const int wid = __builtin_amdgcn_readfirstlane(tid >> 6), lane = tid & 63, wr = wid >> 2, wc = wid & 3, fr = lane & 15, fq = lane >> 4;
    const int K = g.K, nt = K / BK;
    unsigned voffA[2], voffB[2];
#pragma unroll
    for (int i = 0; i < 2; ++i) { int R, C; stage_rc(tid * 16 + i * 8192, R, C); const int Rb = Epi::PERM ? ((R & ~31) + perm32(R & 31)) : R;
        voffA[i] = (unsigned)(R * K + C) * 2u; voffB[i] = (unsigned)(Rb * K + C) * 2u; }
    const size_t kstep = (size_t)(BK * 2);
    const size_t hstep = (size_t)HALF * K * 2;
    const size_t tstep = 2 * hstep;
    const unsigned ldsw = (unsigned)wid * 1024u;
    const int aoff = lds_byte(wr * 64 + fr, fq * 8), boff = lds_byte(wc * 32 + fr, fq * 8);
#define PG8_SA(b, h) (((b) * 2 + (h)) * HTB)
#define PG8_SB(b, h) ((4 + (b) * 2 + (h)) * HTB)
#define PG8_STAGE(bufoff, gbase, voff) do { _Pragma("unroll") for (int _i = 0; _i < 2; ++_i) \
        __builtin_amdgcn_global_load_lds((const unsigned*)((const char*)(gbase) + (voff)[_i]), (PG8_LAS unsigned*)(lds + (bufoff) + ldsw + _i * 8192), 16, 0, 0); } while (0)
#define PG8_LDA(dst, b, h) do { _Pragma("unroll") for (int m = 0; m < 4; ++m) _Pragma("unroll") for (int k = 0; k < 2; ++k) dst[m][k] = *(const PG8_LAS bf16x8*)(lds + PG8_SA(b, h) + aoff + m * 2048 + k * 1024); } while (0)
#define PG8_LDB(dst, b, h) do { _Pragma("unroll") for (int n = 0; n < 2; ++n) _Pragma("unroll") for (int k = 0; k < 2; ++k) dst[n][k] = *(const PG8_LAS bf16x8*)(lds + PG8_SB(b, h) + boff + n * 2048 + k * 1024); } while (0)
#define PG8_MMA(ai, bj, At, Bt) do { __builtin_amdgcn_s_setprio(1); _Pragma("unroll") for (int m = 0; m < 4; ++m) _Pragma("unroll") for (int n = 0; n < 2; ++n) _Pragma("unroll") for (int k = 0; k < 2; ++k) \
        acc[ai][bj][m][n] = __builtin_amdgcn_mfma_f32_16x16x32_bf16(Bt[n][k], At[m][k], acc[ai][bj][m][n], 0, 0, 0); __builtin_amdgcn_s_setprio(0); } while (0)
#define PG8_WAIT_V(n) asm volatile("s_waitcnt vmcnt(" #n ")" ::: "memory")
#define PG8_WAIT_L(n) asm volatile("s_waitcnt lgkmcnt(" #n ")" ::: "memory")
#define PG8_BAR __builtin_amdgcn_s_barrier()
#define PG8_SCHED __builtin_amdgcn_sched_barrier(0)
    Unit cur, nxt; int ui = 0;
    if (!S.next(0, cur)) return;
    f32x4 acc[2][2][4][2];
#pragma unroll
    for (int a = 0; a < 2; ++a)
#pragma unroll
        for (int b = 0; b < 2; ++b)
#pragma unroll
            for (int m = 0; m < 4; ++m)
#pragma unroll
                for (int n = 0; n < 2; ++n) acc[a][b][m][n] = (f32x4){0.f, 0.f, 0.f, 0.f};
    bf16x8 At[4][2], B0[2][2], B1[2][2];
    const char* cA = (const char*)g.A + (size_t)cur.pm * tstep; const char* cB = (const char*)g.Bt + (size_t)cur.pb * tstep;
    S.a_ready(cur);
    if constexpr (SP2) {
        PG8_STAGE(PG8_SB(0, 0), cB, voffB); PG8_STAGE(PG8_SB(0, 1), cB + hstep, voffB); PG8_STAGE(PG8_SA(0, 0), cA, voffA); PG8_STAGE(PG8_SA(0, 1), cA + hstep, voffA);
        if (wr == 1) PG8_BAR;
        PG8_WAIT_V(2); PG8_BAR;
        PG8_STAGE(PG8_SB(1, 0), cB + kstep, voffB); PG8_STAGE(PG8_SA(1, 0), cA + kstep, voffA); PG8_STAGE(PG8_SB(1, 1), cB + hstep + kstep, voffB);
        PG8_WAIT_V(6); PG8_BAR;
    } else {
        PG8_STAGE(PG8_SB(0, 0), cB, voffB); PG8_STAGE(PG8_SA(0, 0), cA, voffA); PG8_STAGE(PG8_SB(0, 1), cB + hstep, voffB); PG8_STAGE(PG8_SA(0, 1), cA + hstep, voffA);
        if (wr == 1) PG8_BAR;
        PG8_WAIT_V(4); PG8_BAR;
        PG8_STAGE(PG8_SB(1, 0), cB + kstep, voffB); PG8_STAGE(PG8_SA(1, 0), cA + kstep, voffA); PG8_STAGE(PG8_SB(1, 1), cB + hstep + kstep, voffB);
        PG8_WAIT_V(6); PG8_BAR;
    }
    for (;;) {
        const bool has_next = S.next(ui + 1, nxt);
        const char* nA = has_next ? (const char*)g.A + (size_t)nxt.pm * tstep : cA; const char* nB = has_next ? (const char*)g.Bt + (size_t)nxt.pb * tstep : cB;
        for (int t = 0; t < nt; t += 2) {
            const bool last = (t == nt - 2);
            const char* a1 = cA + (size_t)(t + 1) * kstep;
            const char* a2 = last ? nA : cA + (size_t)(t + 2) * kstep; const char* b2 = last ? nB : cB + (size_t)(t + 2) * kstep;
            const char* a3 = a2 + kstep; const char* b3 = b2 + kstep;
            if (last && has_next) S.a_ready(nxt);
            if constexpr (SP2) {
            PG8_LDB(B0, 0, 0); PG8_LDB(B1, 0, 1); PG8_SCHED; PG8_LDA(At, 0, 0); PG8_STAGE(PG8_SA(1, 1), a1 + hstep, voffA);
            PG8_WAIT_V(8); PG8_WAIT_L(0); PG8_BAR; PG8_MMA(0, 0, At, B0); PG8_MMA(0, 1, At, B1); PG8_BAR; PG8_SCHED;
            PG8_LDA(At, 0, 1); PG8_STAGE(PG8_SB(0, 0), b2, voffB); PG8_STAGE(PG8_SB(0, 1), b2 + hstep, voffB); PG8_STAGE(PG8_SA(0, 0), a2, voffA);
            PG8_WAIT_V(8); PG8_WAIT_L(0); PG8_BAR; PG8_MMA(1, 0, At, B0); PG8_MMA(1, 1, At, B1); PG8_BAR; PG8_SCHED;
            PG8_LDB(B0, 1, 0); PG8_LDB(B1, 1, 1); PG8_SCHED; PG8_LDA(At, 1, 0); PG8_STAGE(PG8_SA(0, 1), a2 + hstep, voffA);
            PG8_WAIT_V(8); PG8_WAIT_L(0); PG8_BAR; PG8_MMA(0, 0, At, B0); PG8_MMA(0, 1, At, B1); PG8_BAR; PG8_SCHED;
            PG8_LDA(At, 1, 1); PG8_STAGE(PG8_SB(1, 0), b3, voffB); PG8_STAGE(PG8_SB(1, 1), b3 + hstep, voffB); PG8_STAGE(PG8_SA(1, 0), a3, voffA);
            PG8_WAIT_V(8); PG8_WAIT_L(0); PG8_BAR; PG8_MMA(1, 0, At, B0); PG8_MMA(1, 1, At, B1); PG8_BAR; PG8_SCHED;
            } else {
            PG8_LDB(B0, 0, 0); PG8_SCHED; PG8_LDA(At, 0, 0); PG8_STAGE(PG8_SA(1, 1), a1 + hstep, voffA);
            PG8_WAIT_L(8); PG8_BAR; PG8_WAIT_L(0); PG8_MMA(0, 0, At, B0); PG8_BAR; PG8_SCHED;
            PG8_LDB(B1, 0, 1); PG8_STAGE(PG8_SB(0, 0), b2, voffB);
            PG8_BAR; PG8_WAIT_L(0); PG8_MMA(0, 1, At, B1); PG8_BAR;
            PG8_LDA(At, 0, 1); PG8_STAGE(PG8_SA(0, 0), a2, voffA);
            PG8_BAR; PG8_WAIT_L(0); PG8_MMA(1, 0, At, B0); PG8_BAR; PG8_SCHED;
            PG8_STAGE(PG8_SB(0, 1), b2 + hstep, voffB);
            PG8_WAIT_V(6); PG8_BAR; PG8_MMA(1, 1, At, B1); PG8_BAR;
            PG8_LDB(B0, 1, 0); PG8_SCHED; PG8_LDA(At, 1, 0); PG8_STAGE(PG8_SA(0, 1), a2 + hstep, voffA);
            PG8_WAIT_L(8); PG8_BAR; PG8_WAIT_L(0); PG8_MMA(0, 0, At, B0); PG8_BAR; PG8_SCHED;
            PG8_LDB(B1, 1, 1); PG8_STAGE(PG8_SB(1, 0), b3, voffB);
            PG8_BAR; PG8_WAIT_L(0); PG8_MMA(0, 1, At, B1); PG8_BAR;
            PG8_LDA(At, 1, 1); PG8_STAGE(PG8_SA(1, 0), a3, voffA);
            PG8_BAR; PG8_WAIT_L(0); PG8_MMA(1, 0, At, B0); PG8_BAR; PG8_SCHED;
            PG8_STAGE(PG8_SB(1, 1), b3 + hstep, voffB);
            PG8_WAIT_V(6); PG8_BAR; PG8_MMA(1, 1, At, B1); PG8_BAR;
            }
        }
        if constexpr (ALIGN_EPI) { if (wr == 0) PG8_BAR; }
        if constexpr (!Epi::AFTER_DRAIN) { E(acc, cur, wr, wc, fr, fq); S.done(cur); }
        if (!has_next) break;
#pragma unroll
        for (int a = 0; a < 2; ++a)
#pragma unroll
            for (int b = 0; b < 2; ++b)
#pragma unroll
                for (int m = 0; m < 4; ++m)
#pragma unroll
                    for (int n = 0; n < 2; ++n) acc[a][b][m][n] = (f32x4){0.f, 0.f, 0.f, 0.f};
        cur = nxt; cA = nA; cB = nB; ++ui;
        if constexpr (ALIGN_EPI) { if (wr == 1) PG8_BAR; }
    }
    PG8_WAIT_V(0);
    if constexpr (!ALIGN_EPI) { if (wr == 0) PG8_BAR; }
    PG8_BAR;
    if constexpr (Epi::AFTER_DRAIN) { E.fused(acc, cur, wr, wc, fr, fq, lds, wid, lane); S.done(cur); }
#undef PG8_SA
#undef PG8_SB
#undef PG8_STAGE
#undef PG8_LDA
#undef PG8_LDB
#undef PG8_MMA
#undef PG8_WAIT_V
#undef PG8_WAIT_L
#undef PG8_BAR
#undef PG8_SCHED
}
}
#define GAS __attribute__((address_space(1)))
#define LAS __attribute__((address_space(3)))
typedef unsigned short bf16;
typedef unsigned v4u __attribute__((ext_vector_type(4)));
typedef float f32x4 __attribute__((ext_vector_type(4)));
typedef short bf16x8 __attribute__((ext_vector_type(8)));
typedef GAS unsigned gu32;
typedef GAS unsigned long long gu64;
#define RLX_AGENT __ATOMIC_RELAXED, __HIP_MEMORY_SCOPE_AGENT
#define LDS_WAIT() asm volatile("s_waitcnt lgkmcnt(0)" ::: "memory")
#define VM_WAIT() asm volatile("s_waitcnt vmcnt(0)" ::: "memory")
__device__ __forceinline__ unsigned long long rt() { return __builtin_amdgcn_s_memrealtime(); }
__device__ __forceinline__ unsigned f2bf(float f) { unsigned u = __builtin_bit_cast(unsigned, f); return (u + 0x7fffu + ((u >> 16) & 1u)) >> 16; }
__device__ __forceinline__ unsigned pk2(float lo, float hi) { return f2bf(lo) | (f2bf(hi) << 16); }

#define XB_TMO      128
#define XB_XCNT(j)  (256  + 64 * (j))
#define XB_XSUB(j)  (1280 + 64 * (j))
#define XB_XGEN(j)  (2304 + 64 * (j))
#define XB_TOP      3328
#define XB_TOPGEN   3392
#define XCD_BAR_WORDS 3456
#define XB_SPIN_CAP (1u << 18)

__device__ __forceinline__ unsigned xb_ld(unsigned* p)              { return __hip_atomic_load(p, __ATOMIC_RELAXED, __HIP_MEMORY_SCOPE_AGENT); }
__device__ __forceinline__ unsigned xb_add(unsigned* p, unsigned v) { return __hip_atomic_fetch_add(p, v, __ATOMIC_RELAXED, __HIP_MEMORY_SCOPE_AGENT); }
__device__ __forceinline__ unsigned xb_xcc_id() { return (unsigned)__builtin_amdgcn_s_getreg((3 << 11) | 20) & 0xFu; }
#define XB_SPIN(cond, bar) do { unsigned _sp = 0; while (cond) { __builtin_amdgcn_s_sleep(1); \
    if ((++_sp & 255u) == 0u) { if (xb_ld(&(bar)[XB_TMO])) break; if (_sp > XB_SPIN_CAP) { atomicAdd(&(bar)[XB_TMO], 1u); break; } } } } while (0)

struct XcdBarrier {
    unsigned* bar; unsigned x;
    volatile LAS unsigned* st;
};

__device__ __forceinline__ XcdBarrier xcd_barrier_post(unsigned* bar, volatile LAS unsigned* st) {
    XcdBarrier b; b.bar = bar; b.x = xb_xcc_id(); b.st = st;
    if (threadIdx.x == 0) (void)xb_add(&bar[XB_XCNT(b.x)], 1u);
    return b;
}
__device__ __forceinline__ void xcd_barrier_complete(unsigned* bar, unsigned x, unsigned& nloc, unsigned& nx) {
    const unsigned G = gridDim.x * gridDim.y * gridDim.z;
    unsigned sum, cnt, mine, sp = 0u;
    for (;;) {
        sum = 0u; cnt = 0u; mine = 0u;
#pragma unroll
        for (unsigned j = 0; j < 16; ++j) { const unsigned c = xb_ld(&bar[XB_XCNT(j)]); sum += c; cnt += (c > 0u) ? 1u : 0u; mine = (j == x) ? c : mine; }
        if (sum == G) break;
        __builtin_amdgcn_s_sleep(1);
        if ((++sp & 255u) == 0u) { if (xb_ld(&bar[XB_TMO])) break; if (sp > XB_SPIN_CAP) { atomicAdd(&bar[XB_TMO], 1u); break; } }
    }
    nloc = mine > 0u ? mine : 1u; nx = cnt > 0u ? cnt : 1u;
}

__device__ __forceinline__ void xcd_barrier(const XcdBarrier& b) {
    asm volatile("s_waitcnt vmcnt(0)" ::: "memory");
    __syncthreads();
    if (threadIdx.x == 0) {
        unsigned* bar = b.bar;
        __builtin_amdgcn_s_waitcnt(0);
        unsigned nloc = b.st[0], nx = b.st[1];
        if (nloc == 0u) { xcd_barrier_complete(bar, b.x, nloc, nx); b.st[0] = nloc; b.st[1] = nx; }
        const unsigned old = xb_add(&bar[XB_XSUB(b.x)], 1u);
        const unsigned gen = old / nloc;
        if (old + 1u == (gen + 1u) * nloc) {
            __builtin_amdgcn_fence(__ATOMIC_RELEASE, "agent");
            asm volatile("s_waitcnt vmcnt(0)" ::: "memory");
            const unsigned og = xb_add(&bar[XB_TOP], 1u);
            const unsigned tg = og / nx;
            if (og + 1u == (tg + 1u) * nx) xb_add(&bar[XB_TOPGEN], 1u);
            else XB_SPIN(xb_ld(&bar[XB_TOPGEN]) == tg, bar);
            __builtin_amdgcn_fence(__ATOMIC_ACQUIRE, "agent");
            xb_add(&bar[XB_XGEN(b.x)], 1u);
            asm volatile("s_waitcnt vmcnt(0)" ::: "memory");
        } else {
            XB_SPIN(xb_ld(&bar[XB_XGEN(b.x)]) == gen, bar);
            __builtin_amdgcn_fence(__ATOMIC_ACQUIRE, "agent");
            asm volatile("s_waitcnt vmcnt(0)" ::: "memory");
        }
    }
    __syncthreads();
}

constexpr int NWAVES = 8;
constexpr int BATCH = 8, SEQ = 4096, D = 1024, T = BATCH * SEQ, DEPTH = 2;
constexpr int DCONV = 512, NHEAD = 8, HD = 64, DATTN = 512, DFF = 2816, NEXP = 8, DFFE = 2048;
constexpr int NIN = 5120, NPA = 2560, NGT = 2048, NPROJ = NPA + NGT;
constexpr float EPS = 1e-6f;
constexpr float QSCALE = 0.125f * 1.4426950408889634f;
constexpr int MPAD = 2 * T + NEXP * 256;

constexpr size_t MiB = 1u << 20;
constexpr size_t WS_CTL = 0, CTL_ZERO_BYTES = 1 * MiB;
constexpr size_t WS_ROUTE = 1 * MiB;
constexpr size_t WS_SLOTS = WS_ROUTE + 512 * 1024, WS_WGCNT = WS_ROUTE + 768 * 1024;
constexpr size_t WS_WL = 4 * MiB, WL_STRIDE = 14 * MiB;
constexpr size_t WL_WIN = 0, WL_WV = 9 * MiB, WL_WA = 10 * MiB, WL_WB = 11 * MiB, WL_WO = 12 * MiB;
constexpr size_t WS_WGU = 32 * MiB, WS_WD = 43 * MiB;
constexpr size_t WS_H = 50 * MiB;
constexpr size_t WS_UA = WS_H, WS_UB = WS_H + 32 * MiB;
constexpr size_t WS_VT = 114 * MiB;
constexpr size_t WS_GT = 146 * MiB;
constexpr size_t WS_PA = 274 * MiB;
constexpr size_t WS_TMP = 274 * MiB, WS_MIX = 338 * MiB;
constexpr size_t WS_G0 = 146 * MiB;
constexpr size_t WS_WEG = 4 * MiB, WS_WED = 68 * MiB;
constexpr size_t WS_HP = 100 * MiB;
constexpr size_t WS_G1 = 232 * MiB;
constexpr size_t WS_END = 512 * MiB;
static_assert(WS_G1 + (size_t)MPAD * DFFE * 2 <= WS_END && WS_HP + (size_t)MPAD * D * 2 <= WS_G1 && WS_PA + (size_t)T * NPA * 2 <= WS_END, "d_ws map");
constexpr int CW_TMO = 0, CW_CODE = 1, CW_BAR = 4096, CW_CNT = 8192;

constexpr int RING_OFF = 0, RING_BYTES = 131072, LDSCTL_OFF = RING_BYTES, MISC_OFF = LDSCTL_OFF + 320, LDS_BYTES = 147456;

typedef unsigned u32x2v __attribute__((ext_vector_type(2)));
__device__ __forceinline__ float wave_sum(float v) {
#pragma unroll
    for (int o = 1; o < 64; o <<= 1) v += __shfl_xor(v, o);
    return v;
}
using pg8::cvt_pk_bf16;
__device__ __forceinline__ void tr_block(const float* W, int K, int N, bf16* dst, int drow, int k0, int n0, LAS float* scr, int lane) {
#pragma unroll 8
    for (int i = 0; i < 32; ++i) { const int kk = 2 * i + (lane >> 5); scr[kk * 33 + (lane & 31)] = W[(size_t)(k0 + kk) * N + n0 + (lane & 31)]; }
    LDS_WAIT(); asm volatile("" ::: "memory");
    const int c = lane & 7;
#pragma unroll
    for (int j = 0; j < 4; ++j) { const int n = (lane >> 3) + 8 * j; const LAS float* s = scr + (8 * c) * 33 + n;
        v4u o; o.x = cvt_pk_bf16(s[0 * 33], s[1 * 33]); o.y = cvt_pk_bf16(s[2 * 33], s[3 * 33]); o.z = cvt_pk_bf16(s[4 * 33], s[5 * 33]); o.w = cvt_pk_bf16(s[6 * 33], s[7 * 33]);
        *(GAS v4u*)(dst + (size_t)(drow + n) * K + k0 + 8 * c) = o; }
    LDS_WAIT(); asm volatile("" ::: "memory");
}
template <int KIND> __device__ __forceinline__ void tr_item(const float* W, int K, int N, bf16* dst, bf16* dst2, LAS float* scr, int item, int lane) {
    const int nblk = N / 32, kb = item / nblk, nb = item % nblk, k0 = 64 * kb, n0 = 32 * nb;
    bf16* d = dst; int drow = n0;
    if (KIND == 1) { if (n0 >= 3072) drow = n0 - 512; else if (n0 >= 2560) { d = dst2; drow = n0 - 2560; } }
    if (KIND == 2) drow = 256 * (n0 / 128) + (n0 % 128);
    if (KIND == 3) drow = 256 * (n0 / 128) + 128 + (n0 % 128);
    tr_block(W, K, N, d, drow, k0, n0, scr, lane);
}
__device__ __forceinline__ void rms_row_to_bf16(const float* xrow, const float* g, bf16* orow, int lane) {
    const GAS f32x4* xr = (const GAS f32x4*)xrow + lane; const GAS f32x4* gr = (const GAS f32x4*)g + lane;
    f32x4 v[4]; float s = 0.f;
#pragma unroll
    for (int j = 0; j < 4; ++j) { v[j] = xr[64 * j]; s += (v[j].x * v[j].x + v[j].y * v[j].y) + (v[j].z * v[j].z + v[j].w * v[j].w); }
    const float rstd = 1.0f / sqrtf(wave_sum(s) * (1.f / D) + EPS);
    GAS u32x2v* o8 = (GAS u32x2v*)orow + lane;
#pragma unroll
    for (int j = 0; j < 4; ++j) { const f32x4 gg = gr[64 * j]; u32x2v w; w.x = cvt_pk_bf16(v[j].x * rstd * gg.x, v[j].y * rstd * gg.y); w.y = cvt_pk_bf16(v[j].z * rstd * gg.z, v[j].w * rstd * gg.w); o8[64 * j] = w; }
}
__device__ __forceinline__ void unpack8f(const v4u w, float (&f)[8]) {
    f[0] = __builtin_bit_cast(float, w.x << 16); f[1] = __builtin_bit_cast(float, w.x & 0xffff0000u); f[2] = __builtin_bit_cast(float, w.y << 16); f[3] = __builtin_bit_cast(float, w.y & 0xffff0000u);
    f[4] = __builtin_bit_cast(float, w.z << 16); f[5] = __builtin_bit_cast(float, w.z & 0xffff0000u); f[6] = __builtin_bit_cast(float, w.w << 16); f[7] = __builtin_bit_cast(float, w.w & 0xffff0000u);
}
__device__ __forceinline__ v4u pack8f(const float (&f)[8]) { v4u w; w.x = cvt_pk_bf16(f[0], f[1]); w.y = cvt_pk_bf16(f[2], f[3]); w.z = cvt_pk_bf16(f[4], f[5]); w.w = cvt_pk_bf16(f[6], f[7]); return w; }

__device__ __forceinline__ void conv_phase(const bf16* PA, const float* cw, bf16* UA, int gid, int nthr) {
    for (int it = gid; it < (T / 16) * 64; it += nthr) {
        const int cg = it & 63, t0 = (it >> 6) * 16, c0 = cg * 8;
        float w0[8], w1[8], w2[8];
#pragma unroll
        for (int i = 0; i < 8; ++i) { w0[i] = cw[c0 + i]; w1[i] = cw[DCONV + c0 + i]; w2[i] = cw[2 * DCONV + c0 + i]; }
        float um2[8], um1[8];
        if ((t0 & (SEQ - 1)) == 0) {
#pragma unroll
            for (int i = 0; i < 8; ++i) { um2[i] = 0.f; um1[i] = 0.f; }
        } else {
            float a[8], b[8];
            unpack8f(*(const GAS v4u*)(PA + (size_t)(t0 - 2) * NPA + c0), a); unpack8f(*(const GAS v4u*)(PA + (size_t)(t0 - 2) * NPA + 1024 + c0), b);
#pragma unroll
            for (int i = 0; i < 8; ++i) um2[i] = a[i] * b[i];
            unpack8f(*(const GAS v4u*)(PA + (size_t)(t0 - 1) * NPA + c0), a); unpack8f(*(const GAS v4u*)(PA + (size_t)(t0 - 1) * NPA + 1024 + c0), b);
#pragma unroll
            for (int i = 0; i < 8; ++i) um1[i] = a[i] * b[i];
        }
#pragma unroll 4
        for (int r = 0; r < 16; ++r) {
            const bf16* row = PA + (size_t)(t0 + r) * NPA + c0;
            float xin[8], bg[8], cgv[8], o[8];
            unpack8f(*(const GAS v4u*)(row), xin); unpack8f(*(const GAS v4u*)(row + 512), bg); unpack8f(*(const GAS v4u*)(row + 1024), cgv);
#pragma unroll
            for (int i = 0; i < 8; ++i) { const float u = cgv[i] * xin[i]; o[i] = bg[i] * (w0[i] * um2[i] + w1[i] * um1[i] + w2[i] * u); um2[i] = um1[i]; um1[i] = u; }
            *(GAS v4u*)(UA + (size_t)(t0 + r) * DCONV + c0) = pack8f(o);
        }
    }
}

__device__ __forceinline__ void attn_naive(const bf16* PA, const bf16* VT, bf16* UB, int gid, int nthr) {
#pragma unroll 1
    for (int idx4 = gid; idx4 < T * NHEAD * 4; idx4 += nthr) {
        const int part = idx4 & 3, idx = idx4 >> 2;
        const int t = idx & (SEQ - 1), bh = idx >> 12, h = bh & 7, b = bh >> 3;
        const size_t row = (size_t)b * SEQ + t;
        float q[16], o[16];
#pragma unroll
        for (int c = 0; c < 2; ++c) { float f[8]; unpack8f(*(const GAS v4u*)(PA + row * NPA + 1536 + h * 64 + part * 16 + c * 8), f);
#pragma unroll
            for (int i = 0; i < 8; ++i) { q[c * 8 + i] = f[i]; o[c * 8 + i] = 0.f; } }
        float R = 1.f;
#pragma unroll 1
        for (int kb = (t - 1) >> 3; kb >= 0 && t > 0; --kb) {
            float rr[8];
#pragma unroll
            for (int j = 0; j < 8; ++j) {
                const int key = kb * 8 + j;
                const bf16* kr = PA + ((size_t)b * SEQ + key) * NPA + 2048 + h * 64 + part * 16; float z = 0.f;
#pragma unroll
                for (int c = 0; c < 2; ++c) { float f[8]; unpack8f(*(const GAS v4u*)(kr + c * 8), f);
#pragma unroll
                    for (int i = 0; i < 8; ++i) z += q[c * 8 + i] * f[i]; }
                z += __shfl_xor(z, 1); z += __shfl_xor(z, 2);
                rr[j] = (key < t) ? __builtin_amdgcn_rcpf(1.0f + __builtin_amdgcn_exp2f(z)) : 1.f;
            }
            float a[8];
#pragma unroll
            for (int j = 7; j >= 0; --j) { const float Rn = R * rr[j]; a[j] = R - Rn; R = Rn; }
            const bf16* vp = VT + (size_t)(h * 64 + part * 16) * T + (size_t)b * SEQ + kb * 8;
#pragma unroll
            for (int d = 0; d < 16; ++d) { float f[8]; unpack8f(*(const GAS v4u*)(vp + (size_t)d * T), f); float s = 0.f;
#pragma unroll
                for (int j = 0; j < 8; ++j) s += a[j] * f[j];
                o[d] += s; }
            if (R == 0.f) break;
        }
#pragma unroll
        for (int c = 0; c < 2; ++c) { float f[8];
#pragma unroll
            for (int i = 0; i < 8; ++i) f[i] = o[c * 8 + i];
            *(GAS v4u*)(UB + row * DATTN + h * 64 + part * 16 + c * 8) = pack8f(f); }
    }
}

struct Args { const float* in[16]; float* out; unsigned char* ws; };
typedef const __attribute__((address_space(4))) Args* KArgP;
__device__ __forceinline__ KArgP launder_k(KArgP p) { asm volatile("" : "+s"(p)); return p; }
__device__ __forceinline__ int launder_s(int v) { asm volatile("" : "+s"(v)); return v; }
__device__ __forceinline__ int launder_v(int v) { asm volatile("" : "+v"(v)); return v; }
#define PH_BEGIN { const KArgP ap = launder_k(kp0); unsigned char* const ws = ap->ws; const int bx = launder_s(bx0), G = launder_s(G0); const int tid = launder_v(tid0), lane = tid & 63, wave = __builtin_amdgcn_readfirstlane(tid >> 6); \
    const int gid = bx * (NWAVES * 64) + tid, nthr = G * NWAVES * 64, gw = bx * NWAVES + wave, NGW = G * NWAVES; (void)gid; (void)nthr; (void)gw; (void)NGW; (void)lane; \
    LAS float* const scr = (LAS float*)(lds + RING_OFF + wave * 16384); (void)scr; (void)ws;
#define PH_END(BARRIER) if (BARRIER) xcd_barrier(bar); }
#define WSP(T_, off) ((T_*)(ws + (off)))

__global__ void __launch_bounds__(NWAVES * 64, 2) mega_fwd(Args args) {
    extern __shared__ __attribute__((aligned(16))) unsigned char lds_raw[];
    LAS unsigned char* const lds = (LAS unsigned char*)lds_raw;
    volatile LAS unsigned* const MISC = (volatile LAS unsigned*)(lds + MISC_OFF);
    const KArgP kp0 = (KArgP)__builtin_amdgcn_kernarg_segment_ptr();
    const int tid0 = threadIdx.x, G0 = gridDim.x, bx0 = blockIdx.x;
    for (int u = tid0; u < (LDS_BYTES - LDSCTL_OFF) / 4; u += NWAVES * 64) ((LAS unsigned*)(lds + LDSCTL_OFF))[u] = 0u;
    __syncthreads();
    XcdBarrier bar = xcd_barrier_post((unsigned*)(args.ws + WS_CTL) + CW_BAR, MISC + 8);

    PH_BEGIN
        constexpr int I_IN = 16 * 160, I_BR = 8 * 32, I_O = 16 * 32, I_GU = 16 * 88, I_D = 44 * 32;
        constexpr int PER_L = I_IN + 2 * I_BR + I_O, NITEMS = 2 * PER_L + 2 * I_GU + I_D;
#pragma unroll 1
        for (int it = gw; it < NITEMS; it += NGW) {
            int r = it;
            if (r < 2 * PER_L) {
                const int l = r / PER_L; r -= l * PER_L; unsigned char* wl = ws + WS_WL + (size_t)l * WL_STRIDE;
                if (r < I_IN) { tr_item<1>(ap->in[2] + (size_t)l * D * NIN, D, NIN, (bf16*)(wl + WL_WIN), (bf16*)(wl + WL_WV), scr, r, lane); continue; } r -= I_IN;
                if (r < I_BR) { tr_item<0>(ap->in[4] + (size_t)l * DCONV * D, DCONV, D, (bf16*)(wl + WL_WA), nullptr, scr, r, lane); continue; } r -= I_BR;
                if (r < I_BR) { tr_item<0>(ap->in[5] + (size_t)l * DATTN * D, DATTN, D, (bf16*)(wl + WL_WB), nullptr, scr, r, lane); continue; } r -= I_BR;
                tr_item<0>(ap->in[6] + (size_t)l * D * D, D, D, (bf16*)(wl + WL_WO), nullptr, scr, r, lane); continue;
            }
            r -= 2 * PER_L;
            if (r < I_GU) { tr_item<2>(ap->in[8], D, DFF, WSP(bf16, WS_WGU), nullptr, scr, r, lane); continue; } r -= I_GU;
            if (r < I_GU) { tr_item<3>(ap->in[9], D, DFF, WSP(bf16, WS_WGU), nullptr, scr, r, lane); continue; } r -= I_GU;
            tr_item<0>(ap->in[10], DFF, D, WSP(bf16, WS_WD), nullptr, scr, r, lane);
        }
#pragma unroll 1
        for (int m = gw; m < T; m += NGW) rms_row_to_bf16(ap->in[0] + (size_t)m * D, ap->in[1], WSP(bf16, WS_H) + (size_t)m * D, lane);
    PH_END(true)

#pragma unroll 1
    for (int l = 0; l < DEPTH; ++l) {
        PH_BEGIN
            unsigned char* wl = ws + WS_WL + (size_t)l * WL_STRIDE;
            pg8::Gemm g{WSP(bf16, WS_H), (const bf16*)(wl + WL_WIN), T, NPROJ, D}; pg8::StaticOrder S; S.init(T, NPROJ, G, bx);
            pg8::EpiProj E{WSP(bf16, WS_PA), WSP(bf16, WS_GT), QSCALE};
            pg8::gemm_phase<pg8::EpiProj, pg8::StaticOrder, true, true>(lds + RING_OFF, g, S, E, tid);
        PH_END(false)
        PH_BEGIN
            unsigned char* wl = ws + WS_WL + (size_t)l * WL_STRIDE;
            pg8::Gemm g{(const bf16*)(wl + WL_WV), WSP(bf16, WS_H), DATTN, T, D}; pg8::StaticOrder S; S.init(DATTN, T, G, bx);
            pg8::EpiPlain E{WSP(bf16, WS_VT), T};
            pg8::gemm_phase<pg8::EpiPlain, pg8::StaticOrder, true, true>(lds + RING_OFF, g, S, E, tid);
        PH_END(true)
        PH_BEGIN
            conv_phase(WSP(bf16, WS_PA), ap->in[3] + (size_t)l * 3 * DCONV, WSP(bf16, WS_UA), gid, nthr);
        PH_END(false)
        PH_BEGIN
            attn_naive(WSP(bf16, WS_PA), WSP(bf16, WS_VT), WSP(bf16, WS_UB), gid, nthr);
        PH_END(true)
        PH_BEGIN
            unsigned char* wl = ws + WS_WL + (size_t)l * WL_STRIDE;
            pg8::Gemm g{WSP(bf16, WS_UA), (const bf16*)(wl + WL_WA), T, D, DCONV}; pg8::StaticOrder S; S.init(T, D, G, bx);
            pg8::EpiGateA E{WSP(bf16, WS_GT), WSP(bf16, WS_TMP)};
            pg8::gemm_phase<pg8::EpiGateA, pg8::StaticOrder, true, true>(lds + RING_OFF, g, S, E, tid);
        PH_END(false)
        PH_BEGIN
            unsigned char* wl = ws + WS_WL + (size_t)l * WL_STRIDE;
            pg8::Gemm g{WSP(bf16, WS_UB), (const bf16*)(wl + WL_WB), T, D, DATTN}; pg8::StaticOrder S; S.init(T, D, G, bx);
            pg8::EpiGateB E{WSP(bf16, WS_GT), WSP(bf16, WS_TMP), WSP(bf16, WS_MIX)};
            pg8::gemm_phase<pg8::EpiGateB, pg8::StaticOrder, true, true>(lds + RING_OFF, g, S, E, tid);
        PH_END(true)
        PH_BEGIN
            unsigned char* wl = ws + WS_WL + (size_t)l * WL_STRIDE;
            pg8::Gemm g{WSP(bf16, WS_MIX), (const bf16*)(wl + WL_WO), T, D, D}; pg8::StaticOrder S; S.init(T, D, G, bx);
            pg8::EpiRes E{l == 0 ? ap->in[0] : (const float*)ap->out, ap->out, D};
            pg8::gemm_phase<pg8::EpiRes, pg8::StaticOrder, true, true>(lds + RING_OFF, g, S, E, tid);
        PH_END(true)
        if (l == 0) {
            PH_BEGIN
#pragma unroll 1
                for (int m = gw; m < T; m += NGW) rms_row_to_bf16(ap->out + (size_t)m * D, ap->in[7], WSP(bf16, WS_H) + (size_t)m * D, lane);
            PH_END(true)
            PH_BEGIN
                pg8::Gemm g{WSP(bf16, WS_H), WSP(bf16, WS_WGU), T, 2 * DFF, D}; pg8::StaticOrder S; S.init(T, 2 * DFF, G, bx);
                pg8::EpiSwiGLU E{WSP(bf16, WS_G0), DFF};
                pg8::gemm_phase<pg8::EpiSwiGLU, pg8::StaticOrder, true, true>(lds + RING_OFF, g, S, E, tid);
            PH_END(true)
            PH_BEGIN
                pg8::Gemm g{WSP(bf16, WS_G0), WSP(bf16, WS_WD), T, D, DFF}; pg8::StaticOrder S; S.init(T, D, G, bx);
                pg8::EpiRes E{ap->out, ap->out, D};
                pg8::gemm_phase<pg8::EpiRes, pg8::StaticOrder, true, true>(lds + RING_OFF, g, S, E, tid);
            PH_END(true)
            PH_BEGIN
#pragma unroll 1
                for (int m = gw; m < T; m += NGW) rms_row_to_bf16(ap->out + (size_t)m * D, ap->in[1] + D, WSP(bf16, WS_H) + (size_t)m * D, lane);
            PH_END(true)
        } else {
            volatile LAS int* const lcnt = (volatile LAS int*)(MISC + 32);
            volatile LAS unsigned* const loff = MISC + 16;
            volatile LAS int* const lbase = (volatile LAS int*)(MISC + 48);
            PH_BEGIN
                constexpr int I_E = 16 * 64;
#pragma unroll 1
                for (int it = gw; it < NEXP * 3 * I_E; it += NGW) {
                    const int e = it / (3 * I_E); int r = it - e * 3 * I_E;
                    if (r < I_E) { tr_item<2>(ap->in[12] + (size_t)e * D * DFFE, D, DFFE, WSP(bf16, WS_WEG) + (size_t)e * 2 * DFFE * D, nullptr, scr, r, lane); continue; } r -= I_E;
                    if (r < I_E) { tr_item<3>(ap->in[13] + (size_t)e * D * DFFE, D, DFFE, WSP(bf16, WS_WEG) + (size_t)e * 2 * DFFE * D, nullptr, scr, r, lane); continue; } r -= I_E;
                    tr_item<0>(ap->in[14] + (size_t)e * DFFE * D, DFFE, D, WSP(bf16, WS_WED) + (size_t)e * D * DFFE, nullptr, scr, r, lane);
                }
            PH_END(false)
            PH_BEGIN
                int4* route = WSP(int4, WS_ROUTE); int* wgcnt = WSP(int, WS_WGCNT); gu32* ctl = (gu32*)(ws + WS_CTL);
                const int rpw = T / G, r0 = bx * rpw, r1 = r0 + rpw;
                const float* xres = ap->out; const float* gf = ap->in[7] + D; const float* w_router = ap->in[11];
                if (tid < 8) lcnt[tid] = 0;
                __syncthreads();
#pragma unroll 1
                for (int m = r0 + wave; m < r1; m += NWAVES) {
                    const GAS f32x4* xr = (const GAS f32x4*)(xres + (size_t)m * D) + lane; const GAS f32x4* gr = (const GAS f32x4*)gf + lane;
                    f32x4 v[4]; float s = 0.f;
#pragma unroll
                    for (int j = 0; j < 4; ++j) { v[j] = xr[64 * j]; s += (v[j].x * v[j].x + v[j].y * v[j].y) + (v[j].z * v[j].z + v[j].w * v[j].w); }
                    const float rstd = 1.0f / sqrtf(wave_sum(s) * (1.f / D) + EPS);
                    float lg[8];
#pragma unroll
                    for (int e = 0; e < 8; ++e) lg[e] = 0.f;
#pragma unroll
                    for (int j = 0; j < 4; ++j) { const f32x4 gg = gr[64 * j];
#pragma unroll
                        for (int c = 0; c < 4; ++c) { const float hn = v[j][c] * rstd * gg[c]; const int i = 256 * j + 4 * lane + c;
                            const f32x4 wa = *(const GAS f32x4*)(w_router + (size_t)i * 8), wb = *(const GAS f32x4*)(w_router + (size_t)i * 8 + 4);
                            lg[0] += hn * wa.x; lg[1] += hn * wa.y; lg[2] += hn * wa.z; lg[3] += hn * wa.w; lg[4] += hn * wb.x; lg[5] += hn * wb.y; lg[6] += hn * wb.z; lg[7] += hn * wb.w; } }
#pragma unroll
                    for (int e = 0; e < 8; ++e) lg[e] = wave_sum(lg[e]);
                    int e1 = 0; float v1 = lg[0];
#pragma unroll
                    for (int e = 1; e < 8; ++e) if (lg[e] > v1) { v1 = lg[e]; e1 = e; }
                    int e2 = -1; float v2 = -INFINITY;
#pragma unroll
                    for (int e = 0; e < 8; ++e) if (e != e1 && lg[e] > v2) { v2 = lg[e]; e2 = e; }
                    if (e2 < 0) e2 = (e1 + 1) & 7;
                    const float ex = __expf(v2 - v1), w1 = 1.0f / (1.0f + ex), w2 = ex * w1;
                    if (lane == 0) { route[m] = make_int4(e1, e2, __float_as_int(w1), __float_as_int(w2)); atomicAdd((int*)(lcnt + e1), 1); atomicAdd((int*)(lcnt + e2), 1); }
                }
                __syncthreads();
                if (tid < 8) { const int c = lcnt[tid]; wgcnt[bx * 8 + tid] = c; __hip_atomic_fetch_add((unsigned*)(ctl + CW_CNT + tid), (unsigned)c, RLX_AGENT); }
            PH_END(true)
            PH_BEGIN
                int4* route = WSP(int4, WS_ROUTE); int2* slots = WSP(int2, WS_SLOTS); int* wgcnt = WSP(int, WS_WGCNT); gu32* ctl = (gu32*)(ws + WS_CTL); bf16* HP = WSP(bf16, WS_HP);
                const int rpw = T / G, r0 = bx * rpw, r1 = r0 + rpw;
                const float* xres = ap->out; const float* gf = ap->in[7] + D;
                { int s = 0; for (int w = lane; w < bx; w += 64) s += wgcnt[w * 8 + wave]; s = (int)wave_sum((float)s);
                  if (lane == 0) { lbase[wave] = s; lcnt[wave] = 0; } }
                if (tid == 0) { unsigned off = 0; for (int e = 0; e < 8; ++e) { loff[e] = off; off += (__hip_atomic_load((unsigned*)(ctl + CW_CNT + e), RLX_AGENT) + 255u) & ~255u; } loff[8] = off; }
                __syncthreads();
#pragma unroll 1
                for (int m = r0 + wave; m < r1; m += NWAVES) {
                    int s1 = 0, s2 = 0;
                    if (lane == 0) { const int4 rt = route[m]; s1 = (int)loff[rt.x] + lbase[rt.x] + atomicAdd((int*)(lcnt + rt.x), 1); s2 = (int)loff[rt.y] + lbase[rt.y] + atomicAdd((int*)(lcnt + rt.y), 1); slots[m] = make_int2(s1, s2); }
                    s1 = __builtin_amdgcn_readfirstlane(s1); s2 = __builtin_amdgcn_readfirstlane(s2);
                    const GAS f32x4* xr = (const GAS f32x4*)(xres + (size_t)m * D) + lane; const GAS f32x4* gr = (const GAS f32x4*)gf + lane;
                    f32x4 v[4]; float s = 0.f;
#pragma unroll
                    for (int j = 0; j < 4; ++j) { v[j] = xr[64 * j]; s += (v[j].x * v[j].x + v[j].y * v[j].y) + (v[j].z * v[j].z + v[j].w * v[j].w); }
                    const float rstd = 1.0f / sqrtf(wave_sum(s) * (1.f / D) + EPS);
                    GAS u32x2v* o1 = (GAS u32x2v*)(HP + (size_t)s1 * D) + lane; GAS u32x2v* o2 = (GAS u32x2v*)(HP + (size_t)s2 * D) + lane;
#pragma unroll
                    for (int j = 0; j < 4; ++j) { const f32x4 gg = gr[64 * j]; u32x2v w; w.x = cvt_pk_bf16(v[j].x * rstd * gg.x, v[j].y * rstd * gg.y); w.y = cvt_pk_bf16(v[j].z * rstd * gg.z, v[j].w * rstd * gg.w); o1[64 * j] = w; o2[64 * j] = w; }
                }
            PH_END(true)
            PH_BEGIN
                const int mrows = (int)loff[8];
                pg8::Gemm g{WSP(bf16, WS_HP), WSP(bf16, WS_WEG), mrows, 2 * DFFE, D}; pg8::MoeOrder S; S.init(mrows, 2 * DFFE, G, bx); S.offs = loff; S.ntn = 2 * DFFE / 256;
                pg8::EpiSwiGLU E{WSP(bf16, WS_G1), DFFE};
                pg8::gemm_phase<pg8::EpiSwiGLU, pg8::MoeOrder, true, true>(lds + RING_OFF, g, S, E, tid);
            PH_END(true)
            PH_BEGIN
                const int mrows = (int)loff[8];
                pg8::Gemm g{WSP(bf16, WS_G1), WSP(bf16, WS_WED), mrows, D, DFFE}; pg8::MoeOrder S; S.init(mrows, D, G, bx); S.offs = loff; S.ntn = D / 256;
                pg8::EpiPlain E{WSP(bf16, WS_HP), D};
                pg8::gemm_phase<pg8::EpiPlain, pg8::MoeOrder, true, true>(lds + RING_OFF, g, S, E, tid);
            PH_END(true)
            PH_BEGIN
                const int4* route = WSP(int4, WS_ROUTE); const int2* slots = WSP(int2, WS_SLOTS); const bf16* HP = WSP(bf16, WS_HP); float* xres = ap->out; const float* g_final = ap->in[15];
#pragma unroll 1
                for (int m = gw; m < T; m += NGW) {
                    const int4 rt = route[m]; const int2 sl = slots[m]; const float w1 = __int_as_float(rt.z), w2 = __int_as_float(rt.w);
                    GAS f32x4* xr = (GAS f32x4*)(xres + (size_t)m * D) + lane; const GAS f32x4* gr = (const GAS f32x4*)g_final + lane;
                    const GAS u32x2v* y1 = (const GAS u32x2v*)(HP + (size_t)sl.x * D) + lane; const GAS u32x2v* y2 = (const GAS u32x2v*)(HP + (size_t)sl.y * D) + lane;
                    f32x4 v[4]; float s = 0.f;
#pragma unroll
                    for (int j = 0; j < 4; ++j) { v[j] = xr[64 * j]; const u32x2v a = y1[64 * j], b = y2[64 * j];
                        v[j].x += w1 * __builtin_bit_cast(float, a.x << 16) + w2 * __builtin_bit_cast(float, b.x << 16);
                        v[j].y += w1 * __builtin_bit_cast(float, a.x & 0xffff0000u) + w2 * __builtin_bit_cast(float, b.x & 0xffff0000u);
                        v[j].z += w1 * __builtin_bit_cast(float, a.y << 16) + w2 * __builtin_bit_cast(float, b.y << 16);
                        v[j].w += w1 * __builtin_bit_cast(float, a.y & 0xffff0000u) + w2 * __builtin_bit_cast(float, b.y & 0xffff0000u);
                        s += (v[j].x * v[j].x + v[j].y * v[j].y) + (v[j].z * v[j].z + v[j].w * v[j].w); }
                    const float rstd = 1.0f / sqrtf(wave_sum(s) * (1.f / D) + EPS);
#pragma unroll
                    for (int j = 0; j < 4; ++j) { const f32x4 gg = gr[64 * j]; xr[64 * j] = (f32x4){v[j].x * rstd * gg.x, v[j].y * rstd * gg.y, v[j].z * rstd * gg.z, v[j].w * rstd * gg.w}; }
                }
            PH_END(false)
        }
    }
}

extern "C" void kernel_launch(void* const* d_in, const int* in_sizes, int n_in, void* d_out, int out_size, void* d_ws, size_t ws_size, hipStream_t stream) {
    static int grid = 0;
    if (grid == 0) {
        if (n_in != 16 || in_sizes[0] != T * D || out_size != T * D || ws_size < WS_END) { fprintf(stderr, "kernel_launch: unexpected shapes (n_in %d, in0 %d, out %d, ws %zu); nothing launched\n", n_in, n_in > 0 ? in_sizes[0] : -1, out_size, ws_size); grid = -1; return; }
        int dev = 0, cus = 0, per_cu = 0;
        if (hipGetDevice(&dev) != hipSuccess || hipDeviceGetAttribute(&cus, hipDeviceAttributeMultiprocessorCount, dev) != hipSuccess) { grid = -1; return; }
        if (hipFuncSetAttribute((const void*)mega_fwd, hipFuncAttributeMaxDynamicSharedMemorySize, LDS_BYTES) != hipSuccess) { fprintf(stderr, "kernel_launch: hipFuncSetAttribute failed\n"); grid = -1; return; }
        if (hipOccupancyMaxActiveBlocksPerMultiprocessor(&per_cu, (const void*)mega_fwd, NWAVES * 64, LDS_BYTES) != hipSuccess || per_cu < 1) { fprintf(stderr, "kernel_launch: occupancy query reports %d workgroups per CU\n", per_cu); }
        (void)hipGetLastError();
        grid = cus;
        while (grid > 1 && (T % grid) != 0) --grid;
    }
    if (grid < 0) return;
    if (hipMemsetAsync((char*)d_ws + WS_CTL, 0, CTL_ZERO_BYTES, stream) != hipSuccess) return;
    Args a{};
    for (int i = 0; i < 16; ++i) a.in[i] = (const float*)d_in[i];
    a.out = (float*)d_out; a.ws = (unsigned char*)d_ws;
    hipLaunchKernelGGL(mega_fwd, dim3(grid), dim3(NWAVES * 64), LDS_BYTES, stream, a);
}
```

```cpp
#include <hip/hip_runtime.h>
#include <cstdio>
#include <cstdint>
#include <cmath>
namespace pg8 {
#define PG8_LAS __attribute__((address_space(3)))
typedef unsigned short bf16_t;
typedef short bf16x8 __attribute__((ext_vector_type(8)));
typedef float f32x4 __attribute__((ext_vector_type(4)));
typedef unsigned u32x4 __attribute__((ext_vector_type(4)));
constexpr int BM = 256, BK = 64, HALF = 128, HTB = HALF * BK * 2  , STAGE_BYTES = 8 * HTB, NXCD = 8, WGM = 8;

__host__ __device__ __forceinline__ int lds_byte(int r, int c) { const int st = (r >> 4) * 2 + (c >> 5), rr = r & 15, cc = c & 31, ob = rr * 64 + cc * 2; return st * 1024 + (ob ^ (((ob >> 9) & 1) << 5)); }
__host__ __device__ __forceinline__ void stage_rc(int b, int& R, int& C) { const int st = b / 1024, sb = b % 1024, swz = sb ^ (((sb >> 9) & 1) << 5); R = (st >> 1) * 16 + swz / 64; C = (st & 1) * 32 + (swz % 64) / 2; }
__host__ __device__ __forceinline__ int perm32(int rho) { const int n = rho >> 4, i = rho & 15; return 8 * (i >> 2) + 4 * n + (i & 3); }

struct Unit { int pm, pn, pb; };
struct Gemm { const bf16_t* A; const bf16_t* Bt; int M, N, K; };

struct StaticOrder {
    int nM, nN, nwg, G, c;
    __host__ __device__ void init(int M, int N, int G_, int c_) { nM = M / BM; nN = N / BM; nwg = nM * nN; G = G_; c = c_; }
    __host__ __device__ bool next(int i, Unit& u) const {
        const long L = (long)i * G + c; if (L >= nwg) return false;
        int wgid = (int)L; { const int q = nwg / NXCD, r = nwg % NXCD, xcd = wgid % NXCD, off = wgid / NXCD; wgid = (xcd < r ? xcd * (q + 1) : r * (q + 1) + (xcd - r) * q) + off; }
        const int nig = WGM * nN, gid = wgid / nig, fm = gid * WGM, gsz = (nM - fm) < WGM ? (nM - fm) : WGM;
        u.pm = fm + ((wgid % nig) % gsz); u.pn = (wgid % nig) / gsz; u.pb = u.pn; return true;
    }
    __device__ __forceinline__ void a_ready(const Unit&) const {}
    __device__ __forceinline__ void done(const Unit&) const {}
};

__device__ __forceinline__ unsigned cvt_pk_bf16(float lo, float hi) { unsigned r; asm volatile("v_cvt_pk_bf16_f32 %0, %1, %2" : "=v"(r) : "v"(lo), "v"(hi)); return r; }
typedef float f32x2 __attribute__((ext_vector_type(2)));

__device__ __forceinline__ float sigmoidf_fast(float x) { return __builtin_amdgcn_rcpf(1.0f + __builtin_amdgcn_exp2f(-1.4426950408889634f * x)); }
__device__ __forceinline__ float bf_lo(unsigned w) { return __builtin_bit_cast(float, w << 16); }
__device__ __forceinline__ float bf_hi(unsigned w) { return __builtin_bit_cast(float, w & 0xffff0000u); }
__device__ __forceinline__ void unpack8(const u32x4 w, float (&f)[8]) { f[0] = bf_lo(w.x); f[1] = bf_hi(w.x); f[2] = bf_lo(w.y); f[3] = bf_hi(w.y); f[4] = bf_lo(w.z); f[5] = bf_hi(w.z); f[6] = bf_lo(w.w); f[7] = bf_hi(w.w); }
__device__ __forceinline__ u32x4 pack8(const float (&f)[8]) { u32x4 w; w.x = cvt_pk_bf16(f[0], f[1]); w.y = cvt_pk_bf16(f[2], f[3]); w.z = cvt_pk_bf16(f[4], f[5]); w.w = cvt_pk_bf16(f[6], f[7]); return w; }

struct EpiProj {
    static constexpr bool PERM = true, AFTER_DRAIN = false;
    bf16_t* PA; bf16_t* GT; float qscale;
    __device__ __forceinline__ void operator()(const f32x4 (&acc)[2][2][4][2], const Unit& u, int wr, int wc, int fr, int fq) const {
        const int row0 = u.pm * BM + wr * 64 + fr; bf16_t* base; int ldc, colt; float sc = 1.f;
        if (u.pn < 10) { base = PA; ldc = 2560; colt = u.pn * BM; if (u.pn == 6 || u.pn == 7) sc = qscale; } else { base = GT; ldc = 2048; colt = (u.pn - 10) * BM; }
        const int col0 = colt + wc * 32 + 8 * fq;
#pragma unroll
        for (int ai = 0; ai < 2; ++ai)
#pragma unroll
            for (int m = 0; m < 4; ++m) { bf16_t* rowp = base + (size_t)(row0 + ai * HALF + m * 16) * ldc + col0;
#pragma unroll
                for (int bj = 0; bj < 2; ++bj) { const f32x4 v0 = acc[ai][bj][m][0] * sc, v1 = acc[ai][bj][m][1] * sc;
                    u32x4 w; w.x = cvt_pk_bf16(v0[0], v0[1]); w.y = cvt_pk_bf16(v0[2], v0[3]); w.z = cvt_pk_bf16(v1[0], v1[1]); w.w = cvt_pk_bf16(v1[2], v1[3]);
                    *(u32x4*)(rowp + bj * HALF) = w; } }
    }
};
struct EpiPlain {
    static constexpr bool PERM = true, AFTER_DRAIN = false;
    bf16_t* O; int ldc;
    __device__ __forceinline__ void operator()(const f32x4 (&acc)[2][2][4][2], const Unit& u, int wr, int wc, int fr, int fq) const {
        const int row0 = u.pm * BM + wr * 64 + fr, col0 = u.pn * BM + wc * 32 + 8 * fq;
#pragma unroll
        for (int ai = 0; ai < 2; ++ai)
#pragma unroll
            for (int m = 0; m < 4; ++m) { bf16_t* rowp = O + (size_t)(row0 + ai * HALF + m * 16) * ldc + col0;
#pragma unroll
                for (int bj = 0; bj < 2; ++bj) { const f32x4 v0 = acc[ai][bj][m][0], v1 = acc[ai][bj][m][1];
                    u32x4 w; w.x = cvt_pk_bf16(v0[0], v0[1]); w.y = cvt_pk_bf16(v0[2], v0[3]); w.z = cvt_pk_bf16(v1[0], v1[1]); w.w = cvt_pk_bf16(v1[2], v1[3]);
                    *(u32x4*)(rowp + bj * HALF) = w; } }
    }
};
struct EpiSwiGLU {
    static constexpr bool PERM = true, AFTER_DRAIN = false;
    bf16_t* O; int ldc;
    __device__ __forceinline__ void operator()(const f32x4 (&acc)[2][2][4][2], const Unit& u, int wr, int wc, int fr, int fq) const {
        const int row0 = u.pm * BM + wr * 64 + fr, col0 = u.pn * HALF + wc * 32 + 8 * fq;
#pragma unroll
        for (int ai = 0; ai < 2; ++ai)
#pragma unroll
            for (int m = 0; m < 4; ++m) { bf16_t* rowp = O + (size_t)(row0 + ai * HALF + m * 16) * ldc + col0;
                float o[8];
#pragma unroll
                for (int n = 0; n < 2; ++n)
#pragma unroll
                    for (int i = 0; i < 4; ++i) { const float g = acc[ai][0][m][n][i], up = acc[ai][1][m][n][i]; o[4 * n + i] = g * sigmoidf_fast(g) * up; }
                *(u32x4*)rowp = pack8(o); }
    }
};
struct EpiGateA {
    static constexpr bool PERM = true, AFTER_DRAIN = false;
    const bf16_t* GT; bf16_t* TMP;
    __device__ __forceinline__ void operator()(const f32x4 (&acc)[2][2][4][2], const Unit& u, int wr, int wc, int fr, int fq) const {
        const int row0 = u.pm * BM + wr * 64 + fr, col0 = u.pn * BM + wc * 32 + 8 * fq;
#pragma unroll
        for (int ai = 0; ai < 2; ++ai)
#pragma unroll
            for (int m = 0; m < 4; ++m) { const size_t r = (size_t)(row0 + ai * HALF + m * 16);
#pragma unroll
                for (int bj = 0; bj < 2; ++bj) { const int c = col0 + bj * HALF;
                    float g[8], o[8]; unpack8(*(const u32x4*)(GT + r * 2048 + c), g);
#pragma unroll
                    for (int n = 0; n < 2; ++n)
#pragma unroll
                        for (int i = 0; i < 4; ++i) o[4 * n + i] = sigmoidf_fast(g[4 * n + i]) * acc[ai][bj][m][n][i];
                    *(u32x4*)(TMP + r * 1024 + c) = pack8(o); } }
    }
};
struct EpiGateB {
    static constexpr bool PERM = true, AFTER_DRAIN = false;
    const bf16_t* GT; const bf16_t* TMP; bf16_t* MIX;
    __device__ __forceinline__ void operator()(const f32x4 (&acc)[2][2][4][2], const Unit& u, int wr, int wc, int fr, int fq) const {
        const int row0 = u.pm * BM + wr * 64 + fr, col0 = u.pn * BM + wc * 32 + 8 * fq;
#pragma unroll
        for (int ai = 0; ai < 2; ++ai)
#pragma unroll
            for (int m = 0; m < 4; ++m) { const size_t r = (size_t)(row0 + ai * HALF + m * 16);
#pragma unroll
                for (int bj = 0; bj < 2; ++bj) { const int c = col0 + bj * HALF;
                    float g[8], t[8], o[8]; unpack8(*(const u32x4*)(GT + r * 2048 + 1024 + c), g); unpack8(*(const u32x4*)(TMP + r * 1024 + c), t);
#pragma unroll
                    for (int n = 0; n < 2; ++n)
#pragma unroll
                        for (int i = 0; i < 4; ++i) o[4 * n + i] = t[4 * n + i] + sigmoidf_fast(g[4 * n + i]) * acc[ai][bj][m][n][i];
                    *(u32x4*)(MIX + r * 1024 + c) = pack8(o); } }
    }
};
struct EpiRes {
    static constexpr bool PERM = false, AFTER_DRAIN = false;
    const float* base; float* out; int ldc;
    __device__ __forceinline__ void operator()(const f32x4 (&acc)[2][2][4][2], const Unit& u, int wr, int wc, int fr, int fq) const {
        const int row0 = u.pm * BM + wr * 64 + fr, col0 = u.pn * BM + wc * 32 + 4 * fq;
#pragma unroll
        for (int ai = 0; ai < 2; ++ai)
#pragma unroll
            for (int m = 0; m < 4; ++m) { const size_t off = (size_t)(row0 + ai * HALF + m * 16) * ldc + col0;
#pragma unroll
                for (int bj = 0; bj < 2; ++bj)
#pragma unroll
                    for (int n = 0; n < 2; ++n) { const f32x4 b = *(const f32x4*)(base + off + bj * HALF + n * 16); *(f32x4*)(out + off + bj * HALF + n * 16) = b + acc[ai][bj][m][n]; } }
    }
};
struct MoeOrder : StaticOrder {
    const volatile PG8_LAS unsigned* offs; int ntn;
    __device__ __forceinline__ bool next(int i, Unit& u) const {
        if (!StaticOrder::next(i, u)) return false;
        const unsigned row = (unsigned)u.pm * BM; int e = 0;
#pragma unroll
        for (int k = 1; k < 8; ++k) e += (row >= offs[k]) ? 1 : 0;
        u.pb = e * ntn + u.pn; return true;
    }
};
template <class Epi, class Sched, bool ALIGN_EPI = false, bool SP2 = false>
__device__ __forceinline__ void gemm_phase(PG8_LAS unsigned char* lds, const Gemm g, const Sched& S, const Epi& E, const int tid) {
    const int wid = __builtin_amdgcn_readfirstlane(tid >> 6), lane = tid & 63, wr = wid >> 2, wc = wid & 3, fr = lane & 15, fq = lane >> 4;
    const int K = g.K, nt = K / BK;
    unsigned voffA[2], voffB[2];
#pragma unroll
    for (int i = 0; i < 2; ++i) { int R, C; stage_rc(tid * 16 + i * 8192, R, C); const int Rb = Epi::PERM ? ((R & ~31) + perm32(R & 31)) : R;
        voffA[i] = (unsigned)(R * K + C) * 2u; voffB[i] = (unsigned)(Rb * K + C) * 2u; }
    const size_t kstep = (size_t)(BK * 2);
    const size_t hstep = (size_t)HALF * K * 2;
    const size_t tstep = 2 * hstep;
    const unsigned ldsw = (unsigned)wid * 1024u;
    const int aoff = lds_byte(wr * 64 + fr, fq * 8), boff = lds_byte(wc * 32 + fr, fq * 8);
#define PG8_SA(b, h) (((b) * 2 + (h)) * HTB)
#define PG8_SB(b, h) ((4 + (b) * 2 + (h)) * HTB)
#define PG8_STAGE(bufoff, gbase, voff) do { _Pragma("unroll") for (int _i = 0; _i < 2; ++_i) \
        __builtin_amdgcn_global_load_lds((const unsigned*)((const char*)(gbase) + (voff)[_i]), (PG8_LAS unsigned*)(lds + (bufoff) + ldsw + _i * 8192), 16, 0, 0); } while (0)
#define PG8_LDA(dst, b, h) do { _Pragma("unroll") for (int m = 0; m < 4; ++m) _Pragma("unroll") for (int k = 0; k < 2; ++k) dst[m][k] = *(const PG8_LAS bf16x8*)(lds + PG8_SA(b, h) + aoff + m * 2048 + k * 1024); } while (0)
#define PG8_LDB(dst, b, h) do { _Pragma("unroll") for (int n = 0; n < 2; ++n) _Pragma("unroll") for (int k = 0; k < 2; ++k) dst[n][k] = *(const PG8_LAS bf16x8*)(lds + PG8_SB(b, h) + boff + n * 2048 + k * 1024); } while (0)
#define PG8_MMA(ai, bj, At, Bt) do { __builtin_amdgcn_s_setprio(1); _Pragma("unroll") for (int m = 0; m < 4; ++m) _Pragma("unroll") for (int n = 0; n < 2; ++n) _Pragma("unroll") for (int k = 0; k < 2; ++k) \
        acc[ai][bj][m][n] = __builtin_amdgcn_mfma_f32_16x16x32_bf16(Bt[n][k], At[m][k], acc[ai][bj][m][n], 0, 0, 0); __builtin_amdgcn_s_setprio(0); } while (0)
#define PG8_WAIT_V(n) asm volatile("s_waitcnt vmcnt(" #n ")" ::: "memory")
#define PG8_WAIT_L(n) asm volatile("s_waitcnt lgkmcnt(" #n ")" ::: "memory")
#define PG8_BAR __builtin_amdgcn_s_barrier()
#define PG8_SCHED __builtin_amdgcn_sched_barrier(0)
    Unit cur, nxt; int ui = 0;
    if (!S.next(0, cur)) return;
    f32x4 acc[2][2][4][2];
#pragma unroll
    for (int a = 0; a < 2; ++a)
#pragma unroll
        for (int b = 0; b < 2; ++b)
#pragma unroll
            for (int m = 0; m < 4; ++m)
#pragma unroll
                for (int n = 0; n < 2; ++n) acc[a][b][m][n] = (f32x4){0.f, 0.f, 0.f, 0.f};
    bf16x8 At[4][2], B0[2][2], B1[2][2];
    const char* cA = (const char*)g.A + (size_t)cur.pm * tstep; const char* cB = (const char*)g.Bt + (size_t)cur.pb * tstep;
    S.a_ready(cur);
    if constexpr (SP2) {
        PG8_STAGE(PG8_SB(0, 0), cB, voffB); PG8_STAGE(PG8_SB(0, 1), cB + hstep, voffB); PG8_STAGE(PG8_SA(0, 0), cA, voffA); PG8_STAGE(PG8_SA(0, 1), cA + hstep, voffA);
        if (wr == 1) PG8_BAR;
        PG8_WAIT_V(2); PG8_BAR;
        PG8_STAGE(PG8_SB(1, 0), cB + kstep, voffB); PG8_STAGE(PG8_SA(1, 0), cA + kstep, voffA); PG8_STAGE(PG8_SB(1, 1), cB + hstep + kstep, voffB);
        PG8_WAIT_V(6); PG8_BAR;
    } else {
        PG8_STAGE(PG8_SB(0, 0), cB, voffB); PG8_STAGE(PG8_SA(0, 0), cA, voffA); PG8_STAGE(PG8_SB(0, 1), cB + hstep, voffB); PG8_STAGE(PG8_SA(0, 1), cA + hstep, voffA);
        if (wr == 1) PG8_BAR;
        PG8_WAIT_V(4); PG8_BAR;
        PG8_STAGE(PG8_SB(1, 0), cB + kstep, voffB); PG8_STAGE(PG8_SA(1, 0), cA + kstep, voffA); PG8_STAGE(PG8_SB(1, 1), cB + hstep + kstep, voffB);
        PG8_WAIT_V(6); PG8_BAR;
    }
    for (;;) {
        const bool has_next = S.next(ui + 1, nxt);
        const char* nA = has_next ? (const char*)g.A + (size_t)nxt.pm * tstep : cA; const char* nB = has_next ? (const char*)g.Bt + (size_t)nxt.pb * tstep : cB;
        for (int t = 0; t < nt; t += 2) {
            const bool last = (t == nt - 2);
            const char* a1 = cA + (size_t)(t + 1) * kstep;
            const char* a2 = last ? nA : cA + (size_t)(t + 2) * kstep; const char* b2 = last ? nB : cB + (size_t)(t + 2) * kstep;
            const char* a3 = a2 + kstep; const char* b3 = b2 + kstep;
            if (last && has_next) S.a_ready(nxt);
            if constexpr (SP2) {
            PG8_LDB(B0, 0, 0); PG8_LDB(B1, 0, 1); PG8_SCHED; PG8_LDA(At, 0, 0); PG8_STAGE(PG8_SA(1, 1), a1 + hstep, voffA);
            PG8_WAIT_V(8); PG8_WAIT_L(0); PG8_BAR; PG8_MMA(0, 0, At, B0); PG8_MMA(0, 1, At, B1); PG8_BAR; PG8_SCHED;
            PG8_LDA(At, 0, 1); PG8_STAGE(PG8_SB(0, 0), b2, voffB); PG8_STAGE(PG8_SB(0, 1), b2 + hstep, voffB); PG8_STAGE(PG8_SA(0, 0), a2, voffA);
            PG8_WAIT_V(8); PG8_WAIT_L(0); PG8_BAR; PG8_MMA(1, 0, At, B0); PG8_MMA(1, 1, At, B1); PG8_BAR; PG8_SCHED;
            PG8_LDB(B0, 1, 0); PG8_LDB(B1, 1, 1); PG8_SCHED; PG8_LDA(At, 1, 0); PG8_STAGE(PG8_SA(0, 1), a2 + hstep, voffA);
            PG8_WAIT_V(8); PG8_WAIT_L(0); PG8_BAR; PG8_MMA(0, 0, At, B0); PG8_MMA(0, 1, At, B1); PG8_BAR; PG8_SCHED;
            PG8_LDA(At, 1, 1); PG8_STAGE(PG8_SB(1, 0), b3, voffB); PG8_STAGE(PG8_SB(1, 1), b3 + hstep, voffB); PG8_STAGE(PG8_SA(1, 0), a3, voffA);
            PG8_WAIT_V(8); PG8_WAIT_L(0); PG8_BAR; PG8_MMA(1, 0, At, B0); PG8_MMA(1, 1, At, B1); PG8_BAR; PG8_SCHED;
            } else {
            PG8_LDB(B0, 0, 0); PG8_SCHED; PG8_LDA(At, 0, 0); PG8_STAGE(PG8_SA(1, 1), a1 + hstep, voffA);
            PG8_WAIT_L(8); PG8_BAR; PG8_WAIT_L(0); PG8_MMA(0, 0, At, B0); PG8_BAR; PG8_SCHED;
            PG8_LDB(B1, 0, 1); PG8_STAGE(PG8_SB(0, 0), b2, voffB);
            PG8_BAR; PG8_WAIT_L(0); PG8_MMA(0, 1, At, B1); PG8_BAR;
            PG8_LDA(At, 0, 1); PG8_STAGE(PG8_SA(0, 0), a2, voffA);
            PG8_BAR; PG8_WAIT_L(0); PG8_MMA(1, 0, At, B0); PG8_BAR; PG8_SCHED;
            PG8_STAGE(PG8_SB(0, 1), b2 + hstep, voffB);
            PG8_WAIT_V(6); PG8_BAR; PG8_MMA(1, 1, At, B1); PG8_BAR;
            PG8_LDB(B0, 1, 0); PG8_SCHED; PG8_LDA(At, 1, 0); PG8_STAGE(PG8_SA(0, 1), a2 + hstep, voffA);
            PG8_WAIT_L(8); PG8_BAR; PG8_WAIT_L(0); PG8_MMA(0, 0, At, B0); PG8_BAR; PG8_SCHED;
            PG8_LDB(B1, 1, 1); PG8_STAGE(PG8_SB(1, 0), b3, voffB);
            PG8_BAR; PG8_WAIT_L(0); PG8_MMA(0, 1, At, B1); PG8_BAR;
            PG8_LDA(At, 1, 1); PG8_STAGE(PG8_SA(1, 0), a3, voffA);
            PG8_BAR; PG8_WAIT_L(0); PG8_MMA(1, 0, At, B0); PG8_BAR; PG8_SCHED;
            PG8_STAGE(PG8_SB(1, 1), b3 + hstep, voffB);
            PG8_WAIT_V(6); PG8_BAR; PG8_MMA(1, 1, At, B1); PG8_BAR;
            }
        }
        if constexpr (ALIGN_EPI) { if (wr == 0) PG8_BAR; }
        if constexpr (!Epi::AFTER_DRAIN) { E(acc, cur, wr, wc, fr, fq); S.done(cur); }
        if (!has_next) break;
#pragma unroll
        for (int a = 0; a < 2; ++a)
#pragma unroll
            for (int b = 0; b < 2; ++b)
#pragma unroll
                for (int m = 0; m < 4; ++m)
#pragma unroll
                    for (int n = 0; n < 2; ++n) acc[a][b][m][n] = (f32x4){0.f, 0.f, 0.f, 0.f};
        cur = nxt; cA = nA; cB = nB; ++ui;
        if constexpr (ALIGN_EPI) { if (wr == 1) PG8_BAR; }
    }
    PG8_WAIT_V(0);
    if constexpr (!ALIGN_EPI) { if (wr == 0) PG8_BAR; }
    PG8_BAR;
    if constexpr (Epi::AFTER_DRAIN) { E.fused(acc, cur, wr, wc, fr, fq, lds, wid, lane); S.done(cur); }
#undef PG8_SA
#undef PG8_SB
#undef PG8_STAGE
#undef PG8_LDA
#undef PG8_LDB
#undef PG8_MMA
#undef PG8_WAIT_V
#undef PG8_WAIT_L
#undef PG8_BAR
#undef PG8_SCHED
}
}
#define GAS __attribute__((address_space(1)))
#define LAS __attribute__((address_space(3)))
typedef unsigned short bf16;
typedef unsigned v4u __attribute__((ext_vector_type(4)));
typedef float f32x4 __attribute__((ext_vector_type(4)));
typedef short bf16x8 __attribute__((ext_vector_type(8)));
typedef GAS unsigned gu32;
typedef GAS unsigned long long gu64;
#define RLX_AGENT __ATOMIC_RELAXED, __HIP_MEMORY_SCOPE_AGENT
#define LDS_WAIT() asm volatile("s_waitcnt lgkmcnt(0)" ::: "memory")
#define VM_WAIT() asm volatile("s_waitcnt vmcnt(0)" ::: "memory")
__device__ __forceinline__ unsigned long long rt() { return __builtin_amdgcn_s_memrealtime(); }
__device__ __forceinline__ unsigned f2bf(float f) { unsigned u = __builtin_bit_cast(unsigned, f); return (u + 0x7fffu + ((u >> 16) & 1u)) >> 16; }
__device__ __forceinline__ unsigned pk2(float lo, float hi) { return f2bf(lo) | (f2bf(hi) << 16); }

#define XB_TMO      128
#define XB_XCNT(j)  (256  + 64 * (j))
#define XB_XSUB(j)  (1280 + 64 * (j))
#define XB_XGEN(j)  (2304 + 64 * (j))
#define XB_TOP      3328
#define XB_TOPGEN   3392
#define XCD_BAR_WORDS 3456
#define XB_SPIN_CAP (1u << 18)

__device__ __forceinline__ unsigned xb_ld(unsigned* p)              { return __hip_atomic_load(p, __ATOMIC_RELAXED, __HIP_MEMORY_SCOPE_AGENT); }
__device__ __forceinline__ unsigned xb_add(unsigned* p, unsigned v) { return __hip_atomic_fetch_add(p, v, __ATOMIC_RELAXED, __HIP_MEMORY_SCOPE_AGENT); }
__device__ __forceinline__ unsigned xb_xcc_id() { return (unsigned)__builtin_amdgcn_s_getreg((3 << 11) | 20) & 0xFu; }
#define XB_SPIN(cond, bar) do { unsigned _sp = 0; while (cond) { __builtin_amdgcn_s_sleep(1); \
    if ((++_sp & 255u) == 0u) { if (xb_ld(&(bar)[XB_TMO])) break; if (_sp > XB_SPIN_CAP) { atomicAdd(&(bar)[XB_TMO], 1u); break; } } } } while (0)

struct XcdBarrier {
    unsigned* bar; unsigned x;
    volatile LAS unsigned* st;
};

__device__ __forceinline__ XcdBarrier xcd_barrier_post(unsigned* bar, volatile LAS unsigned* st) {
    XcdBarrier b; b.bar = bar; b.x = xb_xcc_id(); b.st = st;
    if (threadIdx.x == 0) (void)xb_add(&bar[XB_XCNT(b.x)], 1u);
    return b;
}
__device__ __forceinline__ void xcd_barrier_complete(unsigned* bar, unsigned x, unsigned& nloc, unsigned& nx) {
    const unsigned G = gridDim.x * gridDim.y * gridDim.z;
    unsigned sum, cnt, mine, sp = 0u;
    for (;;) {
        sum = 0u; cnt = 0u; mine = 0u;
#pragma unroll
        for (unsigned j = 0; j < 16; ++j) { const unsigned c = xb_ld(&bar[XB_XCNT(j)]); sum += c; cnt += (c > 0u) ? 1u : 0u; mine = (j == x) ? c : mine; }
        if (sum == G) break;
        __builtin_amdgcn_s_sleep(1);
        if ((++sp & 255u) == 0u) { if (xb_ld(&bar[XB_TMO])) break; if (sp > XB_SPIN_CAP) { atomicAdd(&bar[XB_TMO], 1u); break; } }
    }
    nloc = mine > 0u ? mine : 1u; nx = cnt > 0u ? cnt : 1u;
}

__device__ __forceinline__ void xcd_barrier(const XcdBarrier& b) {
    asm volatile("s_waitcnt vmcnt(0)" ::: "memory");
    __syncthreads();
    if (threadIdx.x == 0) {
        unsigned* bar = b.bar;
        __builtin_amdgcn_s_waitcnt(0);
        unsigned nloc = b.st[0], nx = b.st[1];
        if (nloc == 0u) { xcd_barrier_complete(bar, b.x, nloc, nx); b.st[0] = nloc; b.st[1] = nx; }
        const unsigned old = xb_add(&bar[XB_XSUB(b.x)], 1u);
        const unsigned gen = old / nloc;
        if (old + 1u == (gen + 1u) * nloc) {
            __builtin_amdgcn_fence(__ATOMIC_RELEASE, "agent");
            asm volatile("s_waitcnt vmcnt(0)" ::: "memory");
            const unsigned og = xb_add(&bar[XB_TOP], 1u);
            const unsigned tg = og / nx;
            if (og + 1u == (tg + 1u) * nx) xb_add(&bar[XB_TOPGEN], 1u);
            else XB_SPIN(xb_ld(&bar[XB_TOPGEN]) == tg, bar);
            __builtin_amdgcn_fence(__ATOMIC_ACQUIRE, "agent");
            xb_add(&bar[XB_XGEN(b.x)], 1u);
            asm volatile("s_waitcnt vmcnt(0)" ::: "memory");
        } else {
            XB_SPIN(xb_ld(&bar[XB_XGEN(b.x)]) == gen, bar);
            __builtin_amdgcn_fence(__ATOMIC_ACQUIRE, "agent");
            asm volatile("s_waitcnt vmcnt(0)" ::: "memory");
        }
    }
    __syncthreads();
}

constexpr int NWAVES = 8;
constexpr int BATCH = 8, SEQ = 4096, D = 1024, T = BATCH * SEQ, DEPTH = 2;
constexpr int DCONV = 512, NHEAD = 8, HD = 64, DATTN = 512, DFF = 2816, NEXP = 8, DFFE = 2048;
constexpr int NIN = 5120, NPA = 2560, NGT = 2048, NPROJ = NPA + NGT;
constexpr float EPS = 1e-6f;
constexpr float QSCALE = 0.125f * 1.4426950408889634f;
constexpr int MPAD = 2 * T + NEXP * 256;

constexpr size_t MiB = 1u << 20;
constexpr size_t WS_CTL = 0, CTL_ZERO_BYTES = 1 * MiB;
constexpr size_t WS_ROUTE = 1 * MiB;
constexpr size_t WS_SLOTS = WS_ROUTE + 512 * 1024, WS_WGCNT = WS_ROUTE + 768 * 1024;
constexpr size_t WS_WL = 4 * MiB, WL_STRIDE = 14 * MiB;
constexpr size_t WL_WIN = 0, WL_WV = 9 * MiB, WL_WA = 10 * MiB, WL_WB = 11 * MiB, WL_WO = 12 * MiB;
constexpr size_t WS_WGU = 32 * MiB, WS_WD = 43 * MiB;
constexpr size_t WS_H = 50 * MiB;
constexpr size_t WS_UA = WS_H, WS_UB = WS_H + 32 * MiB;
constexpr size_t WS_VT = 114 * MiB;
constexpr size_t WS_GT = 146 * MiB;
constexpr size_t WS_PA = 274 * MiB;
constexpr size_t WS_TMP = 274 * MiB, WS_MIX = 338 * MiB;
constexpr size_t WS_G0 = 146 * MiB;
constexpr size_t WS_WEG = 4 * MiB, WS_WED = 68 * MiB;
constexpr size_t WS_HP = 100 * MiB;
constexpr size_t WS_G1 = 232 * MiB;
constexpr size_t WS_END = 512 * MiB;
static_assert(WS_G1 + (size_t)MPAD * DFFE * 2 <= WS_END && WS_HP + (size_t)MPAD * D * 2 <= WS_G1 && WS_PA + (size_t)T * NPA * 2 <= WS_END, "d_ws map");
constexpr int CW_TMO = 0, CW_CODE = 1, CW_BAR = 4096, CW_CNT = 8192;

constexpr int RING_OFF = 0, RING_BYTES = 131072, LDSCTL_OFF = RING_BYTES, MISC_OFF = LDSCTL_OFF + 320, LDS_BYTES = 147456;

typedef unsigned u32x2v __attribute__((ext_vector_type(2)));
__device__ __forceinline__ float wave_sum(float v) {
#pragma unroll
    for (int o = 1; o < 64; o <<= 1) v += __shfl_xor(v, o);
    return v;
}
using pg8::cvt_pk_bf16;
__device__ __forceinline__ void tr_block(const float* W, int K, int N, bf16* dst, int drow, int k0, int n0, LAS float* scr, int lane) {
#pragma unroll 8
    for (int i = 0; i < 32; ++i) { const int kk = 2 * i + (lane >> 5); scr[kk * 33 + (lane & 31)] = W[(size_t)(k0 + kk) * N + n0 + (lane & 31)]; }
    LDS_WAIT(); asm volatile("" ::: "memory");
    const int c = lane & 7;
#pragma unroll
    for (int j = 0; j < 4; ++j) { const int n = (lane >> 3) + 8 * j; const LAS float* s = scr + (8 * c) * 33 + n;
        v4u o; o.x = cvt_pk_bf16(s[0 * 33], s[1 * 33]); o.y = cvt_pk_bf16(s[2 * 33], s[3 * 33]); o.z = cvt_pk_bf16(s[4 * 33], s[5 * 33]); o.w = cvt_pk_bf16(s[6 * 33], s[7 * 33]);
        *(GAS v4u*)(dst + (size_t)(drow + n) * K + k0 + 8 * c) = o; }
    LDS_WAIT(); asm volatile("" ::: "memory");
}
template <int KIND> __device__ __forceinline__ void tr_item(const float* W, int K, int N, bf16* dst, bf16* dst2, LAS float* scr, int item, int lane) {
    const int nblk = N / 32, kb = item / nblk, nb = item % nblk, k0 = 64 * kb, n0 = 32 * nb;
    bf16* d = dst; int drow = n0;
    if (KIND == 1) { if (n0 >= 3072) drow = n0 - 512; else if (n0 >= 2560) { d = dst2; drow = n0 - 2560; } }
    if (KIND == 2) drow = 256 * (n0 / 128) + (n0 % 128);
    if (KIND == 3) drow = 256 * (n0 / 128) + 128 + (n0 % 128);
    tr_block(W, K, N, d, drow, k0, n0, scr, lane);
}
__device__ __forceinline__ void rms_row_to_bf16(const float* xrow, const float* g, bf16* orow, int lane) {
    const GAS f32x4* xr = (const GAS f32x4*)xrow + lane; const GAS f32x4* gr = (const GAS f32x4*)g + lane;
    f32x4 v[4]; float s = 0.f;
#pragma unroll
    for (int j = 0; j < 4; ++j) { v[j] = xr[64 * j]; s += (v[j].x * v[j].x + v[j].y * v[j].y) + (v[j].z * v[j].z + v[j].w * v[j].w); }
    const float rstd = 1.0f / sqrtf(wave_sum(s) * (1.f / D) + EPS);
    GAS u32x2v* o8 = (GAS u32x2v*)orow + lane;
#pragma unroll
    for (int j = 0; j < 4; ++j) { const f32x4 gg = gr[64 * j]; u32x2v w; w.x = cvt_pk_bf16(v[j].x * rstd * gg.x, v[j].y * rstd * gg.y); w.y = cvt_pk_bf16(v[j].z * rstd * gg.z, v[j].w * rstd * gg.w); o8[64 * j] = w; }
}
__device__ __forceinline__ void unpack8f(const v4u w, float (&f)[8]) {
    f[0] = __builtin_bit_cast(float, w.x << 16); f[1] = __builtin_bit_cast(float, w.x & 0xffff0000u); f[2] = __builtin_bit_cast(float, w.y << 16); f[3] = __builtin_bit_cast(float, w.y & 0xffff0000u);
    f[4] = __builtin_bit_cast(float, w.z << 16); f[5] = __builtin_bit_cast(float, w.z & 0xffff0000u); f[6] = __builtin_bit_cast(float, w.w << 16); f[7] = __builtin_bit_cast(float, w.w & 0xffff0000u);
}
__device__ __forceinline__ v4u pack8f(const float (&f)[8]) { v4u w; w.x = cvt_pk_bf16(f[0], f[1]); w.y = cvt_pk_bf16(f[2], f[3]); w.z = cvt_pk_bf16(f[4], f[5]); w.w = cvt_pk_bf16(f[6], f[7]); return w; }

__device__ __forceinline__ void conv_phase(const bf16* PA, const float* cw, bf16* UA, int gid, int nthr) {
    for (int it = gid; it < (T / 16) * 64; it += nthr) {
        const int cg = it & 63, t0 = (it >> 6) * 16, c0 = cg * 8;
        float w0[8], w1[8], w2[8];
#pragma unroll
        for (int i = 0; i < 8; ++i) { w0[i] = cw[c0 + i]; w1[i] = cw[DCONV + c0 + i]; w2[i] = cw[2 * DCONV + c0 + i]; }
        float um2[8], um1[8];
        if ((t0 & (SEQ - 1)) == 0) {
#pragma unroll
            for (int i = 0; i < 8; ++i) { um2[i] = 0.f; um1[i] = 0.f; }
        } else {
            float a[8], b[8];
            unpack8f(*(const GAS v4u*)(PA + (size_t)(t0 - 2) * NPA + c0), a); unpack8f(*(const GAS v4u*)(PA + (size_t)(t0 - 2) * NPA + 1024 + c0), b);
#pragma unroll
            for (int i = 0; i < 8; ++i) um2[i] = a[i] * b[i];
            unpack8f(*(const GAS v4u*)(PA + (size_t)(t0 - 1) * NPA + c0), a); unpack8f(*(const GAS v4u*)(PA + (size_t)(t0 - 1) * NPA + 1024 + c0), b);
#pragma unroll
            for (int i = 0; i < 8; ++i) um1[i] = a[i] * b[i];
        }
#pragma unroll 4
        for (int r = 0; r < 16; ++r) {
            const bf16* row = PA + (size_t)(t0 + r) * NPA + c0;
            float xin[8], bg[8], cgv[8], o[8];
            unpack8f(*(const GAS v4u*)(row), xin); unpack8f(*(const GAS v4u*)(row + 512), bg); unpack8f(*(const GAS v4u*)(row + 1024), cgv);
#pragma unroll
            for (int i = 0; i < 8; ++i) { const float u = cgv[i] * xin[i]; o[i] = bg[i] * (w0[i] * um2[i] + w1[i] * um1[i] + w2[i] * u); um2[i] = um1[i]; um1[i] = u; }
            *(GAS v4u*)(UA + (size_t)(t0 + r) * DCONV + c0) = pack8f(o);
        }
    }
}

__device__ __forceinline__ void attn_naive(const bf16* PA, const bf16* VT, bf16* UB, int gid, int nthr) {
#pragma unroll 1
    for (int idx4 = gid; idx4 < T * NHEAD * 4; idx4 += nthr) {
        const int part = idx4 & 3, idx = idx4 >> 2;
        const int t = idx & (SEQ - 1), bh = idx >> 12, h = bh & 7, b = bh >> 3;
        const size_t row = (size_t)b * SEQ + t;
        float q[16], o[16];
#pragma unroll
        for (int c = 0; c < 2; ++c) { float f[8]; unpack8f(*(const GAS v4u*)(PA + row * NPA + 1536 + h * 64 + part * 16 + c * 8), f);
#pragma unroll
            for (int i = 0; i < 8; ++i) { q[c * 8 + i] = f[i]; o[c * 8 + i] = 0.f; } }
        float R = 1.f;
#pragma unroll 1
        for (int kb = (t - 1) >> 3; kb >= 0 && t > 0; --kb) {
            float rr[8];
#pragma unroll
            for (int j = 0; j < 8; ++j) {
                const int key = kb * 8 + j;
                const bf16* kr = PA + ((size_t)b * SEQ + key) * NPA + 2048 + h * 64 + part * 16; float z = 0.f;
#pragma unroll
                for (int c = 0; c < 2; ++c) { float f[8]; unpack8f(*(const GAS v4u*)(kr + c * 8), f);
#pragma unroll
                    for (int i = 0; i < 8; ++i) z += q[c * 8 + i] * f[i]; }
                z += __shfl_xor(z, 1); z += __shfl_xor(z, 2);
                rr[j] = (key < t) ? __builtin_amdgcn_rcpf(1.0f + __builtin_amdgcn_exp2f(z)) : 1.f;
            }
            float a[8];
#pragma unroll
            for (int j = 7; j >= 0; --j) { const float Rn = R * rr[j]; a[j] = R - Rn; R = Rn; }
            const bf16* vp = VT + (size_t)(h * 64 + part * 16) * T + (size_t)b * SEQ + kb * 8;
#pragma unroll
            for (int d = 0; d < 16; ++d) { float f[8]; unpack8f(*(const GAS v4u*)(vp + (size_t)d * T), f); float s = 0.f;
#pragma unroll
                for (int j = 0; j < 8; ++j) s += a[j] * f[j];
                o[d] += s; }
            if (R == 0.f) break;
        }
#pragma unroll
        for (int c = 0; c < 2; ++c) { float f[8];
#pragma unroll
            for (int i = 0; i < 8; ++i) f[i] = o[c * 8 + i];
            *(GAS v4u*)(UB + row * DATTN + h * 64 + part * 16 + c * 8) = pack8f(f); }
    }
}

typedef float f32x16 __attribute__((ext_vector_type(16)));
__device__ __forceinline__ void attn_mfma(const bf16* PA, const bf16* VT, bf16* UB, int gw, int NGW, int lane) {
    const int q = lane & 31, hh = lane >> 5;
    const int kperm = (q & 19) | ((q & 4) << 1) | ((q & 8) >> 1);
#pragma unroll 1
    for (int u = gw; u < BATCH * NHEAD * (SEQ / 32); u += NGW) {
        const int qb = u & 127, bh = u >> 7, h = bh & 7, b = bh >> 3;
        const size_t rowb = (size_t)b * SEQ;
        const bf16* qp = PA + (rowb + 32 * qb + q) * NPA + 1536 + h * 64 + hh * 8;
        bf16x8 qf[4];
#pragma unroll
        for (int d0 = 0; d0 < 4; ++d0) qf[d0] = *(const GAS bf16x8*)(qp + 16 * d0);
        const bf16* kbase = PA + (rowb + kperm) * NPA + 2048 + h * 64 + hh * 8;
        const bf16* vbase = VT + (size_t)(h * 64 + q) * T + rowb + hh * 8;
        f32x16 o0, o1;
#pragma unroll
        for (int r = 0; r < 16; ++r) { o0[r] = 0.f; o1[r] = 0.f; }
        float R = 1.f;
        bf16x8 kf[4], vf[4];
        {
            const bf16* kp = kbase + (size_t)(32 * qb) * NPA; const bf16* vp = vbase + 32 * qb;
#pragma unroll
            for (int d0 = 0; d0 < 4; ++d0) kf[d0] = *(const GAS bf16x8*)(kp + 16 * d0);
#pragma unroll
            for (int i = 0; i < 4; ++i) vf[i] = *(const GAS bf16x8*)(vp + (size_t)((i >> 1) * 32) * T + 16 * (i & 1));
        }
#pragma unroll 1
        for (int kb = qb; kb >= 0; --kb) {
            bf16x8 kn[4], vn[4];
            if (kb > 0) {
                const bf16* kp = kbase + (size_t)(32 * (kb - 1)) * NPA; const bf16* vp = vbase + 32 * (kb - 1);
#pragma unroll
                for (int d0 = 0; d0 < 4; ++d0) kn[d0] = *(const GAS bf16x8*)(kp + 16 * d0);
#pragma unroll
                for (int i = 0; i < 4; ++i) vn[i] = *(const GAS bf16x8*)(vp + (size_t)((i >> 1) * 32) * T + 16 * (i & 1));
            } else {
#pragma unroll
                for (int i = 0; i < 4; ++i) { kn[i] = kf[i]; vn[i] = vf[i]; }
            }
            f32x16 p;
#pragma unroll
            for (int r = 0; r < 16; ++r) p[r] = 0.f;
#pragma unroll
            for (int d0 = 0; d0 < 4; ++d0) p = __builtin_amdgcn_mfma_f32_32x32x16_bf16(kf[d0], qf[d0], p, 0, 0, 0);
            float rr[16];
            const bool diag = (kb == qb);
#pragma unroll
            for (int r = 0; r < 16; ++r) {
                float e = __builtin_amdgcn_exp2f(p[r]);
                if (diag) { const int kl = (r & 7) + 8 * hh + 16 * (r >> 3); e = (kl < q) ? e : 0.f; }
                rr[r] = __builtin_amdgcn_rcpf(1.0f + e);
            }
            bf16x8 af[2];
#pragma unroll
            for (int s = 1; s >= 0; --s) {
                float g = rr[8 * s];
#pragma unroll
                for (int j = 1; j < 8; ++j) g *= rr[8 * s + j];
                const auto sw = __builtin_amdgcn_permlane32_swap(__float_as_uint(g), __float_as_uint(g), false, false);
                const float g_lo = __uint_as_float(sw[0]), g_hi = __uint_as_float(sw[1]);
                float c = hh ? R : R * g_hi;
                float a[8];
#pragma unroll
                for (int j = 7; j >= 0; --j) { const float cn = c * rr[8 * s + j]; a[j] = c - cn; c = cn; }
                R = R * (g_lo * g_hi);
                typedef unsigned u4 __attribute__((ext_vector_type(4)));
                u4 w; w.x = cvt_pk_bf16(a[0], a[1]); w.y = cvt_pk_bf16(a[2], a[3]); w.z = cvt_pk_bf16(a[4], a[5]); w.w = cvt_pk_bf16(a[6], a[7]);
                af[s] = __builtin_bit_cast(bf16x8, w);
            }
            o0 = __builtin_amdgcn_mfma_f32_32x32x16_bf16(vf[0], af[0], o0, 0, 0, 0);
            o0 = __builtin_amdgcn_mfma_f32_32x32x16_bf16(vf[1], af[1], o0, 0, 0, 0);
            o1 = __builtin_amdgcn_mfma_f32_32x32x16_bf16(vf[2], af[0], o1, 0, 0, 0);
            o1 = __builtin_amdgcn_mfma_f32_32x32x16_bf16(vf[3], af[1], o1, 0, 0, 0);
            if (__builtin_amdgcn_ballot_w64(R != 0.f) == 0ull) break;
#pragma unroll
            for (int i = 0; i < 4; ++i) { kf[i] = kn[i]; vf[i] = vn[i]; }
        }
        bf16* op = UB + (rowb + 32 * qb + q) * DATTN + h * 64 + 4 * hh;
#pragma unroll
        for (int g4 = 0; g4 < 4; ++g4) {
            u32x2v w0, w1;
            w0.x = cvt_pk_bf16(o0[4 * g4], o0[4 * g4 + 1]); w0.y = cvt_pk_bf16(o0[4 * g4 + 2], o0[4 * g4 + 3]);
            w1.x = cvt_pk_bf16(o1[4 * g4], o1[4 * g4 + 1]); w1.y = cvt_pk_bf16(o1[4 * g4 + 2], o1[4 * g4 + 3]);
            *(GAS u32x2v*)(op + 8 * g4) = w0; *(GAS u32x2v*)(op + 32 + 8 * g4) = w1;
        }
    }
}

struct Args { const float* in[16]; float* out; unsigned char* ws; };
typedef const __attribute__((address_space(4))) Args* KArgP;
__device__ __forceinline__ KArgP launder_k(KArgP p) { asm volatile("" : "+s"(p)); return p; }
__device__ __forceinline__ int launder_s(int v) { asm volatile("" : "+s"(v)); return v; }
__device__ __forceinline__ int launder_v(int v) { asm volatile("" : "+v"(v)); return v; }
#define PH_BEGIN { const KArgP ap = launder_k(kp0); unsigned char* const ws = ap->ws; const int bx = launder_s(bx0), G = launder_s(G0); const int tid = launder_v(tid0), lane = tid & 63, wave = __builtin_amdgcn_readfirstlane(tid >> 6); \
    const int gid = bx * (NWAVES * 64) + tid, nthr = G * NWAVES * 64, gw = bx * NWAVES + wave, NGW = G * NWAVES; (void)gid; (void)nthr; (void)gw; (void)NGW; (void)lane; \
    LAS float* const scr = (LAS float*)(lds + RING_OFF + wave * 16384); (void)scr; (void)ws;
#define PH_END(BARRIER) if (BARRIER) xcd_barrier(bar); }
#define WSP(T_, off) ((T_*)(ws + (off)))

__global__ void __launch_bounds__(NWAVES * 64, 2) mega_fwd(Args args) {
    extern __shared__ __attribute__((aligned(16))) unsigned char lds_raw[];
    LAS unsigned char* const lds = (LAS unsigned char*)lds_raw;
    volatile LAS unsigned* const MISC = (volatile LAS unsigned*)(lds + MISC_OFF);
    const KArgP kp0 = (KArgP)__builtin_amdgcn_kernarg_segment_ptr();
    const int tid0 = threadIdx.x, G0 = gridDim.x, bx0 = blockIdx.x;
    for (int u = tid0; u < (LDS_BYTES - LDSCTL_OFF) / 4; u += NWAVES * 64) ((LAS unsigned*)(lds + LDSCTL_OFF))[u] = 0u;
    __syncthreads();
    XcdBarrier bar = xcd_barrier_post((unsigned*)(args.ws + WS_CTL) + CW_BAR, MISC + 8);

    PH_BEGIN
        constexpr int I_IN = 16 * 160, I_BR = 8 * 32, I_O = 16 * 32, I_GU = 16 * 88, I_D = 44 * 32;
        constexpr int PER_L = I_IN + 2 * I_BR + I_O, NITEMS = 2 * PER_L + 2 * I_GU + I_D;
#pragma unroll 1
        for (int it = gw; it < NITEMS; it += NGW) {
            int r = it;
            if (r < 2 * PER_L) {
                const int l = r / PER_L; r -= l * PER_L; unsigned char* wl = ws + WS_WL + (size_t)l * WL_STRIDE;
                if (r < I_IN) { tr_item<1>(ap->in[2] + (size_t)l * D * NIN, D, NIN, (bf16*)(wl + WL_WIN), (bf16*)(wl + WL_WV), scr, r, lane); continue; } r -= I_IN;
                if (r < I_BR) { tr_item<0>(ap->in[4] + (size_t)l * DCONV * D, DCONV, D, (bf16*)(wl + WL_WA), nullptr, scr, r, lane); continue; } r -= I_BR;
                if (r < I_BR) { tr_item<0>(ap->in[5] + (size_t)l * DATTN * D, DATTN, D, (bf16*)(wl + WL_WB), nullptr, scr, r, lane); continue; } r -= I_BR;
                tr_item<0>(ap->in[6] + (size_t)l * D * D, D, D, (bf16*)(wl + WL_WO), nullptr, scr, r, lane); continue;
            }
            r -= 2 * PER_L;
            if (r < I_GU) { tr_item<2>(ap->in[8], D, DFF, WSP(bf16, WS_WGU), nullptr, scr, r, lane); continue; } r -= I_GU;
            if (r < I_GU) { tr_item<3>(ap->in[9], D, DFF, WSP(bf16, WS_WGU), nullptr, scr, r, lane); continue; } r -= I_GU;
            tr_item<0>(ap->in[10], DFF, D, WSP(bf16, WS_WD), nullptr, scr, r, lane);
        }
#pragma unroll 1
        for (int m = gw; m < T; m += NGW) rms_row_to_bf16(ap->in[0] + (size_t)m * D, ap->in[1], WSP(bf16, WS_H) + (size_t)m * D, lane);
    PH_END(true)

#pragma unroll 1
    for (int l = 0; l < DEPTH; ++l) {
        PH_BEGIN
            unsigned char* wl = ws + WS_WL + (size_t)l * WL_STRIDE;
            pg8::Gemm g{WSP(bf16, WS_H), (const bf16*)(wl + WL_WIN), T, NPROJ, D}; pg8::StaticOrder S; S.init(T, NPROJ, G, bx);
            pg8::EpiProj E{WSP(bf16, WS_PA), WSP(bf16, WS_GT), QSCALE};
            pg8::gemm_phase<pg8::EpiProj, pg8::StaticOrder, true, true>(lds + RING_OFF, g, S, E, tid);
        PH_END(false)
        PH_BEGIN
            unsigned char* wl = ws + WS_WL + (size_t)l * WL_STRIDE;
            pg8::Gemm g{(const bf16*)(wl + WL_WV), WSP(bf16, WS_H), DATTN, T, D}; pg8::StaticOrder S; S.init(DATTN, T, G, bx);
            pg8::EpiPlain E{WSP(bf16, WS_VT), T};
            pg8::gemm_phase<pg8::EpiPlain, pg8::StaticOrder, true, true>(lds + RING_OFF, g, S, E, tid);
        PH_END(true)
        PH_BEGIN
            conv_phase(WSP(bf16, WS_PA), ap->in[3] + (size_t)l * 3 * DCONV, WSP(bf16, WS_UA), gid, nthr);
        PH_END(false)
        PH_BEGIN
            attn_mfma(WSP(bf16, WS_PA), WSP(bf16, WS_VT), WSP(bf16, WS_UB), gw, NGW, lane);
        PH_END(true)
        PH_BEGIN
            unsigned char* wl = ws + WS_WL + (size_t)l * WL_STRIDE;
            pg8::Gemm g{WSP(bf16, WS_UA), (const bf16*)(wl + WL_WA), T, D, DCONV}; pg8::StaticOrder S; S.init(T, D, G, bx);
            pg8::EpiGateA E{WSP(bf16, WS_GT), WSP(bf16, WS_TMP)};
            pg8::gemm_phase<pg8::EpiGateA, pg8::StaticOrder, true, true>(lds + RING_OFF, g, S, E, tid);
        PH_END(false)
        PH_BEGIN
            unsigned char* wl = ws + WS_WL + (size_t)l * WL_STRIDE;
            pg8::Gemm g{WSP(bf16, WS_UB), (const bf16*)(wl + WL_WB), T, D, DATTN}; pg8::StaticOrder S; S.init(T, D, G, bx);
            pg8::EpiGateB E{WSP(bf16, WS_GT), WSP(bf16, WS_TMP), WSP(bf16, WS_MIX)};
            pg8::gemm_phase<pg8::EpiGateB, pg8::StaticOrder, true, true>(lds + RING_OFF, g, S, E, tid);
        PH_END(true)
        PH_BEGIN
            unsigned char* wl = ws + WS_WL + (size_t)l * WL_STRIDE;
            pg8::Gemm g{WSP(bf16, WS_MIX), (const bf16*)(wl + WL_WO), T, D, D}; pg8::StaticOrder S; S.init(T, D, G, bx);
            pg8::EpiRes E{l == 0 ? ap->in[0] : (const float*)ap->out, ap->out, D};
            pg8::gemm_phase<pg8::EpiRes, pg8::StaticOrder, true, true>(lds + RING_OFF, g, S, E, tid);
        PH_END(true)
        if (l == 0) {
            PH_BEGIN
#pragma unroll 1
                for (int m = gw; m < T; m += NGW) rms_row_to_bf16(ap->out + (size_t)m * D, ap->in[7], WSP(bf16, WS_H) + (size_t)m * D, lane);
            PH_END(true)
            PH_BEGIN
                pg8::Gemm g{WSP(bf16, WS_H), WSP(bf16, WS_WGU), T, 2 * DFF, D}; pg8::StaticOrder S; S.init(T, 2 * DFF, G, bx);
                pg8::EpiSwiGLU E{WSP(bf16, WS_G0), DFF};
                pg8::gemm_phase<pg8::EpiSwiGLU, pg8::StaticOrder, true, true>(lds + RING_OFF, g, S, E, tid);
            PH_END(true)
            PH_BEGIN
                pg8::Gemm g{WSP(bf16, WS_G0), WSP(bf16, WS_WD), T, D, DFF}; pg8::StaticOrder S; S.init(T, D, G, bx);
                pg8::EpiRes E{ap->out, ap->out, D};
                pg8::gemm_phase<pg8::EpiRes, pg8::StaticOrder, true, true>(lds + RING_OFF, g, S, E, tid);
            PH_END(true)
            PH_BEGIN
#pragma unroll 1
                for (int m = gw; m < T; m += NGW) rms_row_to_bf16(ap->out + (size_t)m * D, ap->in[1] + D, WSP(bf16, WS_H) + (size_t)m * D, lane);
            PH_END(true)
        } else {
            volatile LAS int* const lcnt = (volatile LAS int*)(MISC + 32);
            volatile LAS unsigned* const loff = MISC + 16;
            volatile LAS int* const lbase = (volatile LAS int*)(MISC + 48);
            PH_BEGIN
                constexpr int I_E = 16 * 64;
#pragma unroll 1
                for (int it = gw; it < NEXP * 3 * I_E; it += NGW) {
                    const int e = it / (3 * I_E); int r = it - e * 3 * I_E;
                    if (r < I_E) { tr_item<2>(ap->in[12] + (size_t)e * D * DFFE, D, DFFE, WSP(bf16, WS_WEG) + (size_t)e * 2 * DFFE * D, nullptr, scr, r, lane); continue; } r -= I_E;
                    if (r < I_E) { tr_item<3>(ap->in[13] + (size_t)e * D * DFFE, D, DFFE, WSP(bf16, WS_WEG) + (size_t)e * 2 * DFFE * D, nullptr, scr, r, lane); continue; } r -= I_E;
                    tr_item<0>(ap->in[14] + (size_t)e * DFFE * D, DFFE, D, WSP(bf16, WS_WED) + (size_t)e * D * DFFE, nullptr, scr, r, lane);
                }
            PH_END(false)
            PH_BEGIN
                int4* route = WSP(int4, WS_ROUTE); int* wgcnt = WSP(int, WS_WGCNT); gu32* ctl = (gu32*)(ws + WS_CTL);
                const int rpw = T / G, r0 = bx * rpw, r1 = r0 + rpw;
                const float* xres = ap->out; const float* gf = ap->in[7] + D; const float* w_router = ap->in[11];
                if (tid < 8) lcnt[tid] = 0;
                __syncthreads();
#pragma unroll 1
                for (int m = r0 + wave; m < r1; m += NWAVES) {
                    const GAS f32x4* xr = (const GAS f32x4*)(xres + (size_t)m * D) + lane; const GAS f32x4* gr = (const GAS f32x4*)gf + lane;
                    f32x4 v[4]; float s = 0.f;
#pragma unroll
                    for (int j = 0; j < 4; ++j) { v[j] = xr[64 * j]; s += (v[j].x * v[j].x + v[j].y * v[j].y) + (v[j].z * v[j].z + v[j].w * v[j].w); }
                    const float rstd = 1.0f / sqrtf(wave_sum(s) * (1.f / D) + EPS);
                    float lg[8];
#pragma unroll
                    for (int e = 0; e < 8; ++e) lg[e] = 0.f;
#pragma unroll
                    for (int j = 0; j < 4; ++j) { const f32x4 gg = gr[64 * j];
#pragma unroll
                        for (int c = 0; c < 4; ++c) { const float hn = v[j][c] * rstd * gg[c]; const int i = 256 * j + 4 * lane + c;
                            const f32x4 wa = *(const GAS f32x4*)(w_router + (size_t)i * 8), wb = *(const GAS f32x4*)(w_router + (size_t)i * 8 + 4);
                            lg[0] += hn * wa.x; lg[1] += hn * wa.y; lg[2] += hn * wa.z; lg[3] += hn * wa.w; lg[4] += hn * wb.x; lg[5] += hn * wb.y; lg[6] += hn * wb.z; lg[7] += hn * wb.w; } }
#pragma unroll
                    for (int e = 0; e < 8; ++e) lg[e] = wave_sum(lg[e]);
                    int e1 = 0; float v1 = lg[0];
#pragma unroll
                    for (int e = 1; e < 8; ++e) if (lg[e] > v1) { v1 = lg[e]; e1 = e; }
                    int e2 = -1; float v2 = -INFINITY;
#pragma unroll
                    for (int e = 0; e < 8; ++e) if (e != e1 && lg[e] > v2) { v2 = lg[e]; e2 = e; }
                    if (e2 < 0) e2 = (e1 + 1) & 7;
                    const float ex = __expf(v2 - v1), w1 = 1.0f / (1.0f + ex), w2 = ex * w1;
                    if (lane == 0) { route[m] = make_int4(e1, e2, __float_as_int(w1), __float_as_int(w2)); atomicAdd((int*)(lcnt + e1), 1); atomicAdd((int*)(lcnt + e2), 1); }
                }
                __syncthreads();
                if (tid < 8) { const int c = lcnt[tid]; wgcnt[bx * 8 + tid] = c; __hip_atomic_fetch_add((unsigned*)(ctl + CW_CNT + tid), (unsigned)c, RLX_AGENT); }
            PH_END(true)
            PH_BEGIN
                int4* route = WSP(int4, WS_ROUTE); int2* slots = WSP(int2, WS_SLOTS); int* wgcnt = WSP(int, WS_WGCNT); gu32* ctl = (gu32*)(ws + WS_CTL); bf16* HP = WSP(bf16, WS_HP);
                const int rpw = T / G, r0 = bx * rpw, r1 = r0 + rpw;
                const float* xres = ap->out; const float* gf = ap->in[7] + D;
                { int s = 0; for (int w = lane; w < bx; w += 64) s += wgcnt[w * 8 + wave]; s = (int)wave_sum((float)s);
                  if (lane == 0) { lbase[wave] = s; lcnt[wave] = 0; } }
                if (tid == 0) { unsigned off = 0; for (int e = 0; e < 8; ++e) { loff[e] = off; off += (__hip_atomic_load((unsigned*)(ctl + CW_CNT + e), RLX_AGENT) + 255u) & ~255u; } loff[8] = off; }
                __syncthreads();
#pragma unroll 1
                for (int m = r0 + wave; m < r1; m += NWAVES) {
                    int s1 = 0, s2 = 0;
                    if (lane == 0) { const int4 rt = route[m]; s1 = (int)loff[rt.x] + lbase[rt.x] + atomicAdd((int*)(lcnt + rt.x), 1); s2 = (int)loff[rt.y] + lbase[rt.y] + atomicAdd((int*)(lcnt + rt.y), 1); slots[m] = make_int2(s1, s2); }
                    s1 = __builtin_amdgcn_readfirstlane(s1); s2 = __builtin_amdgcn_readfirstlane(s2);
                    const GAS f32x4* xr = (const GAS f32x4*)(xres + (size_t)m * D) + lane; const GAS f32x4* gr = (const GAS f32x4*)gf + lane;
                    f32x4 v[4]; float s = 0.f;
#pragma unroll
                    for (int j = 0; j < 4; ++j) { v[j] = xr[64 * j]; s += (v[j].x * v[j].x + v[j].y * v[j].y) + (v[j].z * v[j].z + v[j].w * v[j].w); }
                    const float rstd = 1.0f / sqrtf(wave_sum(s) * (1.f / D) + EPS);
                    GAS u32x2v* o1 = (GAS u32x2v*)(HP + (size_t)s1 * D) + lane; GAS u32x2v* o2 = (GAS u32x2v*)(HP + (size_t)s2 * D) + lane;
#pragma unroll
                    for (int j = 0; j < 4; ++j) { const f32x4 gg = gr[64 * j]; u32x2v w; w.x = cvt_pk_bf16(v[j].x * rstd * gg.x, v[j].y * rstd * gg.y); w.y = cvt_pk_bf16(v[j].z * rstd * gg.z, v[j].w * rstd * gg.w); o1[64 * j] = w; o2[64 * j] = w; }
                }
            PH_END(true)
            PH_BEGIN
                const int mrows = (int)loff[8];
                pg8::Gemm g{WSP(bf16, WS_HP), WSP(bf16, WS_WEG), mrows, 2 * DFFE, D}; pg8::MoeOrder S; S.init(mrows, 2 * DFFE, G, bx); S.offs = loff; S.ntn = 2 * DFFE / 256;
                pg8::EpiSwiGLU E{WSP(bf16, WS_G1), DFFE};
                pg8::gemm_phase<pg8::EpiSwiGLU, pg8::MoeOrder, true, true>(lds + RING_OFF, g, S, E, tid);
            PH_END(true)
            PH_BEGIN
                const int mrows = (int)loff[8];
                pg8::Gemm g{WSP(bf16, WS_G1), WSP(bf16, WS_WED), mrows, D, DFFE}; pg8::MoeOrder S; S.init(mrows, D, G, bx); S.offs = loff; S.ntn = D / 256;
                pg8::EpiPlain E{WSP(bf16, WS_HP), D};
                pg8::gemm_phase<pg8::EpiPlain, pg8::MoeOrder, true, true>(lds + RING_OFF, g, S, E, tid);
            PH_END(true)
            PH_BEGIN
                const int4* route = WSP(int4, WS_ROUTE); const int2* slots = WSP(int2, WS_SLOTS); const bf16* HP = WSP(bf16, WS_HP); float* xres = ap->out; const float* g_final = ap->in[15];
#pragma unroll 1
                for (int m = gw; m < T; m += NGW) {
                    const int4 rt = route[m]; const int2 sl = slots[m]; const float w1 = __int_as_float(rt.z), w2 = __int_as_float(rt.w);
                    GAS f32x4* xr = (GAS f32x4*)(xres + (size_t)m * D) + lane; const GAS f32x4* gr = (const GAS f32x4*)g_final + lane;
                    const GAS u32x2v* y1 = (const GAS u32x2v*)(HP + (size_t)sl.x * D) + lane; const GAS u32x2v* y2 = (const GAS u32x2v*)(HP + (size_t)sl.y * D) + lane;
                    f32x4 v[4]; float s = 0.f;
#pragma unroll
                    for (int j = 0; j < 4; ++j) { v[j] = xr[64 * j]; const u32x2v a = y1[64 * j], b = y2[64 * j];
                        v[j].x += w1 * __builtin_bit_cast(float, a.x << 16) + w2 * __builtin_bit_cast(float, b.x << 16);
                        v[j].y += w1 * __builtin_bit_cast(float, a.x & 0xffff0000u) + w2 * __builtin_bit_cast(float, b.x & 0xffff0000u);
                        v[j].z += w1 * __builtin_bit_cast(float, a.y << 16) + w2 * __builtin_bit_cast(float, b.y << 16);
                        v[j].w += w1 * __builtin_bit_cast(float, a.y & 0xffff0000u) + w2 * __builtin_bit_cast(float, b.y & 0xffff0000u);
                        s += (v[j].x * v[j].x + v[j].y * v[j].y) + (v[j].z * v[j].z + v[j].w * v[j].w); }
                    const float rstd = 1.0f / sqrtf(wave_sum(s) * (1.f / D) + EPS);
#pragma unroll
                    for (int j = 0; j < 4; ++j) { const f32x4 gg = gr[64 * j]; xr[64 * j] = (f32x4){v[j].x * rstd * gg.x, v[j].y * rstd * gg.y, v[j].z * rstd * gg.z, v[j].w * rstd * gg.w}; }
                }
            PH_END(false)
        }
    }
}

extern "C" void kernel_launch(void* const* d_in, const int* in_sizes, int n_in, void* d_out, int out_size, void* d_ws, size_t ws_size, hipStream_t stream) {
    static int grid = 0;
    if (grid == 0) {
        if (n_in != 16 || in_sizes[0] != T * D || out_size != T * D || ws_size < WS_END) { fprintf(stderr, "kernel_launch: unexpected shapes (n_in %d, in0 %d, out %d, ws %zu); nothing launched\n", n_in, n_in > 0 ? in_sizes[0] : -1, out_size, ws_size); grid = -1; return; }
        int dev = 0, cus = 0, per_cu = 0;
        if (hipGetDevice(&dev) != hipSuccess || hipDeviceGetAttribute(&cus, hipDeviceAttributeMultiprocessorCount, dev) != hipSuccess) { grid = -1; return; }
        if (hipFuncSetAttribute((const void*)mega_fwd, hipFuncAttributeMaxDynamicSharedMemorySize, LDS_BYTES) != hipSuccess) { fprintf(stderr, "kernel_launch: hipFuncSetAttribute failed\n"); grid = -1; return; }
        if (hipOccupancyMaxActiveBlocksPerMultiprocessor(&per_cu, (const void*)mega_fwd, NWAVES * 64, LDS_BYTES) != hipSuccess || per_cu < 1) { fprintf(stderr, "kernel_launch: occupancy query reports %d workgroups per CU\n", per_cu); }
        (void)hipGetLastError();
        grid = cus;
        while (grid > 1 && (T % grid) != 0) --grid;
    }
    if (grid < 0) return;
    if (hipMemsetAsync((char*)d_ws + WS_CTL, 0, CTL_ZERO_BYTES, stream) != hipSuccess) return;
    Args a{};
    for (int i = 0; i < 16; ++i) a.in[i] = (const float*)d_in[i];
    a.out = (float*)d_out; a.ws = (unsigned char*)d_ws;
    hipLaunchKernelGGL(mega_fwd, dim3(grid), dim3(NWAVES * 64), LDS_BYTES, stream, a);
}
```

```cpp
#include <hip/hip_runtime.h>
#include <cstdio>
#include <cstdint>
#include <cmath>
namespace pg8 {
#define PG8_LAS __attribute__((address_space(3)))
typedef unsigned short bf16_t;
typedef short bf16x8 __attribute__((ext_vector_type(8)));
typedef float f32x4 __attribute__((ext_vector_type(4)));
typedef unsigned u32x4 __attribute__((ext_vector_type(4)));
constexpr int BM = 256, BK = 64, HALF = 128, HTB = HALF * BK * 2  , STAGE_BYTES = 8 * HTB, NXCD = 8, WGM = 8;

__host__ __device__ __forceinline__ int lds_byte(int r, int c) { const int st = (r >> 4) * 2 + (c >> 5), rr = r & 15, cc = c & 31, ob = rr * 64 + cc * 2; return st * 1024 + (ob ^ (((ob >> 9) & 1) << 5)); }
__host__ __device__ __forceinline__ void stage_rc(int b, int& R, int& C) { const int st = b / 1024, sb = b % 1024, swz = sb ^ (((sb >> 9) & 1) << 5); R = (st >> 1) * 16 + swz / 64; C = (st & 1) * 32 + (swz % 64) / 2; }
__host__ __device__ __forceinline__ int perm32(int rho) { const int n = rho >> 4, i = rho & 15; return 8 * (i >> 2) + 4 * n + (i & 3); }

struct Unit { int pm, pn, pb; };
struct Gemm { const bf16_t* A; const bf16_t* Bt; int M, N, K; };

struct StaticOrder {
    int nM, nN, nwg, G, c;
    __host__ __device__ void init(int M, int N, int G_, int c_) { nM = M / BM; nN = N / BM; nwg = nM * nN; G = G_; c = c_; }
    __host__ __device__ bool next(int i, Unit& u) const {
        const long L = (long)i * G + c; if (L >= nwg) return false;
        int wgid = (int)L; { const int q = nwg / NXCD, r = nwg % NXCD, xcd = wgid % NXCD, off = wgid / NXCD; wgid = (xcd < r ? xcd * (q + 1) : r * (q + 1) + (xcd - r) * q) + off; }
        const int nig = WGM * nN, gid = wgid / nig, fm = gid * WGM, gsz = (nM - fm) < WGM ? (nM - fm) : WGM;
        u.pm = fm + ((wgid % nig) % gsz); u.pn = (wgid % nig) / gsz; u.pb = u.pn; return true;
    }
    __device__ __forceinline__ void a_ready(const Unit&) const {}
    __device__ __forceinline__ void done(const Unit&) const {}
};

__device__ __forceinline__ unsigned cvt_pk_bf16(float lo, float hi) { unsigned r; asm volatile("v_cvt_pk_bf16_f32 %0, %1, %2" : "=v"(r) : "v"(lo), "v"(hi)); return r; }
typedef float f32x2 __attribute__((ext_vector_type(2)));

__device__ __forceinline__ float sigmoidf_fast(float x) { return __builtin_amdgcn_rcpf(1.0f + __builtin_amdgcn_exp2f(-1.4426950408889634f * x)); }
__device__ __forceinline__ float bf_lo(unsigned w) { return __builtin_bit_cast(float, w << 16); }
__device__ __forceinline__ float bf_hi(unsigned w) { return __builtin_bit_cast(float, w & 0xffff0000u); }
__device__ __forceinline__ void unpack8(const u32x4 w, float (&f)[8]) { f[0] = bf_lo(w.x); f[1] = bf_hi(w.x); f[2] = bf_lo(w.y); f[3] = bf_hi(w.y); f[4] = bf_lo(w.z); f[5] = bf_hi(w.z); f[6] = bf_lo(w.w); f[7] = bf_hi(w.w); }
__device__ __forceinline__ u32x4 pack8(const float (&f)[8]) { u32x4 w; w.x = cvt_pk_bf16(f[0], f[1]); w.y = cvt_pk_bf16(f[2], f[3]); w.z = cvt_pk_bf16(f[4], f[5]); w.w = cvt_pk_bf16(f[6], f[7]); return w; }

struct EpiProj {
    static constexpr bool PERM = true, AFTER_DRAIN = false;
    bf16_t* PA; bf16_t* QF; bf16_t* KF; bf16_t* GT; float qscale;
    __device__ __forceinline__ void operator()(const f32x4 (&acc)[2][2][4][2], const Unit& u, int wr, int wc, int fr, int fq) const {
        const int row0 = u.pm * BM + wr * 64 + fr;
        if (u.pn >= 6 && u.pn < 10) {
            const bool isq = u.pn < 8; const float sc = isq ? qscale : 1.f; bf16_t* base = isq ? QF : KF;
            const int hc0 = (u.pn - (isq ? 6 : 8)) * BM + wc * 32 + 8 * fq;
#pragma unroll
            for (int ai = 0; ai < 2; ++ai)
#pragma unroll
                for (int m = 0; m < 4; ++m) { const int row = row0 + ai * HALF + m * 16; const int b = row >> 12, t = row & 4095, blk = t >> 5, tl = t & 31;
                    const int li = isq ? tl : ((tl & 19) | ((tl & 4) << 1) | ((tl & 8) >> 1));
#pragma unroll
                    for (int bj = 0; bj < 2; ++bj) { const int hc = hc0 + bj * HALF, h = hc >> 6, c = (hc & 63) >> 3, d0 = c >> 1, hg = c & 1;
                        const f32x4 v0 = acc[ai][bj][m][0] * sc, v1 = acc[ai][bj][m][1] * sc;
                        u32x4 w; w.x = cvt_pk_bf16(v0[0], v0[1]); w.y = cvt_pk_bf16(v0[2], v0[3]); w.z = cvt_pk_bf16(v1[0], v1[1]); w.w = cvt_pk_bf16(v1[2], v1[3]);
                        *(u32x4*)(base + ((((size_t)(b * 8 + h) * 128 + blk) * 4 + d0) * 64 + hg * 32 + li) * 8) = w; } }
            return;
        }
        bf16_t* base; int ldc, colt;
        if (u.pn < 6) { base = PA; ldc = 1536; colt = u.pn * BM; } else { base = GT; ldc = 2048; colt = (u.pn - 10) * BM; }
        const int col0 = colt + wc * 32 + 8 * fq;
#pragma unroll
        for (int ai = 0; ai < 2; ++ai)
#pragma unroll
            for (int m = 0; m < 4; ++m) { bf16_t* rowp = base + (size_t)(row0 + ai * HALF + m * 16) * ldc + col0;
#pragma unroll
                for (int bj = 0; bj < 2; ++bj) { const f32x4 v0 = acc[ai][bj][m][0], v1 = acc[ai][bj][m][1];
                    u32x4 w; w.x = cvt_pk_bf16(v0[0], v0[1]); w.y = cvt_pk_bf16(v0[2], v0[3]); w.z = cvt_pk_bf16(v1[0], v1[1]); w.w = cvt_pk_bf16(v1[2], v1[3]);
                    *(u32x4*)(rowp + bj * HALF) = w; } }
    }
};
struct EpiVT {
    static constexpr bool PERM = true, AFTER_DRAIN = false;
    bf16_t* VF;
    __device__ __forceinline__ void operator()(const f32x4 (&acc)[2][2][4][2], const Unit& u, int wr, int wc, int fr, int fq) const {
        const int row0 = u.pm * BM + wr * 64 + fr, tok0 = u.pn * BM + wc * 32 + 8 * fq;
#pragma unroll
        for (int ai = 0; ai < 2; ++ai)
#pragma unroll
            for (int m = 0; m < 4; ++m) { const int hd = row0 + ai * HALF + m * 16, h = hd >> 6, dblk = (hd >> 5) & 1, dl = hd & 31;
#pragma unroll
                for (int bj = 0; bj < 2; ++bj) { const int tok = tok0 + bj * HALF, b = tok >> 12, t = tok & 4095, blk = t >> 5, s = (t >> 4) & 1, hg = (t >> 3) & 1;
                    const f32x4 v0 = acc[ai][bj][m][0], v1 = acc[ai][bj][m][1];
                    u32x4 w; w.x = cvt_pk_bf16(v0[0], v0[1]); w.y = cvt_pk_bf16(v0[2], v0[3]); w.z = cvt_pk_bf16(v1[0], v1[1]); w.w = cvt_pk_bf16(v1[2], v1[3]);
                    *(u32x4*)(VF + ((((size_t)(b * 8 + h) * 128 + blk) * 4 + dblk * 2 + s) * 64 + hg * 32 + dl) * 8) = w; } }
    }
};
struct EpiPlain {
    static constexpr bool PERM = true, AFTER_DRAIN = false;
    bf16_t* O; int ldc;
    __device__ __forceinline__ void operator()(const f32x4 (&acc)[2][2][4][2], const Unit& u, int wr, int wc, int fr, int fq) const {
        const int row0 = u.pm * BM + wr * 64 + fr, col0 = u.pn * BM + wc * 32 + 8 * fq;
#pragma unroll
        for (int ai = 0; ai < 2; ++ai)
#pragma unroll
            for (int m = 0; m < 4; ++m) { bf16_t* rowp = O + (size_t)(row0 + ai * HALF + m * 16) * ldc + col0;
#pragma unroll
                for (int bj = 0; bj < 2; ++bj) { const f32x4 v0 = acc[ai][bj][m][0], v1 = acc[ai][bj][m][1];
                    u32x4 w; w.x = cvt_pk_bf16(v0[0], v0[1]); w.y = cvt_pk_bf16(v0[2], v0[3]); w.z = cvt_pk_bf16(v1[0], v1[1]); w.w = cvt_pk_bf16(v1[2], v1[3]);
                    *(u32x4*)(rowp + bj * HALF) = w; } }
    }
};
struct EpiSwiGLU {
    static constexpr bool PERM = true, AFTER_DRAIN = false;
    bf16_t* O; int ldc;
    __device__ __forceinline__ void operator()(const f32x4 (&acc)[2][2][4][2], const Unit& u, int wr, int wc, int fr, int fq) const {
        const int row0 = u.pm * BM + wr * 64 + fr, col0 = u.pn * HALF + wc * 32 + 8 * fq;
#pragma unroll
        for (int ai = 0; ai < 2; ++ai)
#pragma unroll
            for (int m = 0; m < 4; ++m) { bf16_t* rowp = O + (size_t)(row0 + ai * HALF + m * 16) * ldc + col0;
                float o[8];
#pragma unroll
                for (int n = 0; n < 2; ++n)
#pragma unroll
                    for (int i = 0; i < 4; ++i) { const float g = acc[ai][0][m][n][i], up = acc[ai][1][m][n][i]; o[4 * n + i] = g * sigmoidf_fast(g) * up; }
                *(u32x4*)rowp = pack8(o); }
    }
};
struct EpiGateA {
    static constexpr bool PERM = true, AFTER_DRAIN = false;
    const bf16_t* GT; bf16_t* TMP;
    __device__ __forceinline__ void operator()(const f32x4 (&acc)[2][2][4][2], const Unit& u, int wr, int wc, int fr, int fq) const {
        const int row0 = u.pm * BM + wr * 64 + fr, col0 = u.pn * BM + wc * 32 + 8 * fq;
#pragma unroll
        for (int ai = 0; ai < 2; ++ai)
#pragma unroll
            for (int m = 0; m < 4; ++m) { const size_t r = (size_t)(row0 + ai * HALF + m * 16);
#pragma unroll
                for (int bj = 0; bj < 2; ++bj) { const int c = col0 + bj * HALF;
                    float g[8], o[8]; unpack8(*(const u32x4*)(GT + r * 2048 + c), g);
#pragma unroll
                    for (int n = 0; n < 2; ++n)
#pragma unroll
                        for (int i = 0; i < 4; ++i) o[4 * n + i] = sigmoidf_fast(g[4 * n + i]) * acc[ai][bj][m][n][i];
                    *(u32x4*)(TMP + r * 1024 + c) = pack8(o); } }
    }
};
struct EpiGateB {
    static constexpr bool PERM = true, AFTER_DRAIN = false;
    const bf16_t* GT; const bf16_t* TMP; bf16_t* MIX;
    __device__ __forceinline__ void operator()(const f32x4 (&acc)[2][2][4][2], const Unit& u, int wr, int wc, int fr, int fq) const {
        const int row0 = u.pm * BM + wr * 64 + fr, col0 = u.pn * BM + wc * 32 + 8 * fq;
#pragma unroll
        for (int ai = 0; ai < 2; ++ai)
#pragma unroll
            for (int m = 0; m < 4; ++m) { const size_t r = (size_t)(row0 + ai * HALF + m * 16);
#pragma unroll
                for (int bj = 0; bj < 2; ++bj) { const int c = col0 + bj * HALF;
                    float g[8], t[8], o[8]; unpack8(*(const u32x4*)(GT + r * 2048 + 1024 + c), g); unpack8(*(const u32x4*)(TMP + r * 1024 + c), t);
#pragma unroll
                    for (int n = 0; n < 2; ++n)
#pragma unroll
                        for (int i = 0; i < 4; ++i) o[4 * n + i] = t[4 * n + i] + sigmoidf_fast(g[4 * n + i]) * acc[ai][bj][m][n][i];
                    *(u32x4*)(MIX + r * 1024 + c) = pack8(o); } }
    }
};
struct EpiRes {
    static constexpr bool PERM = false, AFTER_DRAIN = false;
    const float* base; float* out; int ldc;
    __device__ __forceinline__ void operator()(const f32x4 (&acc)[2][2][4][2], const Unit& u, int wr, int wc, int fr, int fq) const {
        const int row0 = u.pm * BM + wr * 64 + fr, col0 = u.pn * BM + wc * 32 + 4 * fq;
#pragma unroll
        for (int ai = 0; ai < 2; ++ai)
#pragma unroll
            for (int m = 0; m < 4; ++m) { const size_t off = (size_t)(row0 + ai * HALF + m * 16) * ldc + col0;
#pragma unroll
                for (int bj = 0; bj < 2; ++bj)
#pragma unroll
                    for (int n = 0; n < 2; ++n) { const f32x4 b = *(const f32x4*)(base + off + bj * HALF + n * 16); *(f32x4*)(out + off + bj * HALF + n * 16) = b + acc[ai][bj][m][n]; } }
    }
};
struct EpiNull {
    static constexpr bool PERM = true, AFTER_DRAIN = false;
    __device__ __forceinline__ void operator()(const f32x4 (&acc)[2][2][4][2], const Unit& u, int wr, int wc, int fr, int fq) const {
#pragma unroll
        for (int ai = 0; ai < 2; ++ai)
#pragma unroll
            for (int bj = 0; bj < 2; ++bj)
#pragma unroll
                for (int m = 0; m < 4; ++m)
#pragma unroll
                    for (int n = 0; n < 2; ++n) asm volatile("" :: "v"(acc[ai][bj][m][n]));
    }
};
struct MoeOrder : StaticOrder {
    const volatile PG8_LAS unsigned* offs; int ntn;
    __device__ __forceinline__ bool next(int i, Unit& u) const {
        if (!StaticOrder::next(i, u)) return false;
        const unsigned row = (unsigned)u.pm * BM; int e = 0;
#pragma unroll
        for (int k = 1; k < 8; ++k) e += (row >= offs[k]) ? 1 : 0;
        u.pb = e * ntn + u.pn; return true;
    }
};
template <class Epi, class Sched, bool ALIGN_EPI = false, bool SP2 = false>
__device__ __forceinline__ void gemm_phase(PG8_LAS unsigned char* lds, const Gemm g, const Sched& S, const Epi& E, const int tid) {
    const int wid = __builtin_amdgcn_readfirstlane(tid >> 6), lane = tid & 63, wr = wid >> 2, wc = wid & 3, fr = lane & 15, fq = lane >> 4;
    const int K = g.K, nt = K / BK;
    unsigned voffA[2], voffB[2];
#pragma unroll
    for (int i = 0; i < 2; ++i) { int R, C; stage_rc(tid * 16 + i * 8192, R, C); const int Rb = Epi::PERM ? ((R & ~31) + perm32(R & 31)) : R;
        voffA[i] = (unsigned)(R * K + C) * 2u; voffB[i] = (unsigned)(Rb * K + C) * 2u; }
    const size_t kstep = (size_t)(BK * 2);
    const size_t hstep = (size_t)HALF * K * 2;
    const size_t tstep = 2 * hstep;
    const unsigned ldsw = (unsigned)wid * 1024u;
    const int aoff = lds_byte(wr * 64 + fr, fq * 8), boff = lds_byte(wc * 32 + fr, fq * 8);
#define PG8_SA(b, h) (((b) * 2 + (h)) * HTB)
#define PG8_SB(b, h) ((4 + (b) * 2 + (h)) * HTB)
#define PG8_STAGE(bufoff, gbase, voff) do { _Pragma("unroll") for (int _i = 0; _i < 2; ++_i) \
        __builtin_amdgcn_global_load_lds((const unsigned*)((const char*)(gbase) + (voff)[_i]), (PG8_LAS unsigned*)(lds + (bufoff) + ldsw + _i * 8192), 16, 0, 0); } while (0)
#define PG8_LDA(dst, b, h) do { _Pragma("unroll") for (int m = 0; m < 4; ++m) _Pragma("unroll") for (int k = 0; k < 2; ++k) dst[m][k] = *(const PG8_LAS bf16x8*)(lds + PG8_SA(b, h) + aoff + m * 2048 + k * 1024); } while (0)
#define PG8_LDB(dst, b, h) do { _Pragma("unroll") for (int n = 0; n < 2; ++n) _Pragma("unroll") for (int k = 0; k < 2; ++k) dst[n][k] = *(const PG8_LAS bf16x8*)(lds + PG8_SB(b, h) + boff + n * 2048 + k * 1024); } while (0)
#define PG8_MMA(ai, bj, At, Bt) do { __builtin_amdgcn_s_setprio(1); _Pragma("unroll") for (int m = 0; m < 4; ++m) _Pragma("unroll") for (int n = 0; n < 2; ++n) _Pragma("unroll") for (int k = 0; k < 2; ++k) \
        acc[ai][bj][m][n] = __builtin_amdgcn_mfma_f32_16x16x32_bf16(Bt[n][k], At[m][k], acc[ai][bj][m][n], 0, 0, 0); __builtin_amdgcn_s_setprio(0); } while (0)
#define PG8_WAIT_V(n) asm volatile("s_waitcnt vmcnt(" #n ")" ::: "memory")
#define PG8_WAIT_L(n) asm volatile("s_waitcnt lgkmcnt(" #n ")" ::: "memory")
#define PG8_BAR __builtin_amdgcn_s_barrier()
#define PG8_SCHED __builtin_amdgcn_sched_barrier(0)
    Unit cur, nxt; int ui = 0;
    if (!S.next(0, cur)) return;
    f32x4 acc[2][2][4][2];
#pragma unroll
    for (int a = 0; a < 2; ++a)
#pragma unroll
        for (int b = 0; b < 2; ++b)
#pragma unroll
            for (int m = 0; m < 4; ++m)
#pragma unroll
                for (int n = 0; n < 2; ++n) acc[a][b][m][n] = (f32x4){0.f, 0.f, 0.f, 0.f};
    bf16x8 At[4][2], B0[2][2], B1[2][2];
    const char* cA = (const char*)g.A + (size_t)cur.pm * tstep; const char* cB = (const char*)g.Bt + (size_t)cur.pb * tstep;
    S.a_ready(cur);
    if constexpr (SP2) {
        PG8_STAGE(PG8_SB(0, 0), cB, voffB); PG8_STAGE(PG8_SB(0, 1), cB + hstep, voffB); PG8_STAGE(PG8_SA(0, 0), cA, voffA); PG8_STAGE(PG8_SA(0, 1), cA + hstep, voffA);
        if (wr == 1) PG8_BAR;
        PG8_WAIT_V(2); PG8_BAR;
        PG8_STAGE(PG8_SB(1, 0), cB + kstep, voffB); PG8_STAGE(PG8_SA(1, 0), cA + kstep, voffA); PG8_STAGE(PG8_SB(1, 1), cB + hstep + kstep, voffB);
        PG8_WAIT_V(6); PG8_BAR;
    } else {
        PG8_STAGE(PG8_SB(0, 0), cB, voffB); PG8_STAGE(PG8_SA(0, 0), cA, voffA); PG8_STAGE(PG8_SB(0, 1), cB + hstep, voffB); PG8_STAGE(PG8_SA(0, 1), cA + hstep, voffA);
        if (wr == 1) PG8_BAR;
        PG8_WAIT_V(4); PG8_BAR;
        PG8_STAGE(PG8_SB(1, 0), cB + kstep, voffB); PG8_STAGE(PG8_SA(1, 0), cA + kstep, voffA); PG8_STAGE(PG8_SB(1, 1), cB + hstep + kstep, voffB);
        PG8_WAIT_V(6); PG8_BAR;
    }
    for (;;) {
        const bool has_next = S.next(ui + 1, nxt);
        const char* nA = has_next ? (const char*)g.A + (size_t)nxt.pm * tstep : cA; const char* nB = has_next ? (const char*)g.Bt + (size_t)nxt.pb * tstep : cB;
        for (int t = 0; t < nt; t += 2) {
            const bool last = (t == nt - 2);
            const char* a1 = cA + (size_t)(t + 1) * kstep;
            const char* a2 = last ? nA : cA + (size_t)(t + 2) * kstep; const char* b2 = last ? nB : cB + (size_t)(t + 2) * kstep;
            const char* a3 = a2 + kstep; const char* b3 = b2 + kstep;
            if (last && has_next) S.a_ready(nxt);
            if constexpr (SP2) {
            PG8_LDB(B0, 0, 0); PG8_LDB(B1, 0, 1); PG8_SCHED; PG8_LDA(At, 0, 0); PG8_STAGE(PG8_SA(1, 1), a1 + hstep, voffA);
            PG8_WAIT_V(8); PG8_WAIT_L(0); PG8_BAR; PG8_MMA(0, 0, At, B0); PG8_MMA(0, 1, At, B1); PG8_BAR; PG8_SCHED;
            PG8_LDA(At, 0, 1); PG8_STAGE(PG8_SB(0, 0), b2, voffB); PG8_STAGE(PG8_SB(0, 1), b2 + hstep, voffB); PG8_STAGE(PG8_SA(0, 0), a2, voffA);
            PG8_WAIT_V(8); PG8_WAIT_L(0); PG8_BAR; PG8_MMA(1, 0, At, B0); PG8_MMA(1, 1, At, B1); PG8_BAR; PG8_SCHED;
            PG8_LDB(B0, 1, 0); PG8_LDB(B1, 1, 1); PG8_SCHED; PG8_LDA(At, 1, 0); PG8_STAGE(PG8_SA(0, 1), a2 + hstep, voffA);
            PG8_WAIT_V(8); PG8_WAIT_L(0); PG8_BAR; PG8_MMA(0, 0, At, B0); PG8_MMA(0, 1, At, B1); PG8_BAR; PG8_SCHED;
            PG8_LDA(At, 1, 1); PG8_STAGE(PG8_SB(1, 0), b3, voffB); PG8_STAGE(PG8_SB(1, 1), b3 + hstep, voffB); PG8_STAGE(PG8_SA(1, 0), a3, voffA);
            PG8_WAIT_V(8); PG8_WAIT_L(0); PG8_BAR; PG8_MMA(1, 0, At, B0); PG8_MMA(1, 1, At, B1); PG8_BAR; PG8_SCHED;
            } else {
            PG8_LDB(B0, 0, 0); PG8_SCHED; PG8_LDA(At, 0, 0); PG8_STAGE(PG8_SA(1, 1), a1 + hstep, voffA);
            PG8_WAIT_L(8); PG8_BAR; PG8_WAIT_L(0); PG8_MMA(0, 0, At, B0); PG8_BAR; PG8_SCHED;
            PG8_LDB(B1, 0, 1); PG8_STAGE(PG8_SB(0, 0), b2, voffB);
            PG8_BAR; PG8_WAIT_L(0); PG8_MMA(0, 1, At, B1); PG8_BAR;
            PG8_LDA(At, 0, 1); PG8_STAGE(PG8_SA(0, 0), a2, voffA);
            PG8_BAR; PG8_WAIT_L(0); PG8_MMA(1, 0, At, B0); PG8_BAR; PG8_SCHED;
            PG8_STAGE(PG8_SB(0, 1), b2 + hstep, voffB);
            PG8_WAIT_V(6); PG8_BAR; PG8_MMA(1, 1, At, B1); PG8_BAR;
            PG8_LDB(B0, 1, 0); PG8_SCHED; PG8_LDA(At, 1, 0); PG8_STAGE(PG8_SA(0, 1), a2 + hstep, voffA);
            PG8_WAIT_L(8); PG8_BAR; PG8_WAIT_L(0); PG8_MMA(0, 0, At, B0); PG8_BAR; PG8_SCHED;
            PG8_LDB(B1, 1, 1); PG8_STAGE(PG8_SB(1, 0), b3, voffB);
            PG8_BAR; PG8_WAIT_L(0); PG8_MMA(0, 1, At, B1); PG8_BAR;
            PG8_LDA(At, 1, 1); PG8_STAGE(PG8_SA(1, 0), a3, voffA);
            PG8_BAR; PG8_WAIT_L(0); PG8_MMA(1, 0, At, B0); PG8_BAR; PG8_SCHED;
            PG8_STAGE(PG8_SB(1, 1), b3 + hstep, voffB);
            PG8_WAIT_V(6); PG8_BAR; PG8_MMA(1, 1, At, B1); PG8_BAR;
            }
        }
        if constexpr (ALIGN_EPI) { if (wr == 0) PG8_BAR; }
        if constexpr (!Epi::AFTER_DRAIN) { E(acc, cur, wr, wc, fr, fq); S.done(cur); }
        if (!has_next) break;
#pragma unroll
        for (int a = 0; a < 2; ++a)
#pragma unroll
            for (int b = 0; b < 2; ++b)
#pragma unroll
                for (int m = 0; m < 4; ++m)
#pragma unroll
                    for (int n = 0; n < 2; ++n) acc[a][b][m][n] = (f32x4){0.f, 0.f, 0.f, 0.f};
        cur = nxt; cA = nA; cB = nB; ++ui;
        if constexpr (ALIGN_EPI) { if (wr == 1) PG8_BAR; }
    }
    PG8_WAIT_V(0);
    if constexpr (!ALIGN_EPI) { if (wr == 0) PG8_BAR; }
    PG8_BAR;
    if constexpr (Epi::AFTER_DRAIN) { E.fused(acc, cur, wr, wc, fr, fq, lds, wid, lane); S.done(cur); }
#undef PG8_SA
#undef PG8_SB
#undef PG8_STAGE
#undef PG8_LDA
#undef PG8_LDB
#undef PG8_MMA
#undef PG8_WAIT_V
#undef PG8_WAIT_L
#undef PG8_BAR
#undef PG8_SCHED
}
}
#define GAS __attribute__((address_space(1)))
#define LAS __attribute__((address_space(3)))
typedef unsigned short bf16;
typedef unsigned v4u __attribute__((ext_vector_type(4)));
typedef float f32x4 __attribute__((ext_vector_type(4)));
typedef short bf16x8 __attribute__((ext_vector_type(8)));
typedef GAS unsigned gu32;
typedef GAS unsigned long long gu64;
#define RLX_AGENT __ATOMIC_RELAXED, __HIP_MEMORY_SCOPE_AGENT
#define LDS_WAIT() asm volatile("s_waitcnt lgkmcnt(0)" ::: "memory")
#define VM_WAIT() asm volatile("s_waitcnt vmcnt(0)" ::: "memory")
__device__ __forceinline__ unsigned long long rt() { return __builtin_amdgcn_s_memrealtime(); }
__device__ __forceinline__ unsigned f2bf(float f) { unsigned u = __builtin_bit_cast(unsigned, f); return (u + 0x7fffu + ((u >> 16) & 1u)) >> 16; }
__device__ __forceinline__ unsigned pk2(float lo, float hi) { return f2bf(lo) | (f2bf(hi) << 16); }

#define XB_TMO      128
#define XB_XCNT(j)  (256  + 64 * (j))
#define XB_XSUB(j)  (1280 + 64 * (j))
#define XB_XGEN(j)  (2304 + 64 * (j))
#define XB_TOP      3328
#define XB_TOPGEN   3392
#define XCD_BAR_WORDS 3456
#define XB_SPIN_CAP (1u << 18)

__device__ __forceinline__ unsigned xb_ld(unsigned* p)              { return __hip_atomic_load(p, __ATOMIC_RELAXED, __HIP_MEMORY_SCOPE_AGENT); }
__device__ __forceinline__ unsigned xb_add(unsigned* p, unsigned v) { return __hip_atomic_fetch_add(p, v, __ATOMIC_RELAXED, __HIP_MEMORY_SCOPE_AGENT); }
__device__ __forceinline__ unsigned xb_xcc_id() { return (unsigned)__builtin_amdgcn_s_getreg((3 << 11) | 20) & 0xFu; }
#define XB_SPIN(cond, bar) do { unsigned _sp = 0; while (cond) { __builtin_amdgcn_s_sleep(1); \
    if ((++_sp & 255u) == 0u) { if (xb_ld(&(bar)[XB_TMO])) break; if (_sp > XB_SPIN_CAP) { atomicAdd(&(bar)[XB_TMO], 1u); break; } } } } while (0)

struct XcdBarrier {
    unsigned* bar; unsigned x;
    volatile LAS unsigned* st;
};

__device__ __forceinline__ XcdBarrier xcd_barrier_post(unsigned* bar, volatile LAS unsigned* st) {
    XcdBarrier b; b.bar = bar; b.x = xb_xcc_id(); b.st = st;
    if (threadIdx.x == 0) (void)xb_add(&bar[XB_XCNT(b.x)], 1u);
    return b;
}
__device__ __forceinline__ void xcd_barrier_complete(unsigned* bar, unsigned x, unsigned& nloc, unsigned& nx) {
    const unsigned G = gridDim.x * gridDim.y * gridDim.z;
    unsigned sum, cnt, mine, sp = 0u;
    for (;;) {
        sum = 0u; cnt = 0u; mine = 0u;
#pragma unroll
        for (unsigned j = 0; j < 16; ++j) { const unsigned c = xb_ld(&bar[XB_XCNT(j)]); sum += c; cnt += (c > 0u) ? 1u : 0u; mine = (j == x) ? c : mine; }
        if (sum == G) break;
        __builtin_amdgcn_s_sleep(1);
        if ((++sp & 255u) == 0u) { if (xb_ld(&bar[XB_TMO])) break; if (sp > XB_SPIN_CAP) { atomicAdd(&bar[XB_TMO], 1u); break; } }
    }
    nloc = mine > 0u ? mine : 1u; nx = cnt > 0u ? cnt : 1u;
}

__device__ __forceinline__ void xcd_barrier(const XcdBarrier& b) {
    asm volatile("s_waitcnt vmcnt(0)" ::: "memory");
    __syncthreads();
    if (threadIdx.x == 0) {
        unsigned* bar = b.bar;
        __builtin_amdgcn_s_waitcnt(0);
        unsigned nloc = b.st[0], nx = b.st[1];
        if (nloc == 0u) { xcd_barrier_complete(bar, b.x, nloc, nx); b.st[0] = nloc; b.st[1] = nx; }
        const unsigned old = xb_add(&bar[XB_XSUB(b.x)], 1u);
        const unsigned gen = old / nloc;
        if (old + 1u == (gen + 1u) * nloc) {
            __builtin_amdgcn_fence(__ATOMIC_RELEASE, "agent");
            asm volatile("s_waitcnt vmcnt(0)" ::: "memory");
            const unsigned og = xb_add(&bar[XB_TOP], 1u);
            const unsigned tg = og / nx;
            if (og + 1u == (tg + 1u) * nx) xb_add(&bar[XB_TOPGEN], 1u);
            else XB_SPIN(xb_ld(&bar[XB_TOPGEN]) == tg, bar);
            __builtin_amdgcn_fence(__ATOMIC_ACQUIRE, "agent");
            xb_add(&bar[XB_XGEN(b.x)], 1u);
            asm volatile("s_waitcnt vmcnt(0)" ::: "memory");
        } else {
            XB_SPIN(xb_ld(&bar[XB_XGEN(b.x)]) == gen, bar);
            __builtin_amdgcn_fence(__ATOMIC_ACQUIRE, "agent");
            asm volatile("s_waitcnt vmcnt(0)" ::: "memory");
        }
    }
    __syncthreads();
}

constexpr int NWAVES = 8;
constexpr int BATCH = 8, SEQ = 4096, D = 1024, T = BATCH * SEQ, DEPTH = 2;
constexpr int DCONV = 512, NHEAD = 8, HD = 64, DATTN = 512, DFF = 2816, NEXP = 8, DFFE = 2048;
constexpr int NIN = 5120, NPA = 1536, NQK = 1024, NGT = 2048, NPROJ = NPA + NQK + NGT;
constexpr float EPS = 1e-6f;
constexpr float QSCALE = 0.125f * 1.4426950408889634f;
constexpr int MPAD = 2 * T + NEXP * 256;
constexpr int VTP = T + 64;

constexpr size_t MiB = 1u << 20;
constexpr size_t WS_CTL = 0, CTL_ZERO_BYTES = 1 * MiB;
constexpr size_t WS_ROUTE = 1 * MiB;
constexpr size_t WS_SLOTS = WS_ROUTE + 512 * 1024, WS_WGCNT = WS_ROUTE + 768 * 1024;
constexpr size_t WS_WL = 4 * MiB, WL_STRIDE = 14 * MiB;
constexpr size_t WL_WIN = 0, WL_WV = 9 * MiB, WL_WA = 10 * MiB, WL_WB = 11 * MiB, WL_WO = 12 * MiB;
constexpr size_t WS_WGU = 32 * MiB, WS_WD = 43 * MiB;
constexpr size_t WS_H = 50 * MiB;
constexpr size_t WS_UA = WS_H, WS_UB = WS_H + 32 * MiB;
constexpr size_t WS_VT = 114 * MiB;
constexpr size_t WS_GT = 146 * MiB;
constexpr size_t WS_PA = 274 * MiB;
constexpr size_t WS_QF = WS_PA + 96 * MiB, WS_KF = WS_PA + 128 * MiB;
constexpr size_t WS_TMP = 274 * MiB, WS_MIX = 338 * MiB;
constexpr size_t WS_G0 = 146 * MiB;
constexpr size_t WS_WEG = 4 * MiB, WS_WED = 68 * MiB;
constexpr size_t WS_HP = 100 * MiB;
constexpr size_t WS_G1 = 232 * MiB;
constexpr size_t WS_END = 512 * MiB;
static_assert(WS_G1 + (size_t)MPAD * DFFE * 2 <= WS_END && WS_HP + (size_t)MPAD * D * 2 <= WS_G1 && WS_KF + 32 * MiB <= WS_END, "d_ws map");
constexpr int CW_TMO = 0, CW_CODE = 1, CW_BAR = 4096, CW_CNT = 8192;

constexpr int RING_OFF = 0, RING_BYTES = 131072, LDSCTL_OFF = RING_BYTES, MISC_OFF = LDSCTL_OFF + 320, LDS_BYTES = 147456;

typedef unsigned u32x2v __attribute__((ext_vector_type(2)));
__device__ __forceinline__ float wave_sum(float v) {
#pragma unroll
    for (int o = 1; o < 64; o <<= 1) v += __shfl_xor(v, o);
    return v;
}
using pg8::cvt_pk_bf16;
__device__ __forceinline__ void tr_block(const float* W, int K, int N, bf16* dst, int drow, int k0, int n0, LAS float* scr, int lane) {
#pragma unroll 8
    for (int i = 0; i < 32; ++i) { const int kk = 2 * i + (lane >> 5); scr[kk * 33 + (lane & 31)] = W[(size_t)(k0 + kk) * N + n0 + (lane & 31)]; }
    LDS_WAIT(); asm volatile("" ::: "memory");
    const int c = lane & 7;
#pragma unroll
    for (int j = 0; j < 4; ++j) { const int n = (lane >> 3) + 8 * j; const LAS float* s = scr + (8 * c) * 33 + n;
        v4u o; o.x = cvt_pk_bf16(s[0 * 33], s[1 * 33]); o.y = cvt_pk_bf16(s[2 * 33], s[3 * 33]); o.z = cvt_pk_bf16(s[4 * 33], s[5 * 33]); o.w = cvt_pk_bf16(s[6 * 33], s[7 * 33]);
        *(GAS v4u*)(dst + (size_t)(drow + n) * K + k0 + 8 * c) = o; }
    LDS_WAIT(); asm volatile("" ::: "memory");
}
template <int KIND> __device__ __forceinline__ void tr_item(const float* W, int K, int N, bf16* dst, bf16* dst2, LAS float* scr, int item, int lane) {
    const int nblk = N / 32, kb = item / nblk, nb = item % nblk, k0 = 64 * kb, n0 = 32 * nb;
    bf16* d = dst; int drow = n0;
    if (KIND == 1) { if (n0 >= 3072) drow = n0 - 512; else if (n0 >= 2560) { d = dst2; drow = n0 - 2560; } }
    if (KIND == 2) drow = 256 * (n0 / 128) + (n0 % 128);
    if (KIND == 3) drow = 256 * (n0 / 128) + 128 + (n0 % 128);
    tr_block(W, K, N, d, drow, k0, n0, scr, lane);
}
__device__ __forceinline__ void rms_row_to_bf16(const float* xrow, const float* g, bf16* orow, int lane) {
    const GAS f32x4* xr = (const GAS f32x4*)xrow + lane; const GAS f32x4* gr = (const GAS f32x4*)g + lane;
    f32x4 v[4]; float s = 0.f;
#pragma unroll
    for (int j = 0; j < 4; ++j) { v[j] = xr[64 * j]; s += (v[j].x * v[j].x + v[j].y * v[j].y) + (v[j].z * v[j].z + v[j].w * v[j].w); }
    const float rstd = 1.0f / sqrtf(wave_sum(s) * (1.f / D) + EPS);
    GAS u32x2v* o8 = (GAS u32x2v*)orow + lane;
#pragma unroll
    for (int j = 0; j < 4; ++j) { const f32x4 gg = gr[64 * j]; u32x2v w; w.x = cvt_pk_bf16(v[j].x * rstd * gg.x, v[j].y * rstd * gg.y); w.y = cvt_pk_bf16(v[j].z * rstd * gg.z, v[j].w * rstd * gg.w); o8[64 * j] = w; }
}
__device__ __forceinline__ void unpack8f(const v4u w, float (&f)[8]) {
    f[0] = __builtin_bit_cast(float, w.x << 16); f[1] = __builtin_bit_cast(float, w.x & 0xffff0000u); f[2] = __builtin_bit_cast(float, w.y << 16); f[3] = __builtin_bit_cast(float, w.y & 0xffff0000u);
    f[4] = __builtin_bit_cast(float, w.z << 16); f[5] = __builtin_bit_cast(float, w.z & 0xffff0000u); f[6] = __builtin_bit_cast(float, w.w << 16); f[7] = __builtin_bit_cast(float, w.w & 0xffff0000u);
}
__device__ __forceinline__ v4u pack8f(const float (&f)[8]) { v4u w; w.x = cvt_pk_bf16(f[0], f[1]); w.y = cvt_pk_bf16(f[2], f[3]); w.z = cvt_pk_bf16(f[4], f[5]); w.w = cvt_pk_bf16(f[6], f[7]); return w; }

__device__ __forceinline__ void conv_phase(const bf16* PA, const float* cw, bf16* UA, int gid, int nthr) {
    for (int it = gid; it < (T / 16) * 64; it += nthr) {
        const int cg = it & 63, t0 = (it >> 6) * 16, c0 = cg * 8;
        float w0[8], w1[8], w2[8];
#pragma unroll
        for (int i = 0; i < 8; ++i) { w0[i] = cw[c0 + i]; w1[i] = cw[DCONV + c0 + i]; w2[i] = cw[2 * DCONV + c0 + i]; }
        float um2[8], um1[8];
        if ((t0 & (SEQ - 1)) == 0) {
#pragma unroll
            for (int i = 0; i < 8; ++i) { um2[i] = 0.f; um1[i] = 0.f; }
        } else {
            float a[8], b[8];
            unpack8f(*(const GAS v4u*)(PA + (size_t)(t0 - 2) * NPA + c0), a); unpack8f(*(const GAS v4u*)(PA + (size_t)(t0 - 2) * NPA + 1024 + c0), b);
#pragma unroll
            for (int i = 0; i < 8; ++i) um2[i] = a[i] * b[i];
            unpack8f(*(const GAS v4u*)(PA + (size_t)(t0 - 1) * NPA + c0), a); unpack8f(*(const GAS v4u*)(PA + (size_t)(t0 - 1) * NPA + 1024 + c0), b);
#pragma unroll
            for (int i = 0; i < 8; ++i) um1[i] = a[i] * b[i];
        }
#pragma unroll 4
        for (int r = 0; r < 16; ++r) {
            const bf16* row = PA + (size_t)(t0 + r) * NPA + c0;
            float xin[8], bg[8], cgv[8], o[8];
            unpack8f(*(const GAS v4u*)(row), xin); unpack8f(*(const GAS v4u*)(row + 512), bg); unpack8f(*(const GAS v4u*)(row + 1024), cgv);
#pragma unroll
            for (int i = 0; i < 8; ++i) { const float u = cgv[i] * xin[i]; o[i] = bg[i] * (w0[i] * um2[i] + w1[i] * um1[i] + w2[i] * u); um2[i] = um1[i]; um1[i] = u; }
            *(GAS v4u*)(UA + (size_t)(t0 + r) * DCONV + c0) = pack8f(o);
        }
    }
}

typedef float f32x16 __attribute__((ext_vector_type(16)));
__device__ __forceinline__ void attn_mfma(const bf16* QF, const bf16* KF, const bf16* VF, bf16* UB, int gw, int NGW, int lane) {
    const int q = lane & 31, hh = lane >> 5;
    constexpr int NU = BATCH * NHEAD * (SEQ / 32);
    bf16x8 qf[4], kf[4], vf[4];
    if (gw < NU) {
        const size_t o = (size_t)gw * 2048 + lane * 8;
#pragma unroll
        for (int i = 0; i < 4; ++i) { qf[i] = *(const GAS bf16x8*)(QF + o + i * 512); kf[i] = *(const GAS bf16x8*)(KF + o + i * 512); vf[i] = *(const GAS bf16x8*)(VF + o + i * 512); }
    }
#pragma unroll 1
    for (int u = gw; u < NU; u += NGW) {
        const int qb = u & 127, bh = u >> 7, h = bh & 7, b = bh >> 3;
        const size_t rowb = (size_t)b * SEQ;
        bf16x8 qN[4], kN[4], vN[4];
        {
            const int un = (u + NGW < NU) ? u + NGW : u; const size_t o = (size_t)un * 2048 + lane * 8;
#pragma unroll
            for (int i = 0; i < 4; ++i) { qN[i] = *(const GAS bf16x8*)(QF + o + i * 512); kN[i] = *(const GAS bf16x8*)(KF + o + i * 512); vN[i] = *(const GAS bf16x8*)(VF + o + i * 512); }
        }
        __builtin_amdgcn_sched_barrier(0);
        const bf16* const kbase = KF + (size_t)(bh * 128) * 2048 + lane * 8;
        const bf16* const vbase = VF + (size_t)(bh * 128) * 2048 + lane * 8;
        f32x16 o0, o1;
#pragma unroll
        for (int r = 0; r < 16; ++r) { o0[r] = 0.f; o1[r] = 0.f; }
        float R = 1.f;
        bf16x8 kn[4], vn[4];
        const bf16x8 (&qfr)[4] = qf;
        auto block = [&](const bf16x8 (&KF)[4], const bf16x8 (&VF)[4], bf16x8 (&KN)[4], bf16x8 (&VN)[4], const int kb) __attribute__((always_inline)) -> bool {
            {
                const int kbn = kb > 0 ? kb - 1 : 0;
                const bf16* kp = kbase + (size_t)kbn * 2048; const bf16* vp = vbase + (size_t)kbn * 2048;
#pragma unroll
                for (int i = 0; i < 4; ++i) { KN[i] = *(const GAS bf16x8*)(kp + i * 512); VN[i] = *(const GAS bf16x8*)(vp + i * 512); }
            }
            __builtin_amdgcn_sched_barrier(0);
            f32x16 p;
#pragma unroll
            for (int r = 0; r < 16; ++r) p[r] = 0.f;
#pragma unroll
            for (int d0 = 0; d0 < 4; ++d0) p = __builtin_amdgcn_mfma_f32_32x32x16_bf16(KF[d0], qfr[d0], p, 0, 0, 0);
            float rr[16];
            const bool diag = (kb == qb);
#pragma unroll
            for (int r = 0; r < 16; ++r) {
                float e = __builtin_amdgcn_exp2f(p[r]);
                if (diag) { const int kl = (r & 7) + 8 * hh + 16 * (r >> 3); e = (kl < q) ? e : 0.f; }
                rr[r] = __builtin_amdgcn_rcpf(1.0f + e);
            }
            bf16x8 af[2];
#pragma unroll
            for (int s = 1; s >= 0; --s) {
                float g = rr[8 * s];
#pragma unroll
                for (int j = 1; j < 8; ++j) g *= rr[8 * s + j];
                const auto sw = __builtin_amdgcn_permlane32_swap(__float_as_uint(g), __float_as_uint(g), false, false);
                const float g_lo = __uint_as_float(sw[0]), g_hi = __uint_as_float(sw[1]);
                float c = hh ? R : R * g_hi;
                float a[8];
#pragma unroll
                for (int j = 7; j >= 0; --j) { const float cn = c * rr[8 * s + j]; a[j] = c - cn; c = cn; }
                R = R * (g_lo * g_hi);
                typedef unsigned u4 __attribute__((ext_vector_type(4)));
                u4 w; w.x = cvt_pk_bf16(a[0], a[1]); w.y = cvt_pk_bf16(a[2], a[3]); w.z = cvt_pk_bf16(a[4], a[5]); w.w = cvt_pk_bf16(a[6], a[7]);
                af[s] = __builtin_bit_cast(bf16x8, w);
            }
            o0 = __builtin_amdgcn_mfma_f32_32x32x16_bf16(VF[0], af[0], o0, 0, 0, 0);
            o0 = __builtin_amdgcn_mfma_f32_32x32x16_bf16(VF[1], af[1], o0, 0, 0, 0);
            o1 = __builtin_amdgcn_mfma_f32_32x32x16_bf16(VF[2], af[0], o1, 0, 0, 0);
            o1 = __builtin_amdgcn_mfma_f32_32x32x16_bf16(VF[3], af[1], o1, 0, 0, 0);
            return kb == 0 || __builtin_amdgcn_ballot_w64(R != 0.f) == 0ull;
        };
#pragma unroll 1
        for (int kb = qb;; kb -= 2) {
            if (block(kf, vf, kn, vn, kb)) break;
            if (block(kn, vn, kf, vf, kb - 1)) break;
        }
        bf16* op = UB + (rowb + 32 * qb + q) * DATTN + h * 64 + 4 * hh;
#pragma unroll
        for (int g4 = 0; g4 < 4; ++g4) {
            u32x2v w0, w1;
            w0.x = cvt_pk_bf16(o0[4 * g4], o0[4 * g4 + 1]); w0.y = cvt_pk_bf16(o0[4 * g4 + 2], o0[4 * g4 + 3]);
            w1.x = cvt_pk_bf16(o1[4 * g4], o1[4 * g4 + 1]); w1.y = cvt_pk_bf16(o1[4 * g4 + 2], o1[4 * g4 + 3]);
            *(GAS u32x2v*)(op + 8 * g4) = w0; *(GAS u32x2v*)(op + 32 + 8 * g4) = w1;
        }
#pragma unroll
        for (int i = 0; i < 4; ++i) { qf[i] = qN[i]; kf[i] = kN[i]; vf[i] = vN[i]; }
    }
}

#ifndef REP_P0
#define REP_P0 1
#endif
#ifndef REP_P1
#define REP_P1 1
#endif
#ifndef REP_P2
#define REP_P2 1
#endif
#ifndef REP_ATT
#define REP_ATT 1
#endif
#ifndef REP_R1A
#define REP_R1A 1
#endif
struct Args { const float* in[16]; float* out; unsigned char* ws; };
typedef const __attribute__((address_space(4))) Args* KArgP;
__device__ __forceinline__ KArgP launder_k(KArgP p) { asm volatile("" : "+s"(p)); return p; }
__device__ __forceinline__ int launder_s(int v) { asm volatile("" : "+s"(v)); return v; }
__device__ __forceinline__ int launder_v(int v) { asm volatile("" : "+v"(v)); return v; }
#define PH_BEGIN { const KArgP ap = launder_k(kp0); unsigned char* const ws = ap->ws; const int bx = launder_s(bx0), G = launder_s(G0); const int tid = launder_v(tid0), lane = tid & 63, wave = __builtin_amdgcn_readfirstlane(tid >> 6); \
    const int gid = bx * (NWAVES * 64) + tid, nthr = G * NWAVES * 64, gw = bx * NWAVES + wave, NGW = G * NWAVES; (void)gid; (void)nthr; (void)gw; (void)NGW; (void)lane; \
    LAS float* const scr = (LAS float*)(lds + RING_OFF + wave * 16384); (void)scr; (void)ws;
#define PH_END(BARRIER) if (BARRIER) xcd_barrier(bar); }
#define WSP(T_, off) ((T_*)(ws + (off)))

__global__ void __launch_bounds__(NWAVES * 64, 2) mega_fwd(Args args) {
    extern __shared__ __attribute__((aligned(16))) unsigned char lds_raw[];
    LAS unsigned char* const lds = (LAS unsigned char*)lds_raw;
    volatile LAS unsigned* const MISC = (volatile LAS unsigned*)(lds + MISC_OFF);
    const KArgP kp0 = (KArgP)__builtin_amdgcn_kernarg_segment_ptr();
    const int tid0 = threadIdx.x, G0 = gridDim.x, bx0 = blockIdx.x;
    for (int u = tid0; u < (LDS_BYTES - LDSCTL_OFF) / 4; u += NWAVES * 64) ((LAS unsigned*)(lds + LDSCTL_OFF))[u] = 0u;
    __syncthreads();
#ifdef PROBE_CLK
    long long probe_cycles = 0;
#endif
    XcdBarrier bar = xcd_barrier_post((unsigned*)(args.ws + WS_CTL) + CW_BAR, MISC + 8);

#pragma unroll 1
    for (int rep = 0; rep < REP_P0; ++rep)
    PH_BEGIN
        constexpr int I_IN = 16 * 160, I_BR = 8 * 32, I_O = 16 * 32, I_GU = 16 * 88, I_D = 44 * 32;
        constexpr int PER_L = I_IN + 2 * I_BR + I_O, NITEMS = 2 * PER_L + 2 * I_GU + I_D;
#pragma unroll 1
        for (int it = gw; it < NITEMS; it += NGW) {
            int r = it;
            if (r < 2 * PER_L) {
                const int l = r / PER_L; r -= l * PER_L; unsigned char* wl = ws + WS_WL + (size_t)l * WL_STRIDE;
                if (r < I_IN) { tr_item<1>(ap->in[2] + (size_t)l * D * NIN, D, NIN, (bf16*)(wl + WL_WIN), (bf16*)(wl + WL_WV), scr, r, lane); continue; } r -= I_IN;
                if (r < I_BR) { tr_item<0>(ap->in[4] + (size_t)l * DCONV * D, DCONV, D, (bf16*)(wl + WL_WA), nullptr, scr, r, lane); continue; } r -= I_BR;
                if (r < I_BR) { tr_item<0>(ap->in[5] + (size_t)l * DATTN * D, DATTN, D, (bf16*)(wl + WL_WB), nullptr, scr, r, lane); continue; } r -= I_BR;
                tr_item<0>(ap->in[6] + (size_t)l * D * D, D, D, (bf16*)(wl + WL_WO), nullptr, scr, r, lane); continue;
            }
            r -= 2 * PER_L;
            if (r < I_GU) { tr_item<2>(ap->in[8], D, DFF, WSP(bf16, WS_WGU), nullptr, scr, r, lane); continue; } r -= I_GU;
            if (r < I_GU) { tr_item<3>(ap->in[9], D, DFF, WSP(bf16, WS_WGU), nullptr, scr, r, lane); continue; } r -= I_GU;
            tr_item<0>(ap->in[10], DFF, D, WSP(bf16, WS_WD), nullptr, scr, r, lane);
        }
#pragma unroll 1
        for (int m = gw; m < T; m += NGW) rms_row_to_bf16(ap->in[0] + (size_t)m * D, ap->in[1], WSP(bf16, WS_H) + (size_t)m * D, lane);
    PH_END(true)

#pragma unroll 1
    for (int l = 0; l < DEPTH; ++l) {
#pragma unroll 1
        for (int rep = 0; rep < REP_P1; ++rep) {
        PH_BEGIN
            unsigned char* wl = ws + WS_WL + (size_t)l * WL_STRIDE;
            pg8::Gemm g{WSP(bf16, WS_H), (const bf16*)(wl + WL_WIN), T, NPROJ, D}; pg8::StaticOrder S; S.init(T, NPROJ, G, bx);
#ifdef PROBE_NULL
            if (rep == 0) { pg8::EpiNull E0; pg8::gemm_phase<pg8::EpiNull, pg8::StaticOrder, true, true>(lds + RING_OFF, g, S, E0, tid); } else
#endif
            {
#ifdef PROBE_CLK
            long long c0_ = clock64();
#endif
            pg8::EpiProj E{WSP(bf16, WS_PA), WSP(bf16, WS_QF), WSP(bf16, WS_KF), WSP(bf16, WS_GT), QSCALE};
            pg8::gemm_phase<pg8::EpiProj, pg8::StaticOrder, true, true>(lds + RING_OFF, g, S, E, tid);
#ifdef PROBE_CLK
            if (l == 0) probe_cycles = clock64() - c0_;
#endif
            }
        PH_END(false)
        PH_BEGIN
            unsigned char* wl = ws + WS_WL + (size_t)l * WL_STRIDE;
            pg8::Gemm g{(const bf16*)(wl + WL_WV), WSP(bf16, WS_H), DATTN, T, D}; pg8::StaticOrder S; S.init(DATTN, T, G, bx);
#ifdef PROBE_NULL
            if (rep == 0) { pg8::EpiNull E0; pg8::gemm_phase<pg8::EpiNull, pg8::StaticOrder, true, true>(lds + RING_OFF, g, S, E0, tid); } else
#endif
            { pg8::EpiVT E{WSP(bf16, WS_VT)};
            pg8::gemm_phase<pg8::EpiVT, pg8::StaticOrder, true, true>(lds + RING_OFF, g, S, E, tid); }
        PH_END(true)
        }
#pragma unroll 1
        for (int rep = 0; rep < REP_P2; ++rep) {
        PH_BEGIN
            conv_phase(WSP(bf16, WS_PA), ap->in[3] + (size_t)l * 3 * DCONV, WSP(bf16, WS_UA), gid, nthr);
        PH_END(false)
#pragma unroll 1
        for (int rep2 = 0; rep2 < REP_ATT; ++rep2) {
        PH_BEGIN
            attn_mfma(WSP(bf16, WS_QF), WSP(bf16, WS_KF), WSP(bf16, WS_VT), WSP(bf16, WS_UB), gw, NGW, lane);
        PH_END(rep2 == REP_ATT - 1)
        }
        }
        PH_BEGIN
            unsigned char* wl = ws + WS_WL + (size_t)l * WL_STRIDE;
            pg8::Gemm g{WSP(bf16, WS_UA), (const bf16*)(wl + WL_WA), T, D, DCONV}; pg8::StaticOrder S; S.init(T, D, G, bx);
            pg8::EpiGateA E{WSP(bf16, WS_GT), WSP(bf16, WS_TMP)};
            pg8::gemm_phase<pg8::EpiGateA, pg8::StaticOrder, true, true>(lds + RING_OFF, g, S, E, tid);
        PH_END(false)
        PH_BEGIN
            unsigned char* wl = ws + WS_WL + (size_t)l * WL_STRIDE;
            pg8::Gemm g{WSP(bf16, WS_UB), (const bf16*)(wl + WL_WB), T, D, DATTN}; pg8::StaticOrder S; S.init(T, D, G, bx);
            pg8::EpiGateB E{WSP(bf16, WS_GT), WSP(bf16, WS_TMP), WSP(bf16, WS_MIX)};
            pg8::gemm_phase<pg8::EpiGateB, pg8::StaticOrder, true, true>(lds + RING_OFF, g, S, E, tid);
        PH_END(true)
        PH_BEGIN
            unsigned char* wl = ws + WS_WL + (size_t)l * WL_STRIDE;
            pg8::Gemm g{WSP(bf16, WS_MIX), (const bf16*)(wl + WL_WO), T, D, D}; pg8::StaticOrder S; S.init(T, D, G, bx);
            pg8::EpiRes E{l == 0 ? ap->in[0] : (const float*)ap->out, ap->out, D};
            pg8::gemm_phase<pg8::EpiRes, pg8::StaticOrder, true, true>(lds + RING_OFF, g, S, E, tid);
        PH_END(true)
        if (l == 0) {
            PH_BEGIN
#pragma unroll 1
                for (int m = gw; m < T; m += NGW) rms_row_to_bf16(ap->out + (size_t)m * D, ap->in[7], WSP(bf16, WS_H) + (size_t)m * D, lane);
            PH_END(true)
            PH_BEGIN
                pg8::Gemm g{WSP(bf16, WS_H), WSP(bf16, WS_WGU), T, 2 * DFF, D}; pg8::StaticOrder S; S.init(T, 2 * DFF, G, bx);
                pg8::EpiSwiGLU E{WSP(bf16, WS_G0), DFF};
                pg8::gemm_phase<pg8::EpiSwiGLU, pg8::StaticOrder, true, true>(lds + RING_OFF, g, S, E, tid);
            PH_END(true)
            PH_BEGIN
                pg8::Gemm g{WSP(bf16, WS_G0), WSP(bf16, WS_WD), T, D, DFF}; pg8::StaticOrder S; S.init(T, D, G, bx);
#ifdef PROBE_P7NULL
                { pg8::EpiNull E0; pg8::gemm_phase<pg8::EpiNull, pg8::StaticOrder, true, true>(lds + RING_OFF, g, S, E0, tid); }
#endif
                pg8::EpiRes E{ap->out, ap->out, D};
                pg8::gemm_phase<pg8::EpiRes, pg8::StaticOrder, true, true>(lds + RING_OFF, g, S, E, tid);
            PH_END(true)
            PH_BEGIN
#pragma unroll 1
                for (int m = gw; m < T; m += NGW) rms_row_to_bf16(ap->out + (size_t)m * D, ap->in[1] + D, WSP(bf16, WS_H) + (size_t)m * D, lane);
            PH_END(true)
        } else {
            volatile LAS int* const lcnt = (volatile LAS int*)(MISC + 32);
            volatile LAS unsigned* const loff = MISC + 16;
            volatile LAS int* const lbase = (volatile LAS int*)(MISC + 48);
#pragma unroll 1
            for (int rep = 0; rep < REP_R1A; ++rep)
            PH_BEGIN
                constexpr int I_E = 16 * 64;
#pragma unroll 1
                for (int it = gw; it < NEXP * 3 * I_E; it += NGW) {
                    const int e = it / (3 * I_E); int r = it - e * 3 * I_E;
                    if (r < I_E) { tr_item<2>(ap->in[12] + (size_t)e * D * DFFE, D, DFFE, WSP(bf16, WS_WEG) + (size_t)e * 2 * DFFE * D, nullptr, scr, r, lane); continue; } r -= I_E;
                    if (r < I_E) { tr_item<3>(ap->in[13] + (size_t)e * D * DFFE, D, DFFE, WSP(bf16, WS_WEG) + (size_t)e * 2 * DFFE * D, nullptr, scr, r, lane); continue; } r -= I_E;
                    tr_item<0>(ap->in[14] + (size_t)e * DFFE * D, DFFE, D, WSP(bf16, WS_WED) + (size_t)e * D * DFFE, nullptr, scr, r, lane);
                }
            PH_END(false)
            PH_BEGIN
                int4* route = WSP(int4, WS_ROUTE); int* wgcnt = WSP(int, WS_WGCNT); gu32* ctl = (gu32*)(ws + WS_CTL);
                const int rpw = T / G, r0 = bx * rpw, r1 = r0 + rpw;
                const float* xres = ap->out; const float* gf = ap->in[7] + D; const float* w_router = ap->in[11];
                if (tid < 8) lcnt[tid] = 0;
                __syncthreads();
#pragma unroll 1
                for (int m = r0 + wave; m < r1; m += NWAVES) {
                    const GAS f32x4* xr = (const GAS f32x4*)(xres + (size_t)m * D) + lane; const GAS f32x4* gr = (const GAS f32x4*)gf + lane;
                    f32x4 v[4]; float s = 0.f;
#pragma unroll
                    for (int j = 0; j < 4; ++j) { v[j] = xr[64 * j]; s += (v[j].x * v[j].x + v[j].y * v[j].y) + (v[j].z * v[j].z + v[j].w * v[j].w); }
                    const float rstd = 1.0f / sqrtf(wave_sum(s) * (1.f / D) + EPS);
                    float lg[8];
#pragma unroll
                    for (int e = 0; e < 8; ++e) lg[e] = 0.f;
#pragma unroll
                    for (int j = 0; j < 4; ++j) { const f32x4 gg = gr[64 * j];
#pragma unroll
                        for (int c = 0; c < 4; ++c) { const float hn = v[j][c] * rstd * gg[c]; const int i = 256 * j + 4 * lane + c;
                            const f32x4 wa = *(const GAS f32x4*)(w_router + (size_t)i * 8), wb = *(const GAS f32x4*)(w_router + (size_t)i * 8 + 4);
                            lg[0] += hn * wa.x; lg[1] += hn * wa.y; lg[2] += hn * wa.z; lg[3] += hn * wa.w; lg[4] += hn * wb.x; lg[5] += hn * wb.y; lg[6] += hn * wb.z; lg[7] += hn * wb.w; } }
#pragma unroll
                    for (int e = 0; e < 8; ++e) lg[e] = wave_sum(lg[e]);
                    int e1 = 0; float v1 = lg[0];
#pragma unroll
                    for (int e = 1; e < 8; ++e) if (lg[e] > v1) { v1 = lg[e]; e1 = e; }
                    int e2 = -1; float v2 = -INFINITY;
#pragma unroll
                    for (int e = 0; e < 8; ++e) if (e != e1 && lg[e] > v2) { v2 = lg[e]; e2 = e; }
                    if (e2 < 0) e2 = (e1 + 1) & 7;
                    const float ex = __expf(v2 - v1), w1 = 1.0f / (1.0f + ex), w2 = ex * w1;
                    if (lane == 0) { route[m] = make_int4(e1, e2, __float_as_int(w1), __float_as_int(w2)); atomicAdd((int*)(lcnt + e1), 1); atomicAdd((int*)(lcnt + e2), 1); }
                }
                __syncthreads();
                if (tid < 8) { const int c = lcnt[tid]; wgcnt[bx * 8 + tid] = c; __hip_atomic_fetch_add((unsigned*)(ctl + CW_CNT + tid), (unsigned)c, RLX_AGENT); }
            PH_END(true)
            PH_BEGIN
                int4* route = WSP(int4, WS_ROUTE); int2* slots = WSP(int2, WS_SLOTS); int* wgcnt = WSP(int, WS_WGCNT); gu32* ctl = (gu32*)(ws + WS_CTL); bf16* HP = WSP(bf16, WS_HP);
                const int rpw = T / G, r0 = bx * rpw, r1 = r0 + rpw;
                const float* xres = ap->out; const float* gf = ap->in[7] + D;
                { int s = 0; for (int w = lane; w < bx; w += 64) s += wgcnt[w * 8 + wave]; s = (int)wave_sum((float)s);
                  if (lane == 0) { lbase[wave] = s; lcnt[wave] = 0; } }
                if (tid == 0) { unsigned off = 0; for (int e = 0; e < 8; ++e) { loff[e] = off; off += (__hip_atomic_load((unsigned*)(ctl + CW_CNT + e), RLX_AGENT) + 255u) & ~255u; } loff[8] = off; }
                __syncthreads();
#pragma unroll 1
                for (int m = r0 + wave; m < r1; m += NWAVES) {
                    int s1 = 0, s2 = 0;
                    if (lane == 0) { const int4 rt = route[m]; s1 = (int)loff[rt.x] + lbase[rt.x] + atomicAdd((int*)(lcnt + rt.x), 1); s2 = (int)loff[rt.y] + lbase[rt.y] + atomicAdd((int*)(lcnt + rt.y), 1); slots[m] = make_int2(s1, s2); }
                    s1 = __builtin_amdgcn_readfirstlane(s1); s2 = __builtin_amdgcn_readfirstlane(s2);
                    const GAS f32x4* xr = (const GAS f32x4*)(xres + (size_t)m * D) + lane; const GAS f32x4* gr = (const GAS f32x4*)gf + lane;
                    f32x4 v[4]; float s = 0.f;
#pragma unroll
                    for (int j = 0; j < 4; ++j) { v[j] = xr[64 * j]; s += (v[j].x * v[j].x + v[j].y * v[j].y) + (v[j].z * v[j].z + v[j].w * v[j].w); }
                    const float rstd = 1.0f / sqrtf(wave_sum(s) * (1.f / D) + EPS);
                    GAS u32x2v* o1 = (GAS u32x2v*)(HP + (size_t)s1 * D) + lane; GAS u32x2v* o2 = (GAS u32x2v*)(HP + (size_t)s2 * D) + lane;
#pragma unroll
                    for (int j = 0; j < 4; ++j) { const f32x4 gg = gr[64 * j]; u32x2v w; w.x = cvt_pk_bf16(v[j].x * rstd * gg.x, v[j].y * rstd * gg.y); w.y = cvt_pk_bf16(v[j].z * rstd * gg.z, v[j].w * rstd * gg.w); o1[64 * j] = w; o2[64 * j] = w; }
                }
            PH_END(true)
            PH_BEGIN
                const int mrows = (int)loff[8];
                pg8::Gemm g{WSP(bf16, WS_HP), WSP(bf16, WS_WEG), mrows, 2 * DFFE, D}; pg8::MoeOrder S; S.init(mrows, 2 * DFFE, G, bx); S.offs = loff; S.ntn = 2 * DFFE / 256;
                pg8::EpiSwiGLU E{WSP(bf16, WS_G1), DFFE};
                pg8::gemm_phase<pg8::EpiSwiGLU, pg8::MoeOrder, true, true>(lds + RING_OFF, g, S, E, tid);
            PH_END(true)
            PH_BEGIN
                const int mrows = (int)loff[8];
                pg8::Gemm g{WSP(bf16, WS_G1), WSP(bf16, WS_WED), mrows, D, DFFE}; pg8::MoeOrder S; S.init(mrows, D, G, bx); S.offs = loff; S.ntn = D / 256;
                pg8::EpiPlain E{WSP(bf16, WS_HP), D};
                pg8::gemm_phase<pg8::EpiPlain, pg8::MoeOrder, true, true>(lds + RING_OFF, g, S, E, tid);
            PH_END(true)
            PH_BEGIN
                const int4* route = WSP(int4, WS_ROUTE); const int2* slots = WSP(int2, WS_SLOTS); const bf16* HP = WSP(bf16, WS_HP); float* xres = ap->out; const float* g_final = ap->in[15];
#pragma unroll 1
                for (int m = gw; m < T; m += NGW) {
                    const int4 rt = route[m]; const int2 sl = slots[m]; const float w1 = __int_as_float(rt.z), w2 = __int_as_float(rt.w);
                    GAS f32x4* xr = (GAS f32x4*)(xres + (size_t)m * D) + lane; const GAS f32x4* gr = (const GAS f32x4*)g_final + lane;
                    const GAS u32x2v* y1 = (const GAS u32x2v*)(HP + (size_t)sl.x * D) + lane; const GAS u32x2v* y2 = (const GAS u32x2v*)(HP + (size_t)sl.y * D) + lane;
                    f32x4 v[4]; float s = 0.f;
#pragma unroll
                    for (int j = 0; j < 4; ++j) { v[j] = xr[64 * j]; const u32x2v a = y1[64 * j], b = y2[64 * j];
                        v[j].x += w1 * __builtin_bit_cast(float, a.x << 16) + w2 * __builtin_bit_cast(float, b.x << 16);
                        v[j].y += w1 * __builtin_bit_cast(float, a.x & 0xffff0000u) + w2 * __builtin_bit_cast(float, b.x & 0xffff0000u);
                        v[j].z += w1 * __builtin_bit_cast(float, a.y << 16) + w2 * __builtin_bit_cast(float, b.y << 16);
                        v[j].w += w1 * __builtin_bit_cast(float, a.y & 0xffff0000u) + w2 * __builtin_bit_cast(float, b.y & 0xffff0000u);
                        s += (v[j].x * v[j].x + v[j].y * v[j].y) + (v[j].z * v[j].z + v[j].w * v[j].w); }
                    const float rstd = 1.0f / sqrtf(wave_sum(s) * (1.f / D) + EPS);
#pragma unroll
                    for (int j = 0; j < 4; ++j) { const f32x4 gg = gr[64 * j]; xr[64 * j] = (f32x4){v[j].x * rstd * gg.x, v[j].y * rstd * gg.y, v[j].z * rstd * gg.z, v[j].w * rstd * gg.w}; }
                }
            PH_END(false)
        }
    }
#ifdef PROBE_CLK
    if (blockIdx.x == 0) { const unsigned long long t0_ = __builtin_amdgcn_s_memrealtime(); const unsigned long long want = (unsigned long long)(probe_cycles / 64); while (__builtin_amdgcn_s_memrealtime() - t0_ < want) __builtin_amdgcn_s_sleep(4); }
#endif
}

extern "C" void kernel_launch(void* const* d_in, const int* in_sizes, int n_in, void* d_out, int out_size, void* d_ws, size_t ws_size, hipStream_t stream) {
    static int grid = 0;
    if (grid == 0) {
        if (n_in != 16 || in_sizes[0] != T * D || out_size != T * D || ws_size < WS_END) { fprintf(stderr, "kernel_launch: unexpected shapes (n_in %d, in0 %d, out %d, ws %zu); nothing launched\n", n_in, n_in > 0 ? in_sizes[0] : -1, out_size, ws_size); grid = -1; return; }
        int dev = 0, cus = 0, per_cu = 0;
        if (hipGetDevice(&dev) != hipSuccess || hipDeviceGetAttribute(&cus, hipDeviceAttributeMultiprocessorCount, dev) != hipSuccess) { grid = -1; return; }
        if (hipFuncSetAttribute((const void*)mega_fwd, hipFuncAttributeMaxDynamicSharedMemorySize, LDS_BYTES) != hipSuccess) { fprintf(stderr, "kernel_launch: hipFuncSetAttribute failed\n"); grid = -1; return; }
        if (hipOccupancyMaxActiveBlocksPerMultiprocessor(&per_cu, (const void*)mega_fwd, NWAVES * 64, LDS_BYTES) != hipSuccess || per_cu < 1) { fprintf(stderr, "kernel_launch: occupancy query reports %d workgroups per CU\n", per_cu); }
        (void)hipGetLastError();
        grid = cus;
        while (grid > 1 && (T % grid) != 0) --grid;
    }
    if (grid < 0) return;
    if (hipMemsetAsync((char*)d_ws + WS_CTL, 0, CTL_ZERO_BYTES, stream) != hipSuccess) return;
    Args a{};
    for (int i = 0; i < 16; ++i) a.in[i] = (const float*)d_in[i];
    a.out = (float*)d_out; a.ws = (unsigned char*)d_ws;
    hipLaunchKernelGGL(mega_fwd, dim3(grid), dim3(NWAVES * 64), LDS_BYTES, stream, a);
}
```

```cpp
#include <hip/hip_runtime.h>
#include <cstdio>
#include <cstdint>
#include <cmath>
#ifndef PG8_RELAX
#define PG8_RELAX 1
#endif
namespace pg8 {
#define PG8_LAS __attribute__((address_space(3)))
typedef unsigned short bf16_t;
typedef short bf16x8 __attribute__((ext_vector_type(8)));
typedef float f32x4 __attribute__((ext_vector_type(4)));
typedef unsigned u32x4 __attribute__((ext_vector_type(4)));
constexpr int BM = 256, BK = 64, HALF = 128, HTB = HALF * BK * 2  , STAGE_BYTES = 8 * HTB, NXCD = 8, WGM = 8;

__host__ __device__ __forceinline__ int lds_byte(int r, int c) { const int st = (r >> 4) * 2 + (c >> 5), rr = r & 15, cc = c & 31, ob = rr * 64 + cc * 2; return st * 1024 + (ob ^ (((ob >> 9) & 1) << 5)); }
__host__ __device__ __forceinline__ void stage_rc(int b, int& R, int& C) { const int st = b / 1024, sb = b % 1024, swz = sb ^ (((sb >> 9) & 1) << 5); R = (st >> 1) * 16 + swz / 64; C = (st & 1) * 32 + (swz % 64) / 2; }
__host__ __device__ __forceinline__ int perm32(int rho) { const int n = rho >> 4, i = rho & 15; return 8 * (i >> 2) + 4 * n + (i & 3); }

struct Unit { int pm, pn, pb; };
struct Gemm { const bf16_t* A; const bf16_t* Bt; int M, N, K; };

struct StaticOrder {
    int nM, nN, nwg, G, c;
    __host__ __device__ void init(int M, int N, int G_, int c_) { nM = M / BM; nN = N / BM; nwg = nM * nN; G = G_; c = c_; }
    __host__ __device__ bool next(int i, Unit& u) const {
        const long L = (long)i * G + c; if (L >= nwg) return false;
        int wgid = (int)L; { const int q = nwg / NXCD, r = nwg % NXCD, xcd = wgid % NXCD, off = wgid / NXCD; wgid = (xcd < r ? xcd * (q + 1) : r * (q + 1) + (xcd - r) * q) + off; }
        const int nig = WGM * nN, gid = wgid / nig, fm = gid * WGM, gsz = (nM - fm) < WGM ? (nM - fm) : WGM;
        u.pm = fm + ((wgid % nig) % gsz); u.pn = (wgid % nig) / gsz; u.pb = u.pn; return true;
    }
    __device__ __forceinline__ void a_ready(const Unit&) const {}
    __device__ __forceinline__ void done(const Unit&) const {}
};

__device__ __forceinline__ unsigned cvt_pk_bf16(float lo, float hi) { unsigned r; asm volatile("v_cvt_pk_bf16_f32 %0, %1, %2" : "=v"(r) : "v"(lo), "v"(hi)); return r; }
typedef float f32x2 __attribute__((ext_vector_type(2)));

__device__ __forceinline__ float sigmoidf_fast(float x) { return __builtin_amdgcn_rcpf(1.0f + __builtin_amdgcn_exp2f(-1.4426950408889634f * x)); }
__device__ __forceinline__ float bf_lo(unsigned w) { return __builtin_bit_cast(float, w << 16); }
__device__ __forceinline__ float bf_hi(unsigned w) { return __builtin_bit_cast(float, w & 0xffff0000u); }
__device__ __forceinline__ void unpack8(const u32x4 w, float (&f)[8]) { f[0] = bf_lo(w.x); f[1] = bf_hi(w.x); f[2] = bf_lo(w.y); f[3] = bf_hi(w.y); f[4] = bf_lo(w.z); f[5] = bf_hi(w.z); f[6] = bf_lo(w.w); f[7] = bf_hi(w.w); }
__device__ __forceinline__ u32x4 pack8(const float (&f)[8]) { u32x4 w; w.x = cvt_pk_bf16(f[0], f[1]); w.y = cvt_pk_bf16(f[2], f[3]); w.z = cvt_pk_bf16(f[4], f[5]); w.w = cvt_pk_bf16(f[6], f[7]); return w; }

struct EpiProj {
    static constexpr int NVMEM = 16;
    static constexpr bool PERM = true, AFTER_DRAIN = false;
    bf16_t* PA; bf16_t* QF; bf16_t* KF; bf16_t* GT; float qscale;
    __device__ __forceinline__ void operator()(const f32x4 (&acc)[2][2][4][2], const Unit& u, int wr, int wc, int fr, int fq) const {
        const int row0 = u.pm * BM + wr * 64 + fr;
        if (u.pn >= 6 && u.pn < 10) {
            const bool isq = u.pn < 8; const float sc = isq ? qscale : 1.f; bf16_t* base = isq ? QF : KF;
            const int hc0 = (u.pn - (isq ? 6 : 8)) * BM + wc * 32 + 8 * fq;
#pragma unroll
            for (int ai = 0; ai < 2; ++ai)
#pragma unroll
                for (int m = 0; m < 4; ++m) { const int row = row0 + ai * HALF + m * 16; const int b = row >> 12, t = row & 4095, blk = t >> 5, tl = t & 31;
                    const int li = isq ? tl : ((tl & 19) | ((tl & 4) << 1) | ((tl & 8) >> 1));
#pragma unroll
                    for (int bj = 0; bj < 2; ++bj) { const int hc = hc0 + bj * HALF, h = hc >> 6, c = (hc & 63) >> 3, d0 = c >> 1, hg = c & 1;
                        const f32x4 v0 = acc[ai][bj][m][0] * sc, v1 = acc[ai][bj][m][1] * sc;
                        u32x4 w; w.x = cvt_pk_bf16(v0[0], v0[1]); w.y = cvt_pk_bf16(v0[2], v0[3]); w.z = cvt_pk_bf16(v1[0], v1[1]); w.w = cvt_pk_bf16(v1[2], v1[3]);
                        *(u32x4*)(base + ((((size_t)(b * 8 + h) * 128 + blk) * 4 + d0) * 64 + hg * 32 + li) * 8) = w; } }
            return;
        }
        bf16_t* base; int ldc, colt;
        if (u.pn < 6) { base = PA; ldc = 1536; colt = u.pn * BM; } else { base = GT; ldc = 2048; colt = (u.pn - 10) * BM; }
        const int col0 = colt + wc * 32 + 8 * fq;
#pragma unroll
        for (int ai = 0; ai < 2; ++ai)
#pragma unroll
            for (int m = 0; m < 4; ++m) { bf16_t* rowp = base + (size_t)(row0 + ai * HALF + m * 16) * ldc + col0;
#pragma unroll
                for (int bj = 0; bj < 2; ++bj) { const f32x4 v0 = acc[ai][bj][m][0], v1 = acc[ai][bj][m][1];
                    u32x4 w; w.x = cvt_pk_bf16(v0[0], v0[1]); w.y = cvt_pk_bf16(v0[2], v0[3]); w.z = cvt_pk_bf16(v1[0], v1[1]); w.w = cvt_pk_bf16(v1[2], v1[3]);
                    *(u32x4*)(rowp + bj * HALF) = w; } }
    }
};
struct EpiVT {
    static constexpr int NVMEM = 16;
    static constexpr bool PERM = true, AFTER_DRAIN = false;
    bf16_t* VF;
    __device__ __forceinline__ void operator()(const f32x4 (&acc)[2][2][4][2], const Unit& u, int wr, int wc, int fr, int fq) const {
        const int row0 = u.pm * BM + wr * 64 + fr, tok0 = u.pn * BM + wc * 32 + 8 * fq;
#pragma unroll
        for (int ai = 0; ai < 2; ++ai)
#pragma unroll
            for (int m = 0; m < 4; ++m) { const int hd = row0 + ai * HALF + m * 16, h = hd >> 6, dblk = (hd >> 5) & 1, dl = hd & 31;
#pragma unroll
                for (int bj = 0; bj < 2; ++bj) { const int tok = tok0 + bj * HALF, b = tok >> 12, t = tok & 4095, blk = t >> 5, s = (t >> 4) & 1, hg = (t >> 3) & 1;
                    const f32x4 v0 = acc[ai][bj][m][0], v1 = acc[ai][bj][m][1];
                    u32x4 w; w.x = cvt_pk_bf16(v0[0], v0[1]); w.y = cvt_pk_bf16(v0[2], v0[3]); w.z = cvt_pk_bf16(v1[0], v1[1]); w.w = cvt_pk_bf16(v1[2], v1[3]);
                    *(u32x4*)(VF + ((((size_t)(b * 8 + h) * 128 + blk) * 4 + dblk * 2 + s) * 64 + hg * 32 + dl) * 8) = w; } }
    }
};
struct EpiPlain {
    static constexpr int NVMEM = 16;
    static constexpr bool PERM = true, AFTER_DRAIN = false;
    bf16_t* O; int ldc;
    __device__ __forceinline__ void operator()(const f32x4 (&acc)[2][2][4][2], const Unit& u, int wr, int wc, int fr, int fq) const {
        const int row0 = u.pm * BM + wr * 64 + fr, col0 = u.pn * BM + wc * 32 + 8 * fq;
#pragma unroll
        for (int ai = 0; ai < 2; ++ai)
#pragma unroll
            for (int m = 0; m < 4; ++m) { bf16_t* rowp = O + (size_t)(row0 + ai * HALF + m * 16) * ldc + col0;
#pragma unroll
                for (int bj = 0; bj < 2; ++bj) { const f32x4 v0 = acc[ai][bj][m][0], v1 = acc[ai][bj][m][1];
                    u32x4 w; w.x = cvt_pk_bf16(v0[0], v0[1]); w.y = cvt_pk_bf16(v0[2], v0[3]); w.z = cvt_pk_bf16(v1[0], v1[1]); w.w = cvt_pk_bf16(v1[2], v1[3]);
                    *(u32x4*)(rowp + bj * HALF) = w; } }
    }
};
struct EpiSwiGLU {
    static constexpr int NVMEM = 8;
    static constexpr bool PERM = true, AFTER_DRAIN = false;
    bf16_t* O; int ldc;
    __device__ __forceinline__ void operator()(const f32x4 (&acc)[2][2][4][2], const Unit& u, int wr, int wc, int fr, int fq) const {
        const int row0 = u.pm * BM + wr * 64 + fr, col0 = u.pn * HALF + wc * 32 + 8 * fq;
#pragma unroll
        for (int ai = 0; ai < 2; ++ai)
#pragma unroll
            for (int m = 0; m < 4; ++m) { bf16_t* rowp = O + (size_t)(row0 + ai * HALF + m * 16) * ldc + col0;
                float o[8];
#pragma unroll
                for (int n = 0; n < 2; ++n)
#pragma unroll
                    for (int i = 0; i < 4; ++i) { const float g = acc[ai][0][m][n][i], up = acc[ai][1][m][n][i]; o[4 * n + i] = g * sigmoidf_fast(g) * up; }
                *(u32x4*)rowp = pack8(o); }
    }
};
struct EpiGateA {
    static constexpr int NVMEM = 16;
    static constexpr bool PERM = true, AFTER_DRAIN = false;
    const bf16_t* GT; bf16_t* TMP;
    __device__ __forceinline__ void operator()(const f32x4 (&acc)[2][2][4][2], const Unit& u, int wr, int wc, int fr, int fq) const {
        const int row0 = u.pm * BM + wr * 64 + fr, col0 = u.pn * BM + wc * 32 + 8 * fq;
#pragma unroll
        for (int ai = 0; ai < 2; ++ai)
#pragma unroll
            for (int m = 0; m < 4; ++m) { const size_t r = (size_t)(row0 + ai * HALF + m * 16);
#pragma unroll
                for (int bj = 0; bj < 2; ++bj) { const int c = col0 + bj * HALF;
                    float g[8], o[8]; unpack8(*(const u32x4*)(GT + r * 2048 + c), g);
#pragma unroll
                    for (int n = 0; n < 2; ++n)
#pragma unroll
                        for (int i = 0; i < 4; ++i) o[4 * n + i] = sigmoidf_fast(g[4 * n + i]) * acc[ai][bj][m][n][i];
                    *(u32x4*)(TMP + r * 1024 + c) = pack8(o); } }
    }
};
struct EpiGateB {
    static constexpr int NVMEM = 16;
    static constexpr bool PERM = true, AFTER_DRAIN = false;
    const bf16_t* GT; const bf16_t* TMP; bf16_t* MIX;
    __device__ __forceinline__ void operator()(const f32x4 (&acc)[2][2][4][2], const Unit& u, int wr, int wc, int fr, int fq) const {
        const int row0 = u.pm * BM + wr * 64 + fr, col0 = u.pn * BM + wc * 32 + 8 * fq;
#pragma unroll
        for (int ai = 0; ai < 2; ++ai)
#pragma unroll
            for (int m = 0; m < 4; ++m) { const size_t r = (size_t)(row0 + ai * HALF + m * 16);
#pragma unroll
                for (int bj = 0; bj < 2; ++bj) { const int c = col0 + bj * HALF;
                    float g[8], t[8], o[8]; unpack8(*(const u32x4*)(GT + r * 2048 + 1024 + c), g); unpack8(*(const u32x4*)(TMP + r * 1024 + c), t);
#pragma unroll
                    for (int n = 0; n < 2; ++n)
#pragma unroll
                        for (int i = 0; i < 4; ++i) o[4 * n + i] = t[4 * n + i] + sigmoidf_fast(g[4 * n + i]) * acc[ai][bj][m][n][i];
                    *(u32x4*)(MIX + r * 1024 + c) = pack8(o); } }
    }
};
struct EpiRes {
    static constexpr int NVMEM = 32;
    static constexpr bool PERM = false, AFTER_DRAIN = false;
    const float* base; float* out; int ldc;
    __device__ __forceinline__ void operator()(const f32x4 (&acc)[2][2][4][2], const Unit& u, int wr, int wc, int fr, int fq) const {
        const int row0 = u.pm * BM + wr * 64 + fr, col0 = u.pn * BM + wc * 32 + 4 * fq;
#pragma unroll
        for (int ai = 0; ai < 2; ++ai)
#pragma unroll
            for (int m = 0; m < 4; ++m) { const size_t off = (size_t)(row0 + ai * HALF + m * 16) * ldc + col0;
#pragma unroll
                for (int bj = 0; bj < 2; ++bj)
#pragma unroll
                    for (int n = 0; n < 2; ++n) { const f32x4 b = *(const f32x4*)(base + off + bj * HALF + n * 16); *(f32x4*)(out + off + bj * HALF + n * 16) = b + acc[ai][bj][m][n]; } }
    }
};
struct EpiNull {
    static constexpr int NVMEM = 0;
    static constexpr bool PERM = true, AFTER_DRAIN = false;
    __device__ __forceinline__ void operator()(const f32x4 (&acc)[2][2][4][2], const Unit& u, int wr, int wc, int fr, int fq) const {
#pragma unroll
        for (int ai = 0; ai < 2; ++ai)
#pragma unroll
            for (int bj = 0; bj < 2; ++bj)
#pragma unroll
                for (int m = 0; m < 4; ++m)
#pragma unroll
                    for (int n = 0; n < 2; ++n) asm volatile("" :: "v"(acc[ai][bj][m][n]));
    }
};
struct EpiL2 {
    static constexpr int NVMEM = 16;
    static constexpr bool PERM = true, AFTER_DRAIN = false;
    bf16_t* S; int bx;
    __device__ __forceinline__ void operator()(const f32x4 (&acc)[2][2][4][2], const Unit& u, int wr, int wc, int fr, int fq) const {
        const int row0 = wr * 64 + fr, col0 = wc * 32 + 8 * fq; bf16_t* base = S + (size_t)bx * 65536;
#pragma unroll
        for (int ai = 0; ai < 2; ++ai)
#pragma unroll
            for (int m = 0; m < 4; ++m) {
#ifdef PROBE_L2W
                bf16_t* rowp = base + (size_t)(wr * 64 + (fr >> 1) + ai * HALF + m * 16) * 256 + wc * 64 + (fr & 1) * 32 + 8 * fq;
#else
                bf16_t* rowp = base + (size_t)(row0 + ai * HALF + m * 16) * 256 + col0;
#endif
#pragma unroll
                for (int bj = 0; bj < 2; ++bj) { const f32x4 v0 = acc[ai][bj][m][0], v1 = acc[ai][bj][m][1];
                    u32x4 w; w.x = cvt_pk_bf16(v0[0], v0[1]); w.y = cvt_pk_bf16(v0[2], v0[3]); w.z = cvt_pk_bf16(v1[0], v1[1]); w.w = cvt_pk_bf16(v1[2], v1[3]);
#ifdef PROBE_L2ONE
                    if (ai == 0 && m == 0 && bj == 0) *(u32x4*)(rowp + bj * HALF) = w; else asm volatile("" :: "v"(w));
#else
                    *(u32x4*)(rowp + bj * HALF) = w;
#endif
                    } }
    }
};
struct MoeOrder : StaticOrder {
    const volatile PG8_LAS unsigned* offs; int ntn;
    __device__ __forceinline__ bool next(int i, Unit& u) const {
        if (!StaticOrder::next(i, u)) return false;
        const unsigned row = (unsigned)u.pm * BM; int e = 0;
#pragma unroll
        for (int k = 1; k < 8; ++k) e += (row >= offs[k]) ? 1 : 0;
        u.pb = e * ntn + u.pn; return true;
    }
};
template <class Epi, class Sched, bool ALIGN_EPI = false, bool SP2 = false>
__device__ __forceinline__ void gemm_phase(PG8_LAS unsigned char* lds, const Gemm g, const Sched& S, const Epi& E, const int tid) {
    const int wid = __builtin_amdgcn_readfirstlane(tid >> 6), lane = tid & 63, wr = wid >> 2, wc = wid & 3, fr = lane & 15, fq = lane >> 4;
    const int K = g.K, nt = K / BK;
    unsigned voffA[2], voffB[2];
#pragma unroll
    for (int i = 0; i < 2; ++i) { int R, C; stage_rc(tid * 16 + i * 8192, R, C); const int Rb = Epi::PERM ? ((R & ~31) + perm32(R & 31)) : R;
        voffA[i] = (unsigned)(R * K + C) * 2u; voffB[i] = (unsigned)(Rb * K + C) * 2u; }
    const size_t kstep = (size_t)(BK * 2);
    const size_t hstep = (size_t)HALF * K * 2;
    const size_t tstep = 2 * hstep;
    const unsigned ldsw = (unsigned)wid * 1024u;
    const int aoff = lds_byte(wr * 64 + fr, fq * 8), boff = lds_byte(wc * 32 + fr, fq * 8);
#define PG8_SA(b, h) (((b) * 2 + (h)) * HTB)
#define PG8_SB(b, h) ((4 + (b) * 2 + (h)) * HTB)
#define PG8_STAGE(bufoff, gbase, voff) do { _Pragma("unroll") for (int _i = 0; _i < 2; ++_i) \
        __builtin_amdgcn_global_load_lds((const unsigned*)((const char*)(gbase) + (voff)[_i]), (PG8_LAS unsigned*)(lds + (bufoff) + ldsw + _i * 8192), 16, 0, 0); } while (0)
#define PG8_LDA(dst, b, h) do { _Pragma("unroll") for (int m = 0; m < 4; ++m) _Pragma("unroll") for (int k = 0; k < 2; ++k) dst[m][k] = *(const PG8_LAS bf16x8*)(lds + PG8_SA(b, h) + aoff + m * 2048 + k * 1024); } while (0)
#define PG8_LDB(dst, b, h) do { _Pragma("unroll") for (int n = 0; n < 2; ++n) _Pragma("unroll") for (int k = 0; k < 2; ++k) dst[n][k] = *(const PG8_LAS bf16x8*)(lds + PG8_SB(b, h) + boff + n * 2048 + k * 1024); } while (0)
#define PG8_MMA(ai, bj, At, Bt) do { __builtin_amdgcn_s_setprio(1); _Pragma("unroll") for (int m = 0; m < 4; ++m) _Pragma("unroll") for (int n = 0; n < 2; ++n) _Pragma("unroll") for (int k = 0; k < 2; ++k) \
        acc[ai][bj][m][n] = __builtin_amdgcn_mfma_f32_16x16x32_bf16(Bt[n][k], At[m][k], acc[ai][bj][m][n], 0, 0, 0); __builtin_amdgcn_s_setprio(0); } while (0)
#define PG8_WAIT_V(n) asm volatile("s_waitcnt vmcnt(" #n ")" ::: "memory")
#define PG8_WAIT_V8R(rel) asm volatile("s_cmp_lg_u32 %0, 0\n\ts_cbranch_scc1 1\n\ts_waitcnt vmcnt(8)\n\ts_waitcnt vmcnt(%1)" :: "s"(rel), "n"(8 + (Epi::NVMEM > 55 ? 55 : Epi::NVMEM)) : "memory", "scc")
#define PG8_WAIT_L(n) asm volatile("s_waitcnt lgkmcnt(" #n ")" ::: "memory")
#define PG8_BAR __builtin_amdgcn_s_barrier()
#define PG8_SCHED __builtin_amdgcn_sched_barrier(0)
    Unit cur, nxt; int ui = 0;
    if (!S.next(0, cur)) return;
    f32x4 acc[2][2][4][2];
#pragma unroll
    for (int a = 0; a < 2; ++a)
#pragma unroll
        for (int b = 0; b < 2; ++b)
#pragma unroll
            for (int m = 0; m < 4; ++m)
#pragma unroll
                for (int n = 0; n < 2; ++n) acc[a][b][m][n] = (f32x4){0.f, 0.f, 0.f, 0.f};
    bf16x8 At[4][2], B0[2][2], B1[2][2];
    const char* cA = (const char*)g.A + (size_t)cur.pm * tstep; const char* cB = (const char*)g.Bt + (size_t)cur.pb * tstep;
    S.a_ready(cur);
    if constexpr (SP2) {
        PG8_STAGE(PG8_SB(0, 0), cB, voffB); PG8_STAGE(PG8_SB(0, 1), cB + hstep, voffB); PG8_STAGE(PG8_SA(0, 0), cA, voffA); PG8_STAGE(PG8_SA(0, 1), cA + hstep, voffA);
        if (wr == 1) PG8_BAR;
        PG8_WAIT_V(2); PG8_BAR;
        PG8_STAGE(PG8_SB(1, 0), cB + kstep, voffB); PG8_STAGE(PG8_SA(1, 0), cA + kstep, voffA); PG8_STAGE(PG8_SB(1, 1), cB + hstep + kstep, voffB);
        PG8_WAIT_V(6); PG8_BAR;
    } else {
        PG8_STAGE(PG8_SB(0, 0), cB, voffB); PG8_STAGE(PG8_SA(0, 0), cA, voffA); PG8_STAGE(PG8_SB(0, 1), cB + hstep, voffB); PG8_STAGE(PG8_SA(0, 1), cA + hstep, voffA);
        if (wr == 1) PG8_BAR;
        PG8_WAIT_V(4); PG8_BAR;
        PG8_STAGE(PG8_SB(1, 0), cB + kstep, voffB); PG8_STAGE(PG8_SA(1, 0), cA + kstep, voffA); PG8_STAGE(PG8_SB(1, 1), cB + hstep + kstep, voffB);
        PG8_WAIT_V(6); PG8_BAR;
    }
    for (;;) {
        const bool has_next = S.next(ui + 1, nxt);
        const char* nA = has_next ? (const char*)g.A + (size_t)nxt.pm * tstep : cA; const char* nB = has_next ? (const char*)g.Bt + (size_t)nxt.pb * tstep : cB;
        for (int t = 0; t < nt; t += 2) {
            const bool last = (t == nt - 2);
            const int relax = __builtin_amdgcn_readfirstlane((PG8_RELAX && (t == 0) && (ui > 0)) ? 1 : 0);
            const char* a1 = cA + (size_t)(t + 1) * kstep;
            const char* a2 = last ? nA : cA + (size_t)(t + 2) * kstep; const char* b2 = last ? nB : cB + (size_t)(t + 2) * kstep;
            const char* a3 = a2 + kstep; const char* b3 = b2 + kstep;
            if (last && has_next) S.a_ready(nxt);
            if constexpr (SP2) {
            PG8_LDB(B0, 0, 0); PG8_LDB(B1, 0, 1); PG8_SCHED; PG8_LDA(At, 0, 0); PG8_STAGE(PG8_SA(1, 1), a1 + hstep, voffA);
            PG8_WAIT_V8R(relax); PG8_WAIT_L(0); PG8_BAR; PG8_MMA(0, 0, At, B0); PG8_MMA(0, 1, At, B1); PG8_BAR; PG8_SCHED;
            PG8_LDA(At, 0, 1); PG8_STAGE(PG8_SB(0, 0), b2, voffB); PG8_STAGE(PG8_SB(0, 1), b2 + hstep, voffB); PG8_STAGE(PG8_SA(0, 0), a2, voffA);
            PG8_WAIT_V8R(relax); PG8_WAIT_L(0); PG8_BAR; PG8_MMA(1, 0, At, B0); PG8_MMA(1, 1, At, B1); PG8_BAR; PG8_SCHED;
            PG8_LDB(B0, 1, 0); PG8_LDB(B1, 1, 1); PG8_SCHED; PG8_LDA(At, 1, 0); PG8_STAGE(PG8_SA(0, 1), a2 + hstep, voffA);
            PG8_WAIT_V(8); PG8_WAIT_L(0); PG8_BAR; PG8_MMA(0, 0, At, B0); PG8_MMA(0, 1, At, B1); PG8_BAR; PG8_SCHED;
            PG8_LDA(At, 1, 1); PG8_STAGE(PG8_SB(1, 0), b3, voffB); PG8_STAGE(PG8_SB(1, 1), b3 + hstep, voffB); PG8_STAGE(PG8_SA(1, 0), a3, voffA);
            PG8_WAIT_V(8); PG8_WAIT_L(0); PG8_BAR; PG8_MMA(1, 0, At, B0); PG8_MMA(1, 1, At, B1); PG8_BAR; PG8_SCHED;
            } else {
            PG8_LDB(B0, 0, 0); PG8_SCHED; PG8_LDA(At, 0, 0); PG8_STAGE(PG8_SA(1, 1), a1 + hstep, voffA);
            PG8_WAIT_L(8); PG8_BAR; PG8_WAIT_L(0); PG8_MMA(0, 0, At, B0); PG8_BAR; PG8_SCHED;
            PG8_LDB(B1, 0, 1); PG8_STAGE(PG8_SB(0, 0), b2, voffB);
            PG8_BAR; PG8_WAIT_L(0); PG8_MMA(0, 1, At, B1); PG8_BAR;
            PG8_LDA(At, 0, 1); PG8_STAGE(PG8_SA(0, 0), a2, voffA);
            PG8_BAR; PG8_WAIT_L(0); PG8_MMA(1, 0, At, B0); PG8_BAR; PG8_SCHED;
            PG8_STAGE(PG8_SB(0, 1), b2 + hstep, voffB);
            PG8_WAIT_V(6); PG8_BAR; PG8_MMA(1, 1, At, B1); PG8_BAR;
            PG8_LDB(B0, 1, 0); PG8_SCHED; PG8_LDA(At, 1, 0); PG8_STAGE(PG8_SA(0, 1), a2 + hstep, voffA);
            PG8_WAIT_L(8); PG8_BAR; PG8_WAIT_L(0); PG8_MMA(0, 0, At, B0); PG8_BAR; PG8_SCHED;
            PG8_LDB(B1, 1, 1); PG8_STAGE(PG8_SB(1, 0), b3, voffB);
            PG8_BAR; PG8_WAIT_L(0); PG8_MMA(0, 1, At, B1); PG8_BAR;
            PG8_LDA(At, 1, 1); PG8_STAGE(PG8_SA(1, 0), a3, voffA);
            PG8_BAR; PG8_WAIT_L(0); PG8_MMA(1, 0, At, B0); PG8_BAR; PG8_SCHED;
            PG8_STAGE(PG8_SB(1, 1), b3 + hstep, voffB);
            PG8_WAIT_V(6); PG8_BAR; PG8_MMA(1, 1, At, B1); PG8_BAR;
            }
        }
        if constexpr (ALIGN_EPI) { if (wr == 0) PG8_BAR; }
        if constexpr (!Epi::AFTER_DRAIN) { E(acc, cur, wr, wc, fr, fq); S.done(cur); }
        if (!has_next) break;
#pragma unroll
        for (int a = 0; a < 2; ++a)
#pragma unroll
            for (int b = 0; b < 2; ++b)
#pragma unroll
                for (int m = 0; m < 4; ++m)
#pragma unroll
                    for (int n = 0; n < 2; ++n) acc[a][b][m][n] = (f32x4){0.f, 0.f, 0.f, 0.f};
        cur = nxt; cA = nA; cB = nB; ++ui;
        if constexpr (ALIGN_EPI) { if (wr == 1) PG8_BAR; }
    }
    PG8_WAIT_V(0);
    if constexpr (!ALIGN_EPI) { if (wr == 0) PG8_BAR; }
    PG8_BAR;
    if constexpr (Epi::AFTER_DRAIN) { E.fused(acc, cur, wr, wc, fr, fq, lds, wid, lane); S.done(cur); }
#undef PG8_SA
#undef PG8_SB
#undef PG8_STAGE
#undef PG8_LDA
#undef PG8_LDB
#undef PG8_MMA
#undef PG8_WAIT_V
#undef PG8_WAIT_V8R
#undef PG8_WAIT_L
#undef PG8_BAR
#undef PG8_SCHED
}
}
#define GAS __attribute__((address_space(1)))
#define LAS __attribute__((address_space(3)))
typedef unsigned short bf16;
typedef unsigned v4u __attribute__((ext_vector_type(4)));
typedef float f32x4 __attribute__((ext_vector_type(4)));
typedef short bf16x8 __attribute__((ext_vector_type(8)));
typedef GAS unsigned gu32;
typedef GAS unsigned long long gu64;
#define RLX_AGENT __ATOMIC_RELAXED, __HIP_MEMORY_SCOPE_AGENT
#define LDS_WAIT() asm volatile("s_waitcnt lgkmcnt(0)" ::: "memory")
#define VM_WAIT() asm volatile("s_waitcnt vmcnt(0)" ::: "memory")
__device__ __forceinline__ unsigned long long rt() { return __builtin_amdgcn_s_memrealtime(); }
__device__ __forceinline__ unsigned f2bf(float f) { unsigned u = __builtin_bit_cast(unsigned, f); return (u + 0x7fffu + ((u >> 16) & 1u)) >> 16; }
__device__ __forceinline__ unsigned pk2(float lo, float hi) { return f2bf(lo) | (f2bf(hi) << 16); }

#define XB_TMO      128
#define XB_XCNT(j)  (256  + 64 * (j))
#define XB_XSUB(j)  (1280 + 64 * (j))
#define XB_XGEN(j)  (2304 + 64 * (j))
#define XB_TOP      3328
#define XB_TOPGEN   3392
#define XCD_BAR_WORDS 3456
#define XB_SPIN_CAP (1u << 18)

__device__ __forceinline__ unsigned xb_ld(unsigned* p)              { return __hip_atomic_load(p, __ATOMIC_RELAXED, __HIP_MEMORY_SCOPE_AGENT); }
__device__ __forceinline__ unsigned xb_add(unsigned* p, unsigned v) { return __hip_atomic_fetch_add(p, v, __ATOMIC_RELAXED, __HIP_MEMORY_SCOPE_AGENT); }
__device__ __forceinline__ unsigned xb_xcc_id() { return (unsigned)__builtin_amdgcn_s_getreg((3 << 11) | 20) & 0xFu; }
#define XB_SPIN(cond, bar) do { unsigned _sp = 0; while (cond) { __builtin_amdgcn_s_sleep(1); \
    if ((++_sp & 255u) == 0u) { if (xb_ld(&(bar)[XB_TMO])) break; if (_sp > XB_SPIN_CAP) { atomicAdd(&(bar)[XB_TMO], 1u); break; } } } } while (0)

struct XcdBarrier {
    unsigned* bar; unsigned x;
    volatile LAS unsigned* st;
};

__device__ __forceinline__ XcdBarrier xcd_barrier_post(unsigned* bar, volatile LAS unsigned* st) {
    XcdBarrier b; b.bar = bar; b.x = xb_xcc_id(); b.st = st;
    if (threadIdx.x == 0) (void)xb_add(&bar[XB_XCNT(b.x)], 1u);
    return b;
}
__device__ __forceinline__ void xcd_barrier_complete(unsigned* bar, unsigned x, unsigned& nloc, unsigned& nx) {
    const unsigned G = gridDim.x * gridDim.y * gridDim.z;
    unsigned sum, cnt, mine, sp = 0u;
    for (;;) {
        sum = 0u; cnt = 0u; mine = 0u;
#pragma unroll
        for (unsigned j = 0; j < 16; ++j) { const unsigned c = xb_ld(&bar[XB_XCNT(j)]); sum += c; cnt += (c > 0u) ? 1u : 0u; mine = (j == x) ? c : mine; }
        if (sum == G) break;
        __builtin_amdgcn_s_sleep(1);
        if ((++sp & 255u) == 0u) { if (xb_ld(&bar[XB_TMO])) break; if (sp > XB_SPIN_CAP) { atomicAdd(&bar[XB_TMO], 1u); break; } }
    }
    nloc = mine > 0u ? mine : 1u; nx = cnt > 0u ? cnt : 1u;
}

__device__ __forceinline__ void xcd_barrier(const XcdBarrier& b) {
    asm volatile("s_waitcnt vmcnt(0)" ::: "memory");
    __syncthreads();
    if (threadIdx.x == 0) {
        unsigned* bar = b.bar;
        __builtin_amdgcn_s_waitcnt(0);
        unsigned nloc = b.st[0], nx = b.st[1];
        if (nloc == 0u) { xcd_barrier_complete(bar, b.x, nloc, nx); b.st[0] = nloc; b.st[1] = nx; }
        const unsigned old = xb_add(&bar[XB_XSUB(b.x)], 1u);
        const unsigned gen = old / nloc;
        if (old + 1u == (gen + 1u) * nloc) {
            __builtin_amdgcn_fence(__ATOMIC_RELEASE, "agent");
            asm volatile("s_waitcnt vmcnt(0)" ::: "memory");
            const unsigned og = xb_add(&bar[XB_TOP], 1u);
            const unsigned tg = og / nx;
            if (og + 1u == (tg + 1u) * nx) xb_add(&bar[XB_TOPGEN], 1u);
            else XB_SPIN(xb_ld(&bar[XB_TOPGEN]) == tg, bar);
            __builtin_amdgcn_fence(__ATOMIC_ACQUIRE, "agent");
            xb_add(&bar[XB_XGEN(b.x)], 1u);
            asm volatile("s_waitcnt vmcnt(0)" ::: "memory");
        } else {
            XB_SPIN(xb_ld(&bar[XB_XGEN(b.x)]) == gen, bar);
            __builtin_amdgcn_fence(__ATOMIC_ACQUIRE, "agent");
            asm volatile("s_waitcnt vmcnt(0)" ::: "memory");
        }
    }
    __syncthreads();
}

constexpr int NWAVES = 8;
constexpr int BATCH = 8, SEQ = 4096, D = 1024, T = BATCH * SEQ, DEPTH = 2;
constexpr int DCONV = 512, NHEAD = 8, HD = 64, DATTN = 512, DFF = 2816, NEXP = 8, DFFE = 2048;
constexpr int NIN = 5120, NPA = 1536, NQK = 1024, NGT = 2048, NPROJ = NPA + NQK + NGT;
constexpr float EPS = 1e-6f;
constexpr float QSCALE = 0.125f * 1.4426950408889634f;
constexpr int MPAD = 2 * T + NEXP * 256;
constexpr int VTP = T + 64;

constexpr size_t MiB = 1u << 20;
constexpr size_t WS_CTL = 0, CTL_ZERO_BYTES = 1 * MiB;
constexpr size_t WS_ROUTE = 1 * MiB;
constexpr size_t WS_SLOTS = WS_ROUTE + 512 * 1024, WS_WGCNT = WS_ROUTE + 768 * 1024;
constexpr size_t WS_WL = 4 * MiB, WL_STRIDE = 14 * MiB;
constexpr size_t WL_WIN = 0, WL_WV = 9 * MiB, WL_WA = 10 * MiB, WL_WB = 11 * MiB, WL_WO = 12 * MiB;
constexpr size_t WS_WGU = 32 * MiB, WS_WD = 43 * MiB;
constexpr size_t WS_H = 50 * MiB;
constexpr size_t WS_UA = WS_H, WS_UB = WS_H + 32 * MiB;
constexpr size_t WS_VT = 114 * MiB;
constexpr size_t WS_GT = 146 * MiB;
constexpr size_t WS_PA = 274 * MiB;
constexpr size_t WS_QF = WS_PA + 96 * MiB, WS_KF = WS_PA + 128 * MiB;
constexpr size_t WS_TMP = 274 * MiB, WS_MIX = 338 * MiB;
constexpr size_t WS_G0 = 146 * MiB;
constexpr size_t WS_WEG = 4 * MiB, WS_WED = 68 * MiB;
constexpr size_t WS_HP = 100 * MiB;
constexpr size_t WS_G1 = 232 * MiB;
constexpr size_t WS_END = 512 * MiB;
static_assert(WS_G1 + (size_t)MPAD * DFFE * 2 <= WS_END && WS_HP + (size_t)MPAD * D * 2 <= WS_G1 && WS_KF + 32 * MiB <= WS_END, "d_ws map");
constexpr int CW_TMO = 0, CW_CODE = 1, CW_BAR = 4096, CW_CNT = 8192;

constexpr int RING_OFF = 0, RING_BYTES = 131072, LDSCTL_OFF = RING_BYTES, MISC_OFF = LDSCTL_OFF + 320, LDS_BYTES = 147456;

typedef unsigned u32x2v __attribute__((ext_vector_type(2)));
__device__ __forceinline__ float wave_sum(float v) {
#pragma unroll
    for (int o = 1; o < 64; o <<= 1) v += __shfl_xor(v, o);
    return v;
}
using pg8::cvt_pk_bf16;
__device__ __forceinline__ void tr_block(const float* W, int K, int N, bf16* dst, int drow, int k0, int n0, LAS float* scr, int lane) {
#pragma unroll 8
    for (int i = 0; i < 32; ++i) { const int kk = 2 * i + (lane >> 5); scr[kk * 33 + (lane & 31)] = W[(size_t)(k0 + kk) * N + n0 + (lane & 31)]; }
    LDS_WAIT(); asm volatile("" ::: "memory");
    const int c = lane & 7;
#pragma unroll
    for (int j = 0; j < 4; ++j) { const int n = (lane >> 3) + 8 * j; const LAS float* s = scr + (8 * c) * 33 + n;
        v4u o; o.x = cvt_pk_bf16(s[0 * 33], s[1 * 33]); o.y = cvt_pk_bf16(s[2 * 33], s[3 * 33]); o.z = cvt_pk_bf16(s[4 * 33], s[5 * 33]); o.w = cvt_pk_bf16(s[6 * 33], s[7 * 33]);
        *(GAS v4u*)(dst + (size_t)(drow + n) * K + k0 + 8 * c) = o; }
    LDS_WAIT(); asm volatile("" ::: "memory");
}
template <int KIND> __device__ __forceinline__ void tr_item(const float* W, int K, int N, bf16* dst, bf16* dst2, LAS float* scr, int item, int lane) {
    const int nblk = N / 32, kb = item / nblk, nb = item % nblk, k0 = 64 * kb, n0 = 32 * nb;
    bf16* d = dst; int drow = n0;
    if (KIND == 1) { if (n0 >= 3072) drow = n0 - 512; else if (n0 >= 2560) { d = dst2; drow = n0 - 2560; } }
    if (KIND == 2) drow = 256 * (n0 / 128) + (n0 % 128);
    if (KIND == 3) drow = 256 * (n0 / 128) + 128 + (n0 % 128);
    tr_block(W, K, N, d, drow, k0, n0, scr, lane);
}
__device__ __forceinline__ void rms_row_to_bf16(const float* xrow, const float* g, bf16* orow, int lane) {
    const GAS f32x4* xr = (const GAS f32x4*)xrow + lane; const GAS f32x4* gr = (const GAS f32x4*)g + lane;
    f32x4 v[4]; float s = 0.f;
#pragma unroll
    for (int j = 0; j < 4; ++j) { v[j] = xr[64 * j]; s += (v[j].x * v[j].x + v[j].y * v[j].y) + (v[j].z * v[j].z + v[j].w * v[j].w); }
    const float rstd = 1.0f / sqrtf(wave_sum(s) * (1.f / D) + EPS);
    GAS u32x2v* o8 = (GAS u32x2v*)orow + lane;
#pragma unroll
    for (int j = 0; j < 4; ++j) { const f32x4 gg = gr[64 * j]; u32x2v w; w.x = cvt_pk_bf16(v[j].x * rstd * gg.x, v[j].y * rstd * gg.y); w.y = cvt_pk_bf16(v[j].z * rstd * gg.z, v[j].w * rstd * gg.w); o8[64 * j] = w; }
}
__device__ __forceinline__ void unpack8f(const v4u w, float (&f)[8]) {
    f[0] = __builtin_bit_cast(float, w.x << 16); f[1] = __builtin_bit_cast(float, w.x & 0xffff0000u); f[2] = __builtin_bit_cast(float, w.y << 16); f[3] = __builtin_bit_cast(float, w.y & 0xffff0000u);
    f[4] = __builtin_bit_cast(float, w.z << 16); f[5] = __builtin_bit_cast(float, w.z & 0xffff0000u); f[6] = __builtin_bit_cast(float, w.w << 16); f[7] = __builtin_bit_cast(float, w.w & 0xffff0000u);
}
__device__ __forceinline__ v4u pack8f(const float (&f)[8]) { v4u w; w.x = cvt_pk_bf16(f[0], f[1]); w.y = cvt_pk_bf16(f[2], f[3]); w.z = cvt_pk_bf16(f[4], f[5]); w.w = cvt_pk_bf16(f[6], f[7]); return w; }

__device__ __forceinline__ void conv_phase(const bf16* PA, const float* cw, bf16* UA, int gid, int nthr) {
    for (int it = gid; it < (T / 16) * 64; it += nthr) {
        const int cg = it & 63, t0 = (it >> 6) * 16, c0 = cg * 8;
        float w0[8], w1[8], w2[8];
#pragma unroll
        for (int i = 0; i < 8; ++i) { w0[i] = cw[c0 + i]; w1[i] = cw[DCONV + c0 + i]; w2[i] = cw[2 * DCONV + c0 + i]; }
        float um2[8], um1[8];
        if ((t0 & (SEQ - 1)) == 0) {
#pragma unroll
            for (int i = 0; i < 8; ++i) { um2[i] = 0.f; um1[i] = 0.f; }
        } else {
            float a[8], b[8];
            unpack8f(*(const GAS v4u*)(PA + (size_t)(t0 - 2) * NPA + c0), a); unpack8f(*(const GAS v4u*)(PA + (size_t)(t0 - 2) * NPA + 1024 + c0), b);
#pragma unroll
            for (int i = 0; i < 8; ++i) um2[i] = a[i] * b[i];
            unpack8f(*(const GAS v4u*)(PA + (size_t)(t0 - 1) * NPA + c0), a); unpack8f(*(const GAS v4u*)(PA + (size_t)(t0 - 1) * NPA + 1024 + c0), b);
#pragma unroll
            for (int i = 0; i < 8; ++i) um1[i] = a[i] * b[i];
        }
#pragma unroll 4
        for (int r = 0; r < 16; ++r) {
            const bf16* row = PA + (size_t)(t0 + r) * NPA + c0;
            float xin[8], bg[8], cgv[8], o[8];
            unpack8f(*(const GAS v4u*)(row), xin); unpack8f(*(const GAS v4u*)(row + 512), bg); unpack8f(*(const GAS v4u*)(row + 1024), cgv);
#pragma unroll
            for (int i = 0; i < 8; ++i) { const float u = cgv[i] * xin[i]; o[i] = bg[i] * (w0[i] * um2[i] + w1[i] * um1[i] + w2[i] * u); um2[i] = um1[i]; um1[i] = u; }
            *(GAS v4u*)(UA + (size_t)(t0 + r) * DCONV + c0) = pack8f(o);
        }
    }
}

typedef float f32x16 __attribute__((ext_vector_type(16)));
__device__ __forceinline__ void attn_mfma(const bf16* QF, const bf16* KF, const bf16* VF, bf16* UB, int gw, int NGW, int lane) {
    const int q = lane & 31, hh = lane >> 5;
    constexpr int NU = BATCH * NHEAD * (SEQ / 32);
    bf16x8 qf[4], kf[4], vf[4];
    if (gw < NU) {
        const size_t o = (size_t)gw * 2048 + lane * 8;
#pragma unroll
        for (int i = 0; i < 4; ++i) { qf[i] = *(const GAS bf16x8*)(QF + o + i * 512); kf[i] = *(const GAS bf16x8*)(KF + o + i * 512); vf[i] = *(const GAS bf16x8*)(VF + o + i * 512); }
    }
#pragma unroll 1
    for (int u = gw; u < NU; u += NGW) {
        const int qb = u & 127, bh = u >> 7, h = bh & 7, b = bh >> 3;
        const size_t rowb = (size_t)b * SEQ;
        bf16x8 qN[4], kN[4], vN[4];
        {
            const int un = (u + NGW < NU) ? u + NGW : u; const size_t o = (size_t)un * 2048 + lane * 8;
#pragma unroll
            for (int i = 0; i < 4; ++i) { qN[i] = *(const GAS bf16x8*)(QF + o + i * 512); kN[i] = *(const GAS bf16x8*)(KF + o + i * 512); vN[i] = *(const GAS bf16x8*)(VF + o + i * 512); }
        }
        __builtin_amdgcn_sched_barrier(0);
        const bf16* const kbase = KF + (size_t)(bh * 128) * 2048 + lane * 8;
        const bf16* const vbase = VF + (size_t)(bh * 128) * 2048 + lane * 8;
        f32x16 o0, o1;
#pragma unroll
        for (int r = 0; r < 16; ++r) { o0[r] = 0.f; o1[r] = 0.f; }
        float R = 1.f;
        bf16x8 kn[4], vn[4];
        const bf16x8 (&qfr)[4] = qf;
        auto block = [&](const bf16x8 (&KF)[4], const bf16x8 (&VF)[4], bf16x8 (&KN)[4], bf16x8 (&VN)[4], const int kb) __attribute__((always_inline)) -> bool {
            {
                const int kbn = kb > 0 ? kb - 1 : 0;
                const bf16* kp = kbase + (size_t)kbn * 2048; const bf16* vp = vbase + (size_t)kbn * 2048;
#pragma unroll
                for (int i = 0; i < 4; ++i) { KN[i] = *(const GAS bf16x8*)(kp + i * 512); VN[i] = *(const GAS bf16x8*)(vp + i * 512); }
            }
            __builtin_amdgcn_sched_barrier(0);
            f32x16 p;
#pragma unroll
            for (int r = 0; r < 16; ++r) p[r] = 0.f;
#pragma unroll
            for (int d0 = 0; d0 < 4; ++d0) p = __builtin_amdgcn_mfma_f32_32x32x16_bf16(KF[d0], qfr[d0], p, 0, 0, 0);
            float rr[16];
            const bool diag = (kb == qb);
#pragma unroll
            for (int r = 0; r < 16; ++r) {
                float e = __builtin_amdgcn_exp2f(p[r]);
                if (diag) { const int kl = (r & 7) + 8 * hh + 16 * (r >> 3); e = (kl < q) ? e : 0.f; }
                rr[r] = __builtin_amdgcn_rcpf(1.0f + e);
            }
            bf16x8 af[2];
#pragma unroll
            for (int s = 1; s >= 0; --s) {
                float g = rr[8 * s];
#pragma unroll
                for (int j = 1; j < 8; ++j) g *= rr[8 * s + j];
                const auto sw = __builtin_amdgcn_permlane32_swap(__float_as_uint(g), __float_as_uint(g), false, false);
                const float g_lo = __uint_as_float(sw[0]), g_hi = __uint_as_float(sw[1]);
                float c = hh ? R : R * g_hi;
                float a[8];
#pragma unroll
                for (int j = 7; j >= 0; --j) { const float cn = c * rr[8 * s + j]; a[j] = c - cn; c = cn; }
                R = R * (g_lo * g_hi);
                typedef unsigned u4 __attribute__((ext_vector_type(4)));
                u4 w; w.x = cvt_pk_bf16(a[0], a[1]); w.y = cvt_pk_bf16(a[2], a[3]); w.z = cvt_pk_bf16(a[4], a[5]); w.w = cvt_pk_bf16(a[6], a[7]);
                af[s] = __builtin_bit_cast(bf16x8, w);
            }
            o0 = __builtin_amdgcn_mfma_f32_32x32x16_bf16(VF[0], af[0], o0, 0, 0, 0);
            o0 = __builtin_amdgcn_mfma_f32_32x32x16_bf16(VF[1], af[1], o0, 0, 0, 0);
            o1 = __builtin_amdgcn_mfma_f32_32x32x16_bf16(VF[2], af[0], o1, 0, 0, 0);
            o1 = __builtin_amdgcn_mfma_f32_32x32x16_bf16(VF[3], af[1], o1, 0, 0, 0);
            return kb == 0 || __builtin_amdgcn_ballot_w64(R != 0.f) == 0ull;
        };
#pragma unroll 1
        for (int kb = qb;; kb -= 2) {
            if (block(kf, vf, kn, vn, kb)) break;
            if (block(kn, vn, kf, vf, kb - 1)) break;
        }
        bf16* op = UB + (rowb + 32 * qb + q) * DATTN + h * 64 + 4 * hh;
#pragma unroll
        for (int g4 = 0; g4 < 4; ++g4) {
            u32x2v w0, w1;
            w0.x = cvt_pk_bf16(o0[4 * g4], o0[4 * g4 + 1]); w0.y = cvt_pk_bf16(o0[4 * g4 + 2], o0[4 * g4 + 3]);
            w1.x = cvt_pk_bf16(o1[4 * g4], o1[4 * g4 + 1]); w1.y = cvt_pk_bf16(o1[4 * g4 + 2], o1[4 * g4 + 3]);
            *(GAS u32x2v*)(op + 8 * g4) = w0; *(GAS u32x2v*)(op + 32 + 8 * g4) = w1;
        }
#pragma unroll
        for (int i = 0; i < 4; ++i) { qf[i] = qN[i]; kf[i] = kN[i]; vf[i] = vN[i]; }
    }
}

#ifndef REP_P0
#define REP_P0 1
#endif
#ifndef REP_P1
#define REP_P1 1
#endif
#ifndef REP_P2
#define REP_P2 1
#endif
#ifndef REP_ATT
#define REP_ATT 1
#endif
#ifndef REP_R1A
#define REP_R1A 1
#endif
struct Args { const float* in[16]; float* out; unsigned char* ws; };
typedef const __attribute__((address_space(4))) Args* KArgP;
__device__ __forceinline__ KArgP launder_k(KArgP p) { asm volatile("" : "+s"(p)); return p; }
__device__ __forceinline__ int launder_s(int v) { asm volatile("" : "+s"(v)); return v; }
__device__ __forceinline__ int launder_v(int v) { asm volatile("" : "+v"(v)); return v; }
#ifndef STG_TICKS
#define STG_TICKS 150
#endif
__device__ __forceinline__ void stagger(int bx) { const unsigned long long t0 = __builtin_amdgcn_s_memrealtime(); const unsigned long long want = (unsigned long long)(((bx >> 3) & 3) * STG_TICKS); while (__builtin_amdgcn_s_memrealtime() - t0 < want) __builtin_amdgcn_s_sleep(2); }
#define PH_BEGIN { const KArgP ap = launder_k(kp0); unsigned char* const ws = ap->ws; const int bx = launder_s(bx0), G = launder_s(G0); const int tid = launder_v(tid0), lane = tid & 63, wave = __builtin_amdgcn_readfirstlane(tid >> 6); \
    const int gid = bx * (NWAVES * 64) + tid, nthr = G * NWAVES * 64, gw = bx * NWAVES + wave, NGW = G * NWAVES; (void)gid; (void)nthr; (void)gw; (void)NGW; (void)lane; \
    LAS float* const scr = (LAS float*)(lds + RING_OFF + wave * 16384); (void)scr; (void)ws;
#define PH_END(BARRIER) if (BARRIER) xcd_barrier(bar); }
#define WSP(T_, off) ((T_*)(ws + (off)))

__global__ void __launch_bounds__(NWAVES * 64, 2) mega_fwd(Args args) {
    extern __shared__ __attribute__((aligned(16))) unsigned char lds_raw[];
    LAS unsigned char* const lds = (LAS unsigned char*)lds_raw;
    volatile LAS unsigned* const MISC = (volatile LAS unsigned*)(lds + MISC_OFF);
    const KArgP kp0 = (KArgP)__builtin_amdgcn_kernarg_segment_ptr();
    const int tid0 = threadIdx.x, G0 = gridDim.x, bx0 = blockIdx.x;
    for (int u = tid0; u < (LDS_BYTES - LDSCTL_OFF) / 4; u += NWAVES * 64) ((LAS unsigned*)(lds + LDSCTL_OFF))[u] = 0u;
    __syncthreads();
#ifdef PROBE_CLK
    long long probe_cycles = 0;
#endif
    XcdBarrier bar = xcd_barrier_post((unsigned*)(args.ws + WS_CTL) + CW_BAR, MISC + 8);

#pragma unroll 1
    for (int rep = 0; rep < REP_P0; ++rep)
    PH_BEGIN
        constexpr int I_IN = 16 * 160, I_BR = 8 * 32, I_O = 16 * 32, I_GU = 16 * 88, I_D = 44 * 32;
        constexpr int PER_L = I_IN + 2 * I_BR + I_O, NITEMS = 2 * PER_L + 2 * I_GU + I_D;
#pragma unroll 1
        for (int it = gw; it < NITEMS; it += NGW) {
            int r = it;
            if (r < 2 * PER_L) {
                const int l = r / PER_L; r -= l * PER_L; unsigned char* wl = ws + WS_WL + (size_t)l * WL_STRIDE;
                if (r < I_IN) { tr_item<1>(ap->in[2] + (size_t)l * D * NIN, D, NIN, (bf16*)(wl + WL_WIN), (bf16*)(wl + WL_WV), scr, r, lane); continue; } r -= I_IN;
                if (r < I_BR) { tr_item<0>(ap->in[4] + (size_t)l * DCONV * D, DCONV, D, (bf16*)(wl + WL_WA), nullptr, scr, r, lane); continue; } r -= I_BR;
                if (r < I_BR) { tr_item<0>(ap->in[5] + (size_t)l * DATTN * D, DATTN, D, (bf16*)(wl + WL_WB), nullptr, scr, r, lane); continue; } r -= I_BR;
                tr_item<0>(ap->in[6] + (size_t)l * D * D, D, D, (bf16*)(wl + WL_WO), nullptr, scr, r, lane); continue;
            }
            r -= 2 * PER_L;
            if (r < I_GU) { tr_item<2>(ap->in[8], D, DFF, WSP(bf16, WS_WGU), nullptr, scr, r, lane); continue; } r -= I_GU;
            if (r < I_GU) { tr_item<3>(ap->in[9], D, DFF, WSP(bf16, WS_WGU), nullptr, scr, r, lane); continue; } r -= I_GU;
            tr_item<0>(ap->in[10], DFF, D, WSP(bf16, WS_WD), nullptr, scr, r, lane);
        }
#pragma unroll 1
        for (int m = gw; m < T; m += NGW) rms_row_to_bf16(ap->in[0] + (size_t)m * D, ap->in[1], WSP(bf16, WS_H) + (size_t)m * D, lane);
    PH_END(true)

#pragma unroll 1
    for (int l = 0; l < DEPTH; ++l) {
#pragma unroll 1
        for (int rep = 0; rep < REP_P1; ++rep) {
        PH_BEGIN
            unsigned char* wl = ws + WS_WL + (size_t)l * WL_STRIDE;
            pg8::Gemm g{WSP(bf16, WS_H), (const bf16*)(wl + WL_WIN), T, NPROJ, D}; pg8::StaticOrder S; S.init(T, NPROJ, G, bx);
#ifdef PROBE_NULL
            if (rep == 0) { pg8::EpiNull E0; pg8::gemm_phase<pg8::EpiNull, pg8::StaticOrder, true, true>(lds + RING_OFF, g, S, E0, tid); } else
#endif
#ifdef PROBE_L2
            if (rep == 0) { pg8::EpiL2 E0{WSP(bf16, 440 * MiB), bx}; pg8::gemm_phase<pg8::EpiL2, pg8::StaticOrder, true, true>(lds + RING_OFF, g, S, E0, tid); } else
#endif
            {
#ifdef PROBE_CLK
            long long c0_ = clock64();
#endif
            pg8::EpiProj E{WSP(bf16, WS_PA), WSP(bf16, WS_QF), WSP(bf16, WS_KF), WSP(bf16, WS_GT), QSCALE};
            pg8::gemm_phase<pg8::EpiProj, pg8::StaticOrder, true, true>(lds + RING_OFF, g, S, E, tid);
#ifdef PROBE_CLK
            if (l == 0) probe_cycles = clock64() - c0_;
#endif
            }
        PH_END(false)
        PH_BEGIN
            unsigned char* wl = ws + WS_WL + (size_t)l * WL_STRIDE;
            pg8::Gemm g{(const bf16*)(wl + WL_WV), WSP(bf16, WS_H), DATTN, T, D}; pg8::StaticOrder S; S.init(DATTN, T, G, bx);
#ifdef PROBE_NULL
            if (rep == 0) { pg8::EpiNull E0; pg8::gemm_phase<pg8::EpiNull, pg8::StaticOrder, true, true>(lds + RING_OFF, g, S, E0, tid); } else
#endif
#ifdef PROBE_L2
            if (rep == 0) { pg8::EpiL2 E0{WSP(bf16, 440 * MiB), bx}; pg8::gemm_phase<pg8::EpiL2, pg8::StaticOrder, true, true>(lds + RING_OFF, g, S, E0, tid); } else
#endif
            { pg8::EpiVT E{WSP(bf16, WS_VT)};
            pg8::gemm_phase<pg8::EpiVT, pg8::StaticOrder, true, true>(lds + RING_OFF, g, S, E, tid); }
        PH_END(true)
        }
#pragma unroll 1
        for (int rep = 0; rep < REP_P2; ++rep) {
        PH_BEGIN
            conv_phase(WSP(bf16, WS_PA), ap->in[3] + (size_t)l * 3 * DCONV, WSP(bf16, WS_UA), gid, nthr);
        PH_END(false)
#pragma unroll 1
        for (int rep2 = 0; rep2 < REP_ATT; ++rep2) {
        PH_BEGIN
            attn_mfma(WSP(bf16, WS_QF), WSP(bf16, WS_KF), WSP(bf16, WS_VT), WSP(bf16, WS_UB), gw, NGW, lane);
        PH_END(rep2 == REP_ATT - 1)
        }
        }
        PH_BEGIN
            unsigned char* wl = ws + WS_WL + (size_t)l * WL_STRIDE;
            pg8::Gemm g{WSP(bf16, WS_UA), (const bf16*)(wl + WL_WA), T, D, DCONV}; pg8::StaticOrder S; S.init(T, D, G, bx);
            pg8::EpiGateA E{WSP(bf16, WS_GT), WSP(bf16, WS_TMP)};
            pg8::gemm_phase<pg8::EpiGateA, pg8::StaticOrder, true, true>(lds + RING_OFF, g, S, E, tid);
        PH_END(false)
        PH_BEGIN
            unsigned char* wl = ws + WS_WL + (size_t)l * WL_STRIDE;
            pg8::Gemm g{WSP(bf16, WS_UB), (const bf16*)(wl + WL_WB), T, D, DATTN}; pg8::StaticOrder S; S.init(T, D, G, bx);
            pg8::EpiGateB E{WSP(bf16, WS_GT), WSP(bf16, WS_TMP), WSP(bf16, WS_MIX)};
            pg8::gemm_phase<pg8::EpiGateB, pg8::StaticOrder, true, true>(lds + RING_OFF, g, S, E, tid);
        PH_END(true)
        PH_BEGIN
            unsigned char* wl = ws + WS_WL + (size_t)l * WL_STRIDE;
            pg8::Gemm g{WSP(bf16, WS_MIX), (const bf16*)(wl + WL_WO), T, D, D}; pg8::StaticOrder S; S.init(T, D, G, bx);
            pg8::EpiRes E{l == 0 ? ap->in[0] : (const float*)ap->out, ap->out, D};
            pg8::gemm_phase<pg8::EpiRes, pg8::StaticOrder, true, true>(lds + RING_OFF, g, S, E, tid);
        PH_END(true)
        if (l == 0) {
            PH_BEGIN
#pragma unroll 1
                for (int m = gw; m < T; m += NGW) rms_row_to_bf16(ap->out + (size_t)m * D, ap->in[7], WSP(bf16, WS_H) + (size_t)m * D, lane);
            PH_END(true)
            PH_BEGIN
                pg8::Gemm g{WSP(bf16, WS_H), WSP(bf16, WS_WGU), T, 2 * DFF, D}; pg8::StaticOrder S; S.init(T, 2 * DFF, G, bx);
                pg8::EpiSwiGLU E{WSP(bf16, WS_G0), DFF};
                pg8::gemm_phase<pg8::EpiSwiGLU, pg8::StaticOrder, true, true>(lds + RING_OFF, g, S, E, tid);
            PH_END(true)
            PH_BEGIN
                pg8::Gemm g{WSP(bf16, WS_G0), WSP(bf16, WS_WD), T, D, DFF}; pg8::StaticOrder S; S.init(T, D, G, bx);
#ifdef PROBE_P7NULL
                { pg8::EpiNull E0; pg8::gemm_phase<pg8::EpiNull, pg8::StaticOrder, true, true>(lds + RING_OFF, g, S, E0, tid); }
#endif
                pg8::EpiRes E{ap->out, ap->out, D};
                pg8::gemm_phase<pg8::EpiRes, pg8::StaticOrder, true, true>(lds + RING_OFF, g, S, E, tid);
            PH_END(true)
            PH_BEGIN
#pragma unroll 1
                for (int m = gw; m < T; m += NGW) rms_row_to_bf16(ap->out + (size_t)m * D, ap->in[1] + D, WSP(bf16, WS_H) + (size_t)m * D, lane);
            PH_END(true)
        } else {
            volatile LAS int* const lcnt = (volatile LAS int*)(MISC + 32);
            volatile LAS unsigned* const loff = MISC + 16;
            volatile LAS int* const lbase = (volatile LAS int*)(MISC + 48);
#pragma unroll 1
            for (int rep = 0; rep < REP_R1A; ++rep)
            PH_BEGIN
                constexpr int I_E = 16 * 64;
#pragma unroll 1
                for (int it = gw; it < NEXP * 3 * I_E; it += NGW) {
                    const int e = it / (3 * I_E); int r = it - e * 3 * I_E;
                    if (r < I_E) { tr_item<2>(ap->in[12] + (size_t)e * D * DFFE, D, DFFE, WSP(bf16, WS_WEG) + (size_t)e * 2 * DFFE * D, nullptr, scr, r, lane); continue; } r -= I_E;
                    if (r < I_E) { tr_item<3>(ap->in[13] + (size_t)e * D * DFFE, D, DFFE, WSP(bf16, WS_WEG) + (size_t)e * 2 * DFFE * D, nullptr, scr, r, lane); continue; } r -= I_E;
                    tr_item<0>(ap->in[14] + (size_t)e * DFFE * D, DFFE, D, WSP(bf16, WS_WED) + (size_t)e * D * DFFE, nullptr, scr, r, lane);
                }
            PH_END(false)
            PH_BEGIN
                int4* route = WSP(int4, WS_ROUTE); int* wgcnt = WSP(int, WS_WGCNT); gu32* ctl = (gu32*)(ws + WS_CTL);
                const int rpw = T / G, r0 = bx * rpw, r1 = r0 + rpw;
                const float* xres = ap->out; const float* gf = ap->in[7] + D; const float* w_router = ap->in[11];
                if (tid < 8) lcnt[tid] = 0;
                __syncthreads();
#pragma unroll 1
                for (int m = r0 + wave; m < r1; m += NWAVES) {
                    const GAS f32x4* xr = (const GAS f32x4*)(xres + (size_t)m * D) + lane; const GAS f32x4* gr = (const GAS f32x4*)gf + lane;
                    f32x4 v[4]; float s = 0.f;
#pragma unroll
                    for (int j = 0; j < 4; ++j) { v[j] = xr[64 * j]; s += (v[j].x * v[j].x + v[j].y * v[j].y) + (v[j].z * v[j].z + v[j].w * v[j].w); }
                    const float rstd = 1.0f / sqrtf(wave_sum(s) * (1.f / D) + EPS);
                    float lg[8];
#pragma unroll
                    for (int e = 0; e < 8; ++e) lg[e] = 0.f;
#pragma unroll
                    for (int j = 0; j < 4; ++j) { const f32x4 gg = gr[64 * j];
#pragma unroll
                        for (int c = 0; c < 4; ++c) { const float hn = v[j][c] * rstd * gg[c]; const int i = 256 * j + 4 * lane + c;
                            const f32x4 wa = *(const GAS f32x4*)(w_router + (size_t)i * 8), wb = *(const GAS f32x4*)(w_router + (size_t)i * 8 + 4);
                            lg[0] += hn * wa.x; lg[1] += hn * wa.y; lg[2] += hn * wa.z; lg[3] += hn * wa.w; lg[4] += hn * wb.x; lg[5] += hn * wb.y; lg[6] += hn * wb.z; lg[7] += hn * wb.w; } }
#pragma unroll
                    for (int e = 0; e < 8; ++e) lg[e] = wave_sum(lg[e]);
                    int e1 = 0; float v1 = lg[0];
#pragma unroll
                    for (int e = 1; e < 8; ++e) if (lg[e] > v1) { v1 = lg[e]; e1 = e; }
                    int e2 = -1; float v2 = -INFINITY;
#pragma unroll
                    for (int e = 0; e < 8; ++e) if (e != e1 && lg[e] > v2) { v2 = lg[e]; e2 = e; }
                    if (e2 < 0) e2 = (e1 + 1) & 7;
                    const float ex = __expf(v2 - v1), w1 = 1.0f / (1.0f + ex), w2 = ex * w1;
                    if (lane == 0) { route[m] = make_int4(e1, e2, __float_as_int(w1), __float_as_int(w2)); atomicAdd((int*)(lcnt + e1), 1); atomicAdd((int*)(lcnt + e2), 1); }
                }
                __syncthreads();
                if (tid < 8) { const int c = lcnt[tid]; wgcnt[bx * 8 + tid] = c; __hip_atomic_fetch_add((unsigned*)(ctl + CW_CNT + tid), (unsigned)c, RLX_AGENT); }
            PH_END(true)
            PH_BEGIN
                int4* route = WSP(int4, WS_ROUTE); int2* slots = WSP(int2, WS_SLOTS); int* wgcnt = WSP(int, WS_WGCNT); gu32* ctl = (gu32*)(ws + WS_CTL); bf16* HP = WSP(bf16, WS_HP);
                const int rpw = T / G, r0 = bx * rpw, r1 = r0 + rpw;
                const float* xres = ap->out; const float* gf = ap->in[7] + D;
                { int s = 0; for (int w = lane; w < bx; w += 64) s += wgcnt[w * 8 + wave]; s = (int)wave_sum((float)s);
                  if (lane == 0) { lbase[wave] = s; lcnt[wave] = 0; } }
                if (tid == 0) { unsigned off = 0; for (int e = 0; e < 8; ++e) { loff[e] = off; off += (__hip_atomic_load((unsigned*)(ctl + CW_CNT + e), RLX_AGENT) + 255u) & ~255u; } loff[8] = off; }
                __syncthreads();
#pragma unroll 1
                for (int m = r0 + wave; m < r1; m += NWAVES) {
                    int s1 = 0, s2 = 0;
                    if (lane == 0) { const int4 rt = route[m]; s1 = (int)loff[rt.x] + lbase[rt.x] + atomicAdd((int*)(lcnt + rt.x), 1); s2 = (int)loff[rt.y] + lbase[rt.y] + atomicAdd((int*)(lcnt + rt.y), 1); slots[m] = make_int2(s1, s2); }
                    s1 = __builtin_amdgcn_readfirstlane(s1); s2 = __builtin_amdgcn_readfirstlane(s2);
                    const GAS f32x4* xr = (const GAS f32x4*)(xres + (size_t)m * D) + lane; const GAS f32x4* gr = (const GAS f32x4*)gf + lane;
                    f32x4 v[4]; float s = 0.f;
#pragma unroll
                    for (int j = 0; j < 4; ++j) { v[j] = xr[64 * j]; s += (v[j].x * v[j].x + v[j].y * v[j].y) + (v[j].z * v[j].z + v[j].w * v[j].w); }
                    const float rstd = 1.0f / sqrtf(wave_sum(s) * (1.f / D) + EPS);
                    GAS u32x2v* o1 = (GAS u32x2v*)(HP + (size_t)s1 * D) + lane; GAS u32x2v* o2 = (GAS u32x2v*)(HP + (size_t)s2 * D) + lane;
#pragma unroll
                    for (int j = 0; j < 4; ++j) { const f32x4 gg = gr[64 * j]; u32x2v w; w.x = cvt_pk_bf16(v[j].x * rstd * gg.x, v[j].y * rstd * gg.y); w.y = cvt_pk_bf16(v[j].z * rstd * gg.z, v[j].w * rstd * gg.w); o1[64 * j] = w; o2[64 * j] = w; }
                }
            PH_END(true)
            PH_BEGIN
                const int mrows = (int)loff[8];
                pg8::Gemm g{WSP(bf16, WS_HP), WSP(bf16, WS_WEG), mrows, 2 * DFFE, D}; pg8::MoeOrder S; S.init(mrows, 2 * DFFE, G, bx); S.offs = loff; S.ntn = 2 * DFFE / 256;
                pg8::EpiSwiGLU E{WSP(bf16, WS_G1), DFFE};
                pg8::gemm_phase<pg8::EpiSwiGLU, pg8::MoeOrder, true, true>(lds + RING_OFF, g, S, E, tid);
            PH_END(true)
            PH_BEGIN
                const int mrows = (int)loff[8];
                pg8::Gemm g{WSP(bf16, WS_G1), WSP(bf16, WS_WED), mrows, D, DFFE}; pg8::MoeOrder S; S.init(mrows, D, G, bx); S.offs = loff; S.ntn = D / 256;
                pg8::EpiPlain E{WSP(bf16, WS_HP), D};
                pg8::gemm_phase<pg8::EpiPlain, pg8::MoeOrder, true, true>(lds + RING_OFF, g, S, E, tid);
            PH_END(true)
            PH_BEGIN
                const int4* route = WSP(int4, WS_ROUTE); const int2* slots = WSP(int2, WS_SLOTS); const bf16* HP = WSP(bf16, WS_HP); float* xres = ap->out; const float* g_final = ap->in[15];
#pragma unroll 1
                for (int m = gw; m < T; m += NGW) {
                    const int4 rt = route[m]; const int2 sl = slots[m]; const float w1 = __int_as_float(rt.z), w2 = __int_as_float(rt.w);
                    GAS f32x4* xr = (GAS f32x4*)(xres + (size_t)m * D) + lane; const GAS f32x4* gr = (const GAS f32x4*)g_final + lane;
                    const GAS u32x2v* y1 = (const GAS u32x2v*)(HP + (size_t)sl.x * D) + lane; const GAS u32x2v* y2 = (const GAS u32x2v*)(HP + (size_t)sl.y * D) + lane;
                    f32x4 v[4]; float s = 0.f;
#pragma unroll
                    for (int j = 0; j < 4; ++j) { v[j] = xr[64 * j]; const u32x2v a = y1[64 * j], b = y2[64 * j];
                        v[j].x += w1 * __builtin_bit_cast(float, a.x << 16) + w2 * __builtin_bit_cast(float, b.x << 16);
                        v[j].y += w1 * __builtin_bit_cast(float, a.x & 0xffff0000u) + w2 * __builtin_bit_cast(float, b.x & 0xffff0000u);
                        v[j].z += w1 * __builtin_bit_cast(float, a.y << 16) + w2 * __builtin_bit_cast(float, b.y << 16);
                        v[j].w += w1 * __builtin_bit_cast(float, a.y & 0xffff0000u) + w2 * __builtin_bit_cast(float, b.y & 0xffff0000u);
                        s += (v[j].x * v[j].x + v[j].y * v[j].y) + (v[j].z * v[j].z + v[j].w * v[j].w); }
                    const float rstd = 1.0f / sqrtf(wave_sum(s) * (1.f / D) + EPS);
#pragma unroll
                    for (int j = 0; j < 4; ++j) { const f32x4 gg = gr[64 * j]; xr[64 * j] = (f32x4){v[j].x * rstd * gg.x, v[j].y * rstd * gg.y, v[j].z * rstd * gg.z, v[j].w * rstd * gg.w}; }
                }
            PH_END(false)
        }
    }
#ifdef PROBE_CLK
    if (blockIdx.x == 0) { const unsigned long long t0_ = __builtin_amdgcn_s_memrealtime(); const unsigned long long want = (unsigned long long)(probe_cycles / 64); while (__builtin_amdgcn_s_memrealtime() - t0_ < want) __builtin_amdgcn_s_sleep(4); }
#endif
}

extern "C" void kernel_launch(void* const* d_in, const int* in_sizes, int n_in, void* d_out, int out_size, void* d_ws, size_t ws_size, hipStream_t stream) {
    static int grid = 0;
    if (grid == 0) {
        if (n_in != 16 || in_sizes[0] != T * D || out_size != T * D || ws_size < WS_END) { fprintf(stderr, "kernel_launch: unexpected shapes (n_in %d, in0 %d, out %d, ws %zu); nothing launched\n", n_in, n_in > 0 ? in_sizes[0] : -1, out_size, ws_size); grid = -1; return; }
        int dev = 0, cus = 0, per_cu = 0;
        if (hipGetDevice(&dev) != hipSuccess || hipDeviceGetAttribute(&cus, hipDeviceAttributeMultiprocessorCount, dev) != hipSuccess) { grid = -1; return; }
        if (hipFuncSetAttribute((const void*)mega_fwd, hipFuncAttributeMaxDynamicSharedMemorySize, LDS_BYTES) != hipSuccess) { fprintf(stderr, "kernel_launch: hipFuncSetAttribute failed\n"); grid = -1; return; }
        if (hipOccupancyMaxActiveBlocksPerMultiprocessor(&per_cu, (const void*)mega_fwd, NWAVES * 64, LDS_BYTES) != hipSuccess || per_cu < 1) { fprintf(stderr, "kernel_launch: occupancy query reports %d workgroups per CU\n", per_cu); }
        (void)hipGetLastError();
        grid = cus;
        while (grid > 1 && (T % grid) != 0) --grid;
    }
    if (grid < 0) return;
    if (hipMemsetAsync((char*)d_ws + WS_CTL, 0, CTL_ZERO_BYTES, stream) != hipSuccess) return;
    Args a{};
    for (int i = 0; i < 16; ++i) a.in[i] = (const float*)d_in[i];
    a.out = (float*)d_out; a.ws = (unsigned char*)d_ws;
    hipLaunchKernelGGL(mega_fwd, dim3(grid), dim3(NWAVES * 64), LDS_BYTES, stream, a);
}
```

```cpp
#include <hip/hip_runtime.h>
#include <cstdio>
#include <cstdint>
#include <cmath>
#ifndef PG8_RELAX
#define PG8_RELAX 1
#endif
namespace pg8 {
#define PG8_LAS __attribute__((address_space(3)))
typedef unsigned short bf16_t;
typedef short bf16x8 __attribute__((ext_vector_type(8)));
typedef float f32x4 __attribute__((ext_vector_type(4)));
typedef unsigned u32x4 __attribute__((ext_vector_type(4)));
constexpr int BM = 256, BK = 64, HALF = 128, HTB = HALF * BK * 2  , STAGE_BYTES = 8 * HTB, NXCD = 8, WGM = 8;

__host__ __device__ __forceinline__ int lds_byte(int r, int c) { const int st = (r >> 4) * 2 + (c >> 5), rr = r & 15, cc = c & 31, ob = rr * 64 + cc * 2; return st * 1024 + (ob ^ (((ob >> 9) & 1) << 5)); }
__host__ __device__ __forceinline__ void stage_rc(int b, int& R, int& C) { const int st = b / 1024, sb = b % 1024, swz = sb ^ (((sb >> 9) & 1) << 5); R = (st >> 1) * 16 + swz / 64; C = (st & 1) * 32 + (swz % 64) / 2; }
__host__ __device__ __forceinline__ int perm32(int rho) { const int n = rho >> 4, i = rho & 15; return 8 * (i >> 2) + 4 * n + (i & 3); }

struct Unit { int pm, pn, pb; };
struct Gemm { const bf16_t* A; const bf16_t* Bt; int M, N, K; };

struct StaticOrder {
    int nM, nN, nwg, G, c;
    __host__ __device__ void init(int M, int N, int G_, int c_) { nM = M / BM; nN = N / BM; nwg = nM * nN; G = G_; c = c_; }
    __host__ __device__ bool next(int i, Unit& u) const {
        const long L = (long)i * G + c; if (L >= nwg) return false;
        int wgid = (int)L; { const int q = nwg / NXCD, r = nwg % NXCD, xcd = wgid % NXCD, off = wgid / NXCD; wgid = (xcd < r ? xcd * (q + 1) : r * (q + 1) + (xcd - r) * q) + off; }
        const int nig = WGM * nN, gid = wgid / nig, fm = gid * WGM, gsz = (nM - fm) < WGM ? (nM - fm) : WGM;
        u.pm = fm + ((wgid % nig) % gsz); u.pn = (wgid % nig) / gsz; u.pb = u.pn; return true;
    }
    __device__ __forceinline__ void a_ready(const Unit&) const {}
    __device__ __forceinline__ void done(const Unit&) const {}
};

__device__ __forceinline__ unsigned cvt_pk_bf16(float lo, float hi) { unsigned r; asm volatile("v_cvt_pk_bf16_f32 %0, %1, %2" : "=v"(r) : "v"(lo), "v"(hi)); return r; }
typedef float f32x2 __attribute__((ext_vector_type(2)));

__device__ __forceinline__ float sigmoidf_fast(float x) { return __builtin_amdgcn_rcpf(1.0f + __builtin_amdgcn_exp2f(-1.4426950408889634f * x)); }
__device__ __forceinline__ float bf_lo(unsigned w) { return __builtin_bit_cast(float, w << 16); }
__device__ __forceinline__ float bf_hi(unsigned w) { return __builtin_bit_cast(float, w & 0xffff0000u); }
__device__ __forceinline__ void unpack8(const u32x4 w, float (&f)[8]) { f[0] = bf_lo(w.x); f[1] = bf_hi(w.x); f[2] = bf_lo(w.y); f[3] = bf_hi(w.y); f[4] = bf_lo(w.z); f[5] = bf_hi(w.z); f[6] = bf_lo(w.w); f[7] = bf_hi(w.w); }
__device__ __forceinline__ u32x4 pack8(const float (&f)[8]) { u32x4 w; w.x = cvt_pk_bf16(f[0], f[1]); w.y = cvt_pk_bf16(f[2], f[3]); w.z = cvt_pk_bf16(f[4], f[5]); w.w = cvt_pk_bf16(f[6], f[7]); return w; }

struct EpiProj {
    static constexpr int NVMEM = 16;
    static constexpr bool PERM = true, AFTER_DRAIN = false;
    bf16_t* PA; bf16_t* QF; bf16_t* KF; bf16_t* GT; float qscale;
    __device__ __forceinline__ void operator()(const f32x4 (&acc)[2][2][4][2], const Unit& u, int wr, int wc, int fr, int fq) const {
        const int row0 = u.pm * BM + wr * 64 + fr;
        if (u.pn >= 6 && u.pn < 10) {
            const bool isq = u.pn < 8; const float sc = isq ? qscale : 1.f; bf16_t* base = isq ? QF : KF;
            const int hc0 = (u.pn - (isq ? 6 : 8)) * BM + wc * 32 + 8 * fq;
#pragma unroll
            for (int ai = 0; ai < 2; ++ai)
#pragma unroll
                for (int m = 0; m < 4; ++m) { const int row = row0 + ai * HALF + m * 16; const int b = row >> 12, t = row & 4095, blk = t >> 5, tl = t & 31;
                    const int li = isq ? tl : ((tl & 19) | ((tl & 4) << 1) | ((tl & 8) >> 1));
#pragma unroll
                    for (int bj = 0; bj < 2; ++bj) { const int hc = hc0 + bj * HALF, h = hc >> 6, c = (hc & 63) >> 3, d0 = c >> 1, hg = c & 1;
                        const f32x4 v0 = acc[ai][bj][m][0] * sc, v1 = acc[ai][bj][m][1] * sc;
                        u32x4 w; w.x = cvt_pk_bf16(v0[0], v0[1]); w.y = cvt_pk_bf16(v0[2], v0[3]); w.z = cvt_pk_bf16(v1[0], v1[1]); w.w = cvt_pk_bf16(v1[2], v1[3]);
                        *(u32x4*)(base + ((((size_t)(b * 8 + h) * 128 + blk) * 4 + d0) * 64 + hg * 32 + li) * 8) = w; } }
            return;
        }
        bf16_t* base; int ldc, colt;
        if (u.pn < 6) { base = PA; ldc = 1536; colt = u.pn * BM; } else { base = GT; ldc = 2048; colt = (u.pn - 10) * BM; }
        const int col0 = colt + wc * 32 + 8 * fq;
#pragma unroll
        for (int ai = 0; ai < 2; ++ai)
#pragma unroll
            for (int m = 0; m < 4; ++m) { bf16_t* rowp = base + (size_t)(row0 + ai * HALF + m * 16) * ldc + col0;
#pragma unroll
                for (int bj = 0; bj < 2; ++bj) { const f32x4 v0 = acc[ai][bj][m][0], v1 = acc[ai][bj][m][1];
                    u32x4 w; w.x = cvt_pk_bf16(v0[0], v0[1]); w.y = cvt_pk_bf16(v0[2], v0[3]); w.z = cvt_pk_bf16(v1[0], v1[1]); w.w = cvt_pk_bf16(v1[2], v1[3]);
                    *(u32x4*)(rowp + bj * HALF) = w; } }
    }
};
struct EpiVT {
    static constexpr int NVMEM = 16;
    static constexpr bool PERM = true, AFTER_DRAIN = false;
    bf16_t* VF;
    __device__ __forceinline__ void operator()(const f32x4 (&acc)[2][2][4][2], const Unit& u, int wr, int wc, int fr, int fq) const {
        const int row0 = u.pm * BM + wr * 64 + fr, tok0 = u.pn * BM + wc * 32 + 8 * fq;
#pragma unroll
        for (int ai = 0; ai < 2; ++ai)
#pragma unroll
            for (int m = 0; m < 4; ++m) { const int hd = row0 + ai * HALF + m * 16, h = hd >> 6, dblk = (hd >> 5) & 1, dl = hd & 31;
#pragma unroll
                for (int bj = 0; bj < 2; ++bj) { const int tok = tok0 + bj * HALF, b = tok >> 12, t = tok & 4095, blk = t >> 5, s = (t >> 4) & 1, hg = (t >> 3) & 1;
                    const f32x4 v0 = acc[ai][bj][m][0], v1 = acc[ai][bj][m][1];
                    u32x4 w; w.x = cvt_pk_bf16(v0[0], v0[1]); w.y = cvt_pk_bf16(v0[2], v0[3]); w.z = cvt_pk_bf16(v1[0], v1[1]); w.w = cvt_pk_bf16(v1[2], v1[3]);
                    *(u32x4*)(VF + ((((size_t)(b * 8 + h) * 128 + blk) * 4 + dblk * 2 + s) * 64 + hg * 32 + dl) * 8) = w; } }
    }
};
struct EpiPlain {
    static constexpr int NVMEM = 16;
    static constexpr bool PERM = true, AFTER_DRAIN = false;
    bf16_t* O; int ldc;
    __device__ __forceinline__ void operator()(const f32x4 (&acc)[2][2][4][2], const Unit& u, int wr, int wc, int fr, int fq) const {
        const int row0 = u.pm * BM + wr * 64 + fr, col0 = u.pn * BM + wc * 32 + 8 * fq;
#pragma unroll
        for (int ai = 0; ai < 2; ++ai)
#pragma unroll
            for (int m = 0; m < 4; ++m) { bf16_t* rowp = O + (size_t)(row0 + ai * HALF + m * 16) * ldc + col0;
#pragma unroll
                for (int bj = 0; bj < 2; ++bj) { const f32x4 v0 = acc[ai][bj][m][0], v1 = acc[ai][bj][m][1];
                    u32x4 w; w.x = cvt_pk_bf16(v0[0], v0[1]); w.y = cvt_pk_bf16(v0[2], v0[3]); w.z = cvt_pk_bf16(v1[0], v1[1]); w.w = cvt_pk_bf16(v1[2], v1[3]);
                    *(u32x4*)(rowp + bj * HALF) = w; } }
    }
};
struct EpiSwiGLU {
    static constexpr int NVMEM = 8;
    static constexpr bool PERM = true, AFTER_DRAIN = false;
    bf16_t* O; int ldc;
    __device__ __forceinline__ void operator()(const f32x4 (&acc)[2][2][4][2], const Unit& u, int wr, int wc, int fr, int fq) const {
        const int row0 = u.pm * BM + wr * 64 + fr, col0 = u.pn * HALF + wc * 32 + 8 * fq;
#pragma unroll
        for (int ai = 0; ai < 2; ++ai)
#pragma unroll
            for (int m = 0; m < 4; ++m) { bf16_t* rowp = O + (size_t)(row0 + ai * HALF + m * 16) * ldc + col0;
                float o[8];
#pragma unroll
                for (int n = 0; n < 2; ++n)
#pragma unroll
                    for (int i = 0; i < 4; ++i) { const float g = acc[ai][0][m][n][i], up = acc[ai][1][m][n][i]; o[4 * n + i] = g * sigmoidf_fast(g) * up; }
                *(u32x4*)rowp = pack8(o); }
    }
};
struct EpiGateA {
    static constexpr int NVMEM = 16;
    static constexpr bool PERM = true, AFTER_DRAIN = false;
    const bf16_t* GT; bf16_t* TMP;
    __device__ __forceinline__ void operator()(const f32x4 (&acc)[2][2][4][2], const Unit& u, int wr, int wc, int fr, int fq) const {
        const int row0 = u.pm * BM + wr * 64 + fr, col0 = u.pn * BM + wc * 32 + 8 * fq;
#pragma unroll
        for (int ai = 0; ai < 2; ++ai)
#pragma unroll
            for (int m = 0; m < 4; ++m) { const size_t r = (size_t)(row0 + ai * HALF + m * 16);
#pragma unroll
                for (int bj = 0; bj < 2; ++bj) { const int c = col0 + bj * HALF;
                    float g[8], o[8]; unpack8(*(const u32x4*)(GT + r * 2048 + c), g);
#pragma unroll
                    for (int n = 0; n < 2; ++n)
#pragma unroll
                        for (int i = 0; i < 4; ++i) o[4 * n + i] = sigmoidf_fast(g[4 * n + i]) * acc[ai][bj][m][n][i];
                    *(u32x4*)(TMP + r * 1024 + c) = pack8(o); } }
    }
};
struct EpiGateB {
    static constexpr int NVMEM = 16;
    static constexpr bool PERM = true, AFTER_DRAIN = false;
    const bf16_t* GT; const bf16_t* TMP; bf16_t* MIX;
    __device__ __forceinline__ void operator()(const f32x4 (&acc)[2][2][4][2], const Unit& u, int wr, int wc, int fr, int fq) const {
        const int row0 = u.pm * BM + wr * 64 + fr, col0 = u.pn * BM + wc * 32 + 8 * fq;
#pragma unroll
        for (int ai = 0; ai < 2; ++ai)
#pragma unroll
            for (int m = 0; m < 4; ++m) { const size_t r = (size_t)(row0 + ai * HALF + m * 16);
#pragma unroll
                for (int bj = 0; bj < 2; ++bj) { const int c = col0 + bj * HALF;
                    float g[8], t[8], o[8]; unpack8(*(const u32x4*)(GT + r * 2048 + 1024 + c), g); unpack8(*(const u32x4*)(TMP + r * 1024 + c), t);
#pragma unroll
                    for (int n = 0; n < 2; ++n)
#pragma unroll
                        for (int i = 0; i < 4; ++i) o[4 * n + i] = t[4 * n + i] + sigmoidf_fast(g[4 * n + i]) * acc[ai][bj][m][n][i];
                    *(u32x4*)(MIX + r * 1024 + c) = pack8(o); } }
    }
};
struct EpiRes {
    static constexpr int NVMEM = 32;
    static constexpr bool PERM = false, AFTER_DRAIN = false;
    const float* base; float* out; int ldc;
    __device__ __forceinline__ void operator()(const f32x4 (&acc)[2][2][4][2], const Unit& u, int wr, int wc, int fr, int fq) const {
        const int row0 = u.pm * BM + wr * 64 + fr, col0 = u.pn * BM + wc * 32 + 4 * fq;
#pragma unroll
        for (int ai = 0; ai < 2; ++ai)
#pragma unroll
            for (int m = 0; m < 4; ++m) { const size_t off = (size_t)(row0 + ai * HALF + m * 16) * ldc + col0;
#pragma unroll
                for (int bj = 0; bj < 2; ++bj)
#pragma unroll
                    for (int n = 0; n < 2; ++n) { const f32x4 b = *(const f32x4*)(base + off + bj * HALF + n * 16); *(f32x4*)(out + off + bj * HALF + n * 16) = b + acc[ai][bj][m][n]; } }
    }
};
__device__ __forceinline__ unsigned pk4_fp8(float a, float b, float c, float d) {
    a = __builtin_amdgcn_fmed3f(a, -448.f, 448.f); b = __builtin_amdgcn_fmed3f(b, -448.f, 448.f); c = __builtin_amdgcn_fmed3f(c, -448.f, 448.f); d = __builtin_amdgcn_fmed3f(d, -448.f, 448.f);
    int w = 0; w = __builtin_amdgcn_cvt_pk_fp8_f32(a, b, w, false); w = __builtin_amdgcn_cvt_pk_fp8_f32(c, d, w, true); return (unsigned)w;
}
struct EpiSwiGLU8 {
    static constexpr int NVMEM = 8;
    static constexpr bool PERM = true, AFTER_DRAIN = false;
    unsigned char* O; int ldc; float wsc, osc;
    __device__ __forceinline__ void operator()(const f32x4 (&acc)[2][2][4][2], const Unit& u, int wr, int wc, int fr, int fq) const {
        const int row0 = u.pm * BM + wr * 64 + fr, col0 = u.pn * HALF + wc * 32 + 8 * fq;
        typedef unsigned u32x2 __attribute__((ext_vector_type(2)));
#pragma unroll
        for (int ai = 0; ai < 2; ++ai)
#pragma unroll
            for (int m = 0; m < 4; ++m) { unsigned char* rowp = O + (size_t)(row0 + ai * HALF + m * 16) * ldc + col0;
                float o[8];
#pragma unroll
                for (int n = 0; n < 2; ++n)
#pragma unroll
                    for (int i = 0; i < 4; ++i) { const float g = acc[ai][0][m][n][i] * wsc, up = acc[ai][1][m][n][i] * wsc; o[4 * n + i] = g * sigmoidf_fast(g) * up * osc; }
                u32x2 w; w.x = pk4_fp8(o[0], o[1], o[2], o[3]); w.y = pk4_fp8(o[4], o[5], o[6], o[7]);
                *(u32x2*)rowp = w; }
    }
};
struct EpiPlainS {
    static constexpr int NVMEM = 16;
    static constexpr bool PERM = true, AFTER_DRAIN = false;
    bf16_t* O; int ldc; float sc;
    __device__ __forceinline__ void operator()(const f32x4 (&acc)[2][2][4][2], const Unit& u, int wr, int wc, int fr, int fq) const {
        const int row0 = u.pm * BM + wr * 64 + fr, col0 = u.pn * BM + wc * 32 + 8 * fq;
#pragma unroll
        for (int ai = 0; ai < 2; ++ai)
#pragma unroll
            for (int m = 0; m < 4; ++m) { bf16_t* rowp = O + (size_t)(row0 + ai * HALF + m * 16) * ldc + col0;
#pragma unroll
                for (int bj = 0; bj < 2; ++bj) { const f32x4 v0 = acc[ai][bj][m][0] * sc, v1 = acc[ai][bj][m][1] * sc;
                    u32x4 w; w.x = cvt_pk_bf16(v0[0], v0[1]); w.y = cvt_pk_bf16(v0[2], v0[3]); w.z = cvt_pk_bf16(v1[0], v1[1]); w.w = cvt_pk_bf16(v1[2], v1[3]);
                    *(u32x4*)(rowp + bj * HALF) = w; } }
    }
};
struct EpiNull {
    static constexpr int NVMEM = 0;
    static constexpr bool PERM = true, AFTER_DRAIN = false;
    __device__ __forceinline__ void operator()(const f32x4 (&acc)[2][2][4][2], const Unit& u, int wr, int wc, int fr, int fq) const {
#pragma unroll
        for (int ai = 0; ai < 2; ++ai)
#pragma unroll
            for (int bj = 0; bj < 2; ++bj)
#pragma unroll
                for (int m = 0; m < 4; ++m)
#pragma unroll
                    for (int n = 0; n < 2; ++n) asm volatile("" :: "v"(acc[ai][bj][m][n]));
    }
};
struct EpiL2 {
    static constexpr int NVMEM = 16;
    static constexpr bool PERM = true, AFTER_DRAIN = false;
    bf16_t* S; int bx;
    __device__ __forceinline__ void operator()(const f32x4 (&acc)[2][2][4][2], const Unit& u, int wr, int wc, int fr, int fq) const {
        const int row0 = wr * 64 + fr, col0 = wc * 32 + 8 * fq; bf16_t* base = S + (size_t)bx * 65536;
#pragma unroll
        for (int ai = 0; ai < 2; ++ai)
#pragma unroll
            for (int m = 0; m < 4; ++m) {
#ifdef PROBE_L2W
                bf16_t* rowp = base + (size_t)(wr * 64 + (fr >> 1) + ai * HALF + m * 16) * 256 + wc * 64 + (fr & 1) * 32 + 8 * fq;
#else
                bf16_t* rowp = base + (size_t)(row0 + ai * HALF + m * 16) * 256 + col0;
#endif
#pragma unroll
                for (int bj = 0; bj < 2; ++bj) { const f32x4 v0 = acc[ai][bj][m][0], v1 = acc[ai][bj][m][1];
                    u32x4 w; w.x = cvt_pk_bf16(v0[0], v0[1]); w.y = cvt_pk_bf16(v0[2], v0[3]); w.z = cvt_pk_bf16(v1[0], v1[1]); w.w = cvt_pk_bf16(v1[2], v1[3]);
#ifdef PROBE_L2ONE
                    if (ai == 0 && m == 0 && bj == 0) *(u32x4*)(rowp + bj * HALF) = w; else asm volatile("" :: "v"(w));
#else
                    *(u32x4*)(rowp + bj * HALF) = w;
#endif
                    } }
    }
};
struct MoeOrder : StaticOrder {
    const volatile PG8_LAS unsigned* offs; int ntn;
    __device__ __forceinline__ bool next(int i, Unit& u) const {
        if (!StaticOrder::next(i, u)) return false;
        const unsigned row = (unsigned)u.pm * BM; int e = 0;
#pragma unroll
        for (int k = 1; k < 8; ++k) e += (row >= offs[k]) ? 1 : 0;
        u.pb = e * ntn + u.pn; return true;
    }
};
typedef int i32x8 __attribute__((ext_vector_type(8))); typedef int i32x4 __attribute__((ext_vector_type(4)));
__device__ __forceinline__ i32x8 cat8(const bf16x8 lo, const bf16x8 hi) { const i32x4 a = __builtin_bit_cast(i32x4, lo), b = __builtin_bit_cast(i32x4, hi); return (i32x8){a.x, a.y, a.z, a.w, b.x, b.y, b.z, b.w}; }
template <class Epi, class Sched, bool ALIGN_EPI = false, bool SP2 = false, bool FP8 = false>
__device__ __forceinline__ void gemm_phase(PG8_LAS unsigned char* lds, const Gemm g, const Sched& S, const Epi& E, const int tid) {
    const int wid = __builtin_amdgcn_readfirstlane(tid >> 6), lane = tid & 63, wr = wid >> 2, wc = wid & 3, fr = lane & 15, fq = lane >> 4;
    const int K = g.K, nt = K / BK;
    unsigned voffA[2], voffB[2];
#pragma unroll
    for (int i = 0; i < 2; ++i) { int R, C; stage_rc(tid * 16 + i * 8192, R, C); const int Rb = Epi::PERM ? ((R & ~31) + perm32(R & 31)) : R;
        voffA[i] = (unsigned)(R * K + C) * 2u; voffB[i] = (unsigned)(Rb * K + C) * 2u; }
    const size_t kstep = (size_t)(BK * 2);
    const size_t hstep = (size_t)HALF * K * 2;
    const size_t tstep = 2 * hstep;
    const unsigned ldsw = (unsigned)wid * 1024u;
    const int aoff = lds_byte(wr * 64 + fr, fq * 8), boff = lds_byte(wc * 32 + fr, fq * 8);
#define PG8_SA(b, h) (((b) * 2 + (h)) * HTB)
#define PG8_SB(b, h) ((4 + (b) * 2 + (h)) * HTB)
#define PG8_STAGE(bufoff, gbase, voff) do { _Pragma("unroll") for (int _i = 0; _i < 2; ++_i) \
        __builtin_amdgcn_global_load_lds((const unsigned*)((const char*)(gbase) + (voff)[_i]), (PG8_LAS unsigned*)(lds + (bufoff) + ldsw + _i * 8192), 16, 0, 0); } while (0)
#define PG8_LDA(dst, b, h) do { if constexpr (FP8) { _Pragma("unroll") for (int m = 0; m < 4; ++m) { const i32x4 l_ = *(const PG8_LAS i32x4*)(lds + PG8_SA(b, h) + aoff + m * 2048), h_ = *(const PG8_LAS i32x4*)(lds + PG8_SA(b, h) + aoff + m * 2048 + 1024); dst##8[m] = (i32x8){l_.x, l_.y, l_.z, l_.w, h_.x, h_.y, h_.z, h_.w}; } } \
        else { _Pragma("unroll") for (int m = 0; m < 4; ++m) _Pragma("unroll") for (int k = 0; k < 2; ++k) dst[m][k] = *(const PG8_LAS i32x4*)(lds + PG8_SA(b, h) + aoff + m * 2048 + k * 1024); } } while (0)
#define PG8_LDB(dst, b, h) do { if constexpr (FP8) { _Pragma("unroll") for (int n = 0; n < 2; ++n) { const i32x4 l_ = *(const PG8_LAS i32x4*)(lds + PG8_SB(b, h) + boff + n * 2048), h_ = *(const PG8_LAS i32x4*)(lds + PG8_SB(b, h) + boff + n * 2048 + 1024); dst##8[n] = (i32x8){l_.x, l_.y, l_.z, l_.w, h_.x, h_.y, h_.z, h_.w}; } } \
        else { _Pragma("unroll") for (int n = 0; n < 2; ++n) _Pragma("unroll") for (int k = 0; k < 2; ++k) dst[n][k] = *(const PG8_LAS i32x4*)(lds + PG8_SB(b, h) + boff + n * 2048 + k * 1024); } } while (0)
#define PG8_MMA(ai, bj, At, Bt) do { __builtin_amdgcn_s_setprio(1); \
        if constexpr (FP8) { _Pragma("unroll") for (int m = 0; m < 4; ++m) _Pragma("unroll") for (int n = 0; n < 2; ++n) \
            asm volatile("v_mfma_scale_f32_16x16x128_f8f6f4 %0, %1, %2, %0, %3, %3 op_sel_hi:[0,0,0]" : "+v"(acc[ai][bj][m][n]) : "v"(Bt##8[n]), "v"(At##8[m]), "v"(sc1_)); } \
        else { _Pragma("unroll") for (int m = 0; m < 4; ++m) _Pragma("unroll") for (int n = 0; n < 2; ++n) _Pragma("unroll") for (int k = 0; k < 2; ++k) \
            acc[ai][bj][m][n] = __builtin_amdgcn_mfma_f32_16x16x32_bf16(__builtin_bit_cast(bf16x8, Bt[n][k]), __builtin_bit_cast(bf16x8, At[m][k]), acc[ai][bj][m][n], 0, 0, 0); } \
        __builtin_amdgcn_s_setprio(0); } while (0)
#define PG8_WAIT_V(n) asm volatile("s_waitcnt vmcnt(" #n ")" ::: "memory")
#define PG8_WAIT_V8R(rel) asm volatile("s_cmp_lg_u32 %0, 0\n\ts_cbranch_scc1 1\n\ts_waitcnt vmcnt(8)\n\ts_waitcnt vmcnt(%1)" :: "s"(rel), "n"(8 + (Epi::NVMEM > 55 ? 55 : Epi::NVMEM)) : "memory", "scc")
#define PG8_WAIT_L(n) asm volatile("s_waitcnt lgkmcnt(" #n ")" ::: "memory")
#define PG8_BAR __builtin_amdgcn_s_barrier()
#define PG8_SCHED __builtin_amdgcn_sched_barrier(0)
    Unit cur, nxt; int ui = 0;
    if (!S.next(0, cur)) return;
    f32x4 acc[2][2][4][2];
#pragma unroll
    for (int a = 0; a < 2; ++a)
#pragma unroll
        for (int b = 0; b < 2; ++b)
#pragma unroll
            for (int m = 0; m < 4; ++m)
#pragma unroll
                for (int n = 0; n < 2; ++n) acc[a][b][m][n] = (f32x4){0.f, 0.f, 0.f, 0.f};
    int sc1_ = 0x7f7f7f7f; asm volatile("" : "+v"(sc1_));
    typedef i32x4 frag_t; frag_t At[4][2], B0[2][2], B1[2][2]; i32x8 At8[4], B08[2], B18[2];
    const char* cA = (const char*)g.A + (size_t)cur.pm * tstep; const char* cB = (const char*)g.Bt + (size_t)cur.pb * tstep;
    S.a_ready(cur);
    if constexpr (SP2) {
        PG8_STAGE(PG8_SB(0, 0), cB, voffB); PG8_STAGE(PG8_SB(0, 1), cB + hstep, voffB); PG8_STAGE(PG8_SA(0, 0), cA, voffA); PG8_STAGE(PG8_SA(0, 1), cA + hstep, voffA);
        if (wr == 1) PG8_BAR;
        PG8_WAIT_V(2); PG8_BAR;
        PG8_STAGE(PG8_SB(1, 0), cB + kstep, voffB); PG8_STAGE(PG8_SA(1, 0), cA + kstep, voffA); PG8_STAGE(PG8_SB(1, 1), cB + hstep + kstep, voffB);
        PG8_WAIT_V(6); PG8_BAR;
    } else {
        PG8_STAGE(PG8_SB(0, 0), cB, voffB); PG8_STAGE(PG8_SA(0, 0), cA, voffA); PG8_STAGE(PG8_SB(0, 1), cB + hstep, voffB); PG8_STAGE(PG8_SA(0, 1), cA + hstep, voffA);
        if (wr == 1) PG8_BAR;
        PG8_WAIT_V(4); PG8_BAR;
        PG8_STAGE(PG8_SB(1, 0), cB + kstep, voffB); PG8_STAGE(PG8_SA(1, 0), cA + kstep, voffA); PG8_STAGE(PG8_SB(1, 1), cB + hstep + kstep, voffB);
        PG8_WAIT_V(6); PG8_BAR;
    }
    for (;;) {
        const bool has_next = S.next(ui + 1, nxt);
        const char* nA = has_next ? (const char*)g.A + (size_t)nxt.pm * tstep : cA; const char* nB = has_next ? (const char*)g.Bt + (size_t)nxt.pb * tstep : cB;
        for (int t = 0; t < nt; t += 2) {
            const bool last = (t == nt - 2);
            const int relax = __builtin_amdgcn_readfirstlane((PG8_RELAX && (t == 0) && (ui > 0)) ? 1 : 0);
            const char* a1 = cA + (size_t)(t + 1) * kstep;
            const char* a2 = last ? nA : cA + (size_t)(t + 2) * kstep; const char* b2 = last ? nB : cB + (size_t)(t + 2) * kstep;
            const char* a3 = a2 + kstep; const char* b3 = b2 + kstep;
            if (last && has_next) S.a_ready(nxt);
            if constexpr (SP2) {
            PG8_LDB(B0, 0, 0); PG8_LDB(B1, 0, 1); PG8_SCHED; PG8_LDA(At, 0, 0); PG8_STAGE(PG8_SA(1, 1), a1 + hstep, voffA);
            PG8_WAIT_V8R(relax); PG8_WAIT_L(0); PG8_BAR; PG8_MMA(0, 0, At, B0); PG8_MMA(0, 1, At, B1); PG8_BAR; PG8_SCHED;
            PG8_LDA(At, 0, 1); PG8_STAGE(PG8_SB(0, 0), b2, voffB); PG8_STAGE(PG8_SB(0, 1), b2 + hstep, voffB); PG8_STAGE(PG8_SA(0, 0), a2, voffA);
            PG8_WAIT_V8R(relax); PG8_WAIT_L(0); PG8_BAR; PG8_MMA(1, 0, At, B0); PG8_MMA(1, 1, At, B1); PG8_BAR; PG8_SCHED;
            PG8_LDB(B0, 1, 0); PG8_LDB(B1, 1, 1); PG8_SCHED; PG8_LDA(At, 1, 0); PG8_STAGE(PG8_SA(0, 1), a2 + hstep, voffA);
            PG8_WAIT_V(8); PG8_WAIT_L(0); PG8_BAR; PG8_MMA(0, 0, At, B0); PG8_MMA(0, 1, At, B1); PG8_BAR; PG8_SCHED;
            PG8_LDA(At, 1, 1); PG8_STAGE(PG8_SB(1, 0), b3, voffB); PG8_STAGE(PG8_SB(1, 1), b3 + hstep, voffB); PG8_STAGE(PG8_SA(1, 0), a3, voffA);
            PG8_WAIT_V(8); PG8_WAIT_L(0); PG8_BAR; PG8_MMA(1, 0, At, B0); PG8_MMA(1, 1, At, B1); PG8_BAR; PG8_SCHED;
            } else {
            PG8_LDB(B0, 0, 0); PG8_SCHED; PG8_LDA(At, 0, 0); PG8_STAGE(PG8_SA(1, 1), a1 + hstep, voffA);
            PG8_WAIT_L(8); PG8_BAR; PG8_WAIT_L(0); PG8_MMA(0, 0, At, B0); PG8_BAR; PG8_SCHED;
            PG8_LDB(B1, 0, 1); PG8_STAGE(PG8_SB(0, 0), b2, voffB);
            PG8_BAR; PG8_WAIT_L(0); PG8_MMA(0, 1, At, B1); PG8_BAR;
            PG8_LDA(At, 0, 1); PG8_STAGE(PG8_SA(0, 0), a2, voffA);
            PG8_BAR; PG8_WAIT_L(0); PG8_MMA(1, 0, At, B0); PG8_BAR; PG8_SCHED;
            PG8_STAGE(PG8_SB(0, 1), b2 + hstep, voffB);
            PG8_WAIT_V(6); PG8_BAR; PG8_MMA(1, 1, At, B1); PG8_BAR;
            PG8_LDB(B0, 1, 0); PG8_SCHED; PG8_LDA(At, 1, 0); PG8_STAGE(PG8_SA(0, 1), a2 + hstep, voffA);
            PG8_WAIT_L(8); PG8_BAR; PG8_WAIT_L(0); PG8_MMA(0, 0, At, B0); PG8_BAR; PG8_SCHED;
            PG8_LDB(B1, 1, 1); PG8_STAGE(PG8_SB(1, 0), b3, voffB);
            PG8_BAR; PG8_WAIT_L(0); PG8_MMA(0, 1, At, B1); PG8_BAR;
            PG8_LDA(At, 1, 1); PG8_STAGE(PG8_SA(1, 0), a3, voffA);
            PG8_BAR; PG8_WAIT_L(0); PG8_MMA(1, 0, At, B0); PG8_BAR; PG8_SCHED;
            PG8_STAGE(PG8_SB(1, 1), b3 + hstep, voffB);
            PG8_WAIT_V(6); PG8_BAR; PG8_MMA(1, 1, At, B1); PG8_BAR;
            }
        }
        if constexpr (FP8) asm volatile("s_nop 15\n\ts_nop 15" ::: "memory");
        if constexpr (ALIGN_EPI) { if (wr == 0) PG8_BAR; }
        if constexpr (!Epi::AFTER_DRAIN) { E(acc, cur, wr, wc, fr, fq); S.done(cur); }
        if (!has_next) break;
#pragma unroll
        for (int a = 0; a < 2; ++a)
#pragma unroll
            for (int b = 0; b < 2; ++b)
#pragma unroll
                for (int m = 0; m < 4; ++m)
#pragma unroll
                    for (int n = 0; n < 2; ++n) acc[a][b][m][n] = (f32x4){0.f, 0.f, 0.f, 0.f};
        cur = nxt; cA = nA; cB = nB; ++ui;
        if constexpr (ALIGN_EPI) { if (wr == 1) PG8_BAR; }
    }
    PG8_WAIT_V(0);
    if constexpr (!ALIGN_EPI) { if (wr == 0) PG8_BAR; }
    PG8_BAR;
    if constexpr (Epi::AFTER_DRAIN) { E.fused(acc, cur, wr, wc, fr, fq, lds, wid, lane); S.done(cur); }
#undef PG8_SA
#undef PG8_SB
#undef PG8_STAGE
#undef PG8_LDA
#undef PG8_LDB
#undef PG8_MMA
#undef PG8_WAIT_V
#undef PG8_WAIT_V8R
#undef PG8_WAIT_L
#undef PG8_BAR
#undef PG8_SCHED
}
}
#define GAS __attribute__((address_space(1)))
#define LAS __attribute__((address_space(3)))
typedef unsigned short bf16;
typedef unsigned v4u __attribute__((ext_vector_type(4)));
typedef float f32x4 __attribute__((ext_vector_type(4)));
typedef short bf16x8 __attribute__((ext_vector_type(8)));
typedef GAS unsigned gu32;
typedef GAS unsigned long long gu64;
#define RLX_AGENT __ATOMIC_RELAXED, __HIP_MEMORY_SCOPE_AGENT
#define LDS_WAIT() asm volatile("s_waitcnt lgkmcnt(0)" ::: "memory")
#define VM_WAIT() asm volatile("s_waitcnt vmcnt(0)" ::: "memory")
__device__ __forceinline__ unsigned long long rt() { return __builtin_amdgcn_s_memrealtime(); }
__device__ __forceinline__ unsigned f2bf(float f) { unsigned u = __builtin_bit_cast(unsigned, f); return (u + 0x7fffu + ((u >> 16) & 1u)) >> 16; }
__device__ __forceinline__ unsigned pk2(float lo, float hi) { return f2bf(lo) | (f2bf(hi) << 16); }

#define XB_TMO      128
#define XB_XCNT(j)  (256  + 64 * (j))
#define XB_XSUB(j)  (1280 + 64 * (j))
#define XB_XGEN(j)  (2304 + 64 * (j))
#define XB_TOP      3328
#define XB_TOPGEN   3392
#define XCD_BAR_WORDS 3456
#define XB_SPIN_CAP (1u << 18)

__device__ __forceinline__ unsigned xb_ld(unsigned* p)              { return __hip_atomic_load(p, __ATOMIC_RELAXED, __HIP_MEMORY_SCOPE_AGENT); }
__device__ __forceinline__ unsigned xb_add(unsigned* p, unsigned v) { return __hip_atomic_fetch_add(p, v, __ATOMIC_RELAXED, __HIP_MEMORY_SCOPE_AGENT); }
__device__ __forceinline__ unsigned xb_xcc_id() { return (unsigned)__builtin_amdgcn_s_getreg((3 << 11) | 20) & 0xFu; }
#define XB_SPIN(cond, bar) do { unsigned _sp = 0; while (cond) { __builtin_amdgcn_s_sleep(1); \
    if ((++_sp & 255u) == 0u) { if (xb_ld(&(bar)[XB_TMO])) break; if (_sp > XB_SPIN_CAP) { atomicAdd(&(bar)[XB_TMO], 1u); break; } } } } while (0)

struct XcdBarrier {
    unsigned* bar; unsigned x;
    volatile LAS unsigned* st;
};

__device__ __forceinline__ XcdBarrier xcd_barrier_post(unsigned* bar, volatile LAS unsigned* st) {
    XcdBarrier b; b.bar = bar; b.x = xb_xcc_id(); b.st = st;
    if (threadIdx.x == 0) (void)xb_add(&bar[XB_XCNT(b.x)], 1u);
    return b;
}
__device__ __forceinline__ void xcd_barrier_complete(unsigned* bar, unsigned x, unsigned& nloc, unsigned& nx) {
    const unsigned G = gridDim.x * gridDim.y * gridDim.z;
    unsigned sum, cnt, mine, sp = 0u;
    for (;;) {
        sum = 0u; cnt = 0u; mine = 0u;
#pragma unroll
        for (unsigned j = 0; j < 16; ++j) { const unsigned c = xb_ld(&bar[XB_XCNT(j)]); sum += c; cnt += (c > 0u) ? 1u : 0u; mine = (j == x) ? c : mine; }
        if (sum == G) break;
        __builtin_amdgcn_s_sleep(1);
        if ((++sp & 255u) == 0u) { if (xb_ld(&bar[XB_TMO])) break; if (sp > XB_SPIN_CAP) { atomicAdd(&bar[XB_TMO], 1u); break; } }
    }
    nloc = mine > 0u ? mine : 1u; nx = cnt > 0u ? cnt : 1u;
}

__device__ __forceinline__ void xcd_barrier(const XcdBarrier& b) {
    asm volatile("s_waitcnt vmcnt(0)" ::: "memory");
    __syncthreads();
    if (threadIdx.x == 0) {
        unsigned* bar = b.bar;
        __builtin_amdgcn_s_waitcnt(0);
        unsigned nloc = b.st[0], nx = b.st[1];
        if (nloc == 0u) { xcd_barrier_complete(bar, b.x, nloc, nx); b.st[0] = nloc; b.st[1] = nx; }
        const unsigned old = xb_add(&bar[XB_XSUB(b.x)], 1u);
        const unsigned gen = old / nloc;
        if (old + 1u == (gen + 1u) * nloc) {
            __builtin_amdgcn_fence(__ATOMIC_RELEASE, "agent");
            asm volatile("s_waitcnt vmcnt(0)" ::: "memory");
            const unsigned og = xb_add(&bar[XB_TOP], 1u);
            const unsigned tg = og / nx;
            if (og + 1u == (tg + 1u) * nx) xb_add(&bar[XB_TOPGEN], 1u);
            else XB_SPIN(xb_ld(&bar[XB_TOPGEN]) == tg, bar);
            __builtin_amdgcn_fence(__ATOMIC_ACQUIRE, "agent");
            xb_add(&bar[XB_XGEN(b.x)], 1u);
            asm volatile("s_waitcnt vmcnt(0)" ::: "memory");
        } else {
            XB_SPIN(xb_ld(&bar[XB_XGEN(b.x)]) == gen, bar);
            __builtin_amdgcn_fence(__ATOMIC_ACQUIRE, "agent");
            asm volatile("s_waitcnt vmcnt(0)" ::: "memory");
        }
    }
    __syncthreads();
}

constexpr int NWAVES = 8;
constexpr int BATCH = 8, SEQ = 4096, D = 1024, T = BATCH * SEQ, DEPTH = 2;
constexpr int DCONV = 512, NHEAD = 8, HD = 64, DATTN = 512, DFF = 2816, NEXP = 8, DFFE = 2048;
constexpr int NIN = 5120, NPA = 1536, NQK = 1024, NGT = 2048, NPROJ = NPA + NQK + NGT;
constexpr float EPS = 1e-6f;
constexpr float QSCALE = 0.125f * 1.4426950408889634f;
constexpr int MPAD = 2 * T + NEXP * 256;
constexpr int VTP = T + 64;

constexpr size_t MiB = 1u << 20;
constexpr size_t WS_CTL = 0, CTL_ZERO_BYTES = 1 * MiB;
constexpr size_t WS_ROUTE = 1 * MiB;
constexpr size_t WS_SLOTS = WS_ROUTE + 512 * 1024, WS_WGCNT = WS_ROUTE + 768 * 1024;
constexpr size_t WS_WL = 4 * MiB, WL_STRIDE = 14 * MiB;
constexpr size_t WL_WIN = 0, WL_WV = 9 * MiB, WL_WA = 10 * MiB, WL_WB = 11 * MiB, WL_WO = 12 * MiB;
constexpr size_t WS_WGU = 32 * MiB, WS_WD = 43 * MiB;
constexpr size_t WS_H = 50 * MiB;
constexpr size_t WS_UA = WS_H, WS_UB = WS_H + 32 * MiB;
constexpr size_t WS_VT = 114 * MiB;
constexpr size_t WS_GT = 146 * MiB;
constexpr size_t WS_PA = 274 * MiB;
constexpr size_t WS_QF = WS_PA + 96 * MiB, WS_KF = WS_PA + 128 * MiB;
constexpr size_t WS_TMP = 274 * MiB, WS_MIX = 338 * MiB;
constexpr size_t WS_G0 = 146 * MiB;
constexpr size_t WS_WEG = 4 * MiB, WS_WED = 36 * MiB;
constexpr size_t WS_HP = 52 * MiB;
constexpr size_t WS_G1 = 118 * MiB;
constexpr size_t WS_Y = 250 * MiB;
constexpr float WSCALE = 32.f, GSCALE = 8.f;
constexpr size_t WS_END = 512 * MiB;
static_assert(WS_G1 + (size_t)MPAD * DFFE <= WS_Y && WS_HP + (size_t)MPAD * D <= WS_G1 && WS_Y + (size_t)MPAD * D * 2 <= WS_END && WS_KF + 32 * MiB <= WS_END, "d_ws map");
constexpr int CW_TMO = 0, CW_CODE = 1, CW_BAR = 4096, CW_CNT = 8192;

constexpr int RING_OFF = 0, RING_BYTES = 131072, LDSCTL_OFF = RING_BYTES, MISC_OFF = LDSCTL_OFF + 320, LDS_BYTES = 147456;

typedef unsigned u32x2v __attribute__((ext_vector_type(2)));
__device__ __forceinline__ float wave_sum(float v) {
#pragma unroll
    for (int o = 1; o < 64; o <<= 1) v += __shfl_xor(v, o);
    return v;
}
using pg8::cvt_pk_bf16;
__device__ __forceinline__ void tr_block(const float* W, int K, int N, bf16* dst, int drow, int k0, int n0, LAS float* scr, int lane) {
#pragma unroll 8
    for (int i = 0; i < 32; ++i) { const int kk = 2 * i + (lane >> 5); scr[kk * 33 + (lane & 31)] = W[(size_t)(k0 + kk) * N + n0 + (lane & 31)]; }
    LDS_WAIT(); asm volatile("" ::: "memory");
    const int c = lane & 7;
#pragma unroll
    for (int j = 0; j < 4; ++j) { const int n = (lane >> 3) + 8 * j; const LAS float* s = scr + (8 * c) * 33 + n;
        v4u o; o.x = cvt_pk_bf16(s[0 * 33], s[1 * 33]); o.y = cvt_pk_bf16(s[2 * 33], s[3 * 33]); o.z = cvt_pk_bf16(s[4 * 33], s[5 * 33]); o.w = cvt_pk_bf16(s[6 * 33], s[7 * 33]);
        *(GAS v4u*)(dst + (size_t)(drow + n) * K + k0 + 8 * c) = o; }
    LDS_WAIT(); asm volatile("" ::: "memory");
}
__device__ __forceinline__ void tr_block8(const float* W, int K, int N, unsigned char* dst, int drow, int k0, int n0, float sc, LAS float* scr, int lane) {
#pragma unroll 8
    for (int i = 0; i < 32; ++i) { const int kk = 2 * i + (lane >> 5); scr[kk * 33 + (lane & 31)] = W[(size_t)(k0 + kk) * N + n0 + (lane & 31)]; }
    LDS_WAIT(); asm volatile("" ::: "memory");
    const int c = lane & 7;
#pragma unroll
    for (int j = 0; j < 4; ++j) { const int n = (lane >> 3) + 8 * j; const LAS float* s = scr + (8 * c) * 33 + n;
        u32x2v o; o.x = pg8::pk4_fp8(s[0 * 33] * sc, s[1 * 33] * sc, s[2 * 33] * sc, s[3 * 33] * sc); o.y = pg8::pk4_fp8(s[4 * 33] * sc, s[5 * 33] * sc, s[6 * 33] * sc, s[7 * 33] * sc);
        *(GAS u32x2v*)(dst + (size_t)(drow + n) * K + k0 + 8 * c) = o; }
    LDS_WAIT(); asm volatile("" ::: "memory");
}
template <int KIND> __device__ __forceinline__ void tr_item8(const float* W, int K, int N, unsigned char* dst, float sc, LAS float* scr, int item, int lane) {
    const int nblk = N / 32, kb = item / nblk, nb = item % nblk, k0 = 64 * kb, n0 = 32 * nb;
    int drow = n0;
    if (KIND == 2) drow = 256 * (n0 / 128) + (n0 % 128);
    if (KIND == 3) drow = 256 * (n0 / 128) + 128 + (n0 % 128);
    tr_block8(W, K, N, dst, drow, k0, n0, sc, scr, lane);
}
template <int KIND> __device__ __forceinline__ void tr_item(const float* W, int K, int N, bf16* dst, bf16* dst2, LAS float* scr, int item, int lane) {
    const int nblk = N / 32, kb = item / nblk, nb = item % nblk, k0 = 64 * kb, n0 = 32 * nb;
    bf16* d = dst; int drow = n0;
    if (KIND == 1) { if (n0 >= 3072) drow = n0 - 512; else if (n0 >= 2560) { d = dst2; drow = n0 - 2560; } }
    if (KIND == 2) drow = 256 * (n0 / 128) + (n0 % 128);
    if (KIND == 3) drow = 256 * (n0 / 128) + 128 + (n0 % 128);
    tr_block(W, K, N, d, drow, k0, n0, scr, lane);
}
__device__ __forceinline__ void rms_row_to_bf16(const float* xrow, const float* g, bf16* orow, int lane) {
    const GAS f32x4* xr = (const GAS f32x4*)xrow + lane; const GAS f32x4* gr = (const GAS f32x4*)g + lane;
    f32x4 v[4]; float s = 0.f;
#pragma unroll
    for (int j = 0; j < 4; ++j) { v[j] = xr[64 * j]; s += (v[j].x * v[j].x + v[j].y * v[j].y) + (v[j].z * v[j].z + v[j].w * v[j].w); }
    const float rstd = 1.0f / sqrtf(wave_sum(s) * (1.f / D) + EPS);
    GAS u32x2v* o8 = (GAS u32x2v*)orow + lane;
#pragma unroll
    for (int j = 0; j < 4; ++j) { const f32x4 gg = gr[64 * j]; u32x2v w; w.x = cvt_pk_bf16(v[j].x * rstd * gg.x, v[j].y * rstd * gg.y); w.y = cvt_pk_bf16(v[j].z * rstd * gg.z, v[j].w * rstd * gg.w); o8[64 * j] = w; }
}
__device__ __forceinline__ void unpack8f(const v4u w, float (&f)[8]) {
    f[0] = __builtin_bit_cast(float, w.x << 16); f[1] = __builtin_bit_cast(float, w.x & 0xffff0000u); f[2] = __builtin_bit_cast(float, w.y << 16); f[3] = __builtin_bit_cast(float, w.y & 0xffff0000u);
    f[4] = __builtin_bit_cast(float, w.z << 16); f[5] = __builtin_bit_cast(float, w.z & 0xffff0000u); f[6] = __builtin_bit_cast(float, w.w << 16); f[7] = __builtin_bit_cast(float, w.w & 0xffff0000u);
}
__device__ __forceinline__ v4u pack8f(const float (&f)[8]) { v4u w; w.x = cvt_pk_bf16(f[0], f[1]); w.y = cvt_pk_bf16(f[2], f[3]); w.z = cvt_pk_bf16(f[4], f[5]); w.w = cvt_pk_bf16(f[6], f[7]); return w; }

__device__ __forceinline__ void conv_phase(const bf16* PA, const float* cw, bf16* UA, int gid, int nthr) {
    for (int it = gid; it < (T / 16) * 64; it += nthr) {
        const int cg = it & 63, t0 = (it >> 6) * 16, c0 = cg * 8;
        float w0[8], w1[8], w2[8];
#pragma unroll
        for (int i = 0; i < 8; ++i) { w0[i] = cw[c0 + i]; w1[i] = cw[DCONV + c0 + i]; w2[i] = cw[2 * DCONV + c0 + i]; }
        float um2[8], um1[8];
        if ((t0 & (SEQ - 1)) == 0) {
#pragma unroll
            for (int i = 0; i < 8; ++i) { um2[i] = 0.f; um1[i] = 0.f; }
        } else {
            float a[8], b[8];
            unpack8f(*(const GAS v4u*)(PA + (size_t)(t0 - 2) * NPA + c0), a); unpack8f(*(const GAS v4u*)(PA + (size_t)(t0 - 2) * NPA + 1024 + c0), b);
#pragma unroll
            for (int i = 0; i < 8; ++i) um2[i] = a[i] * b[i];
            unpack8f(*(const GAS v4u*)(PA + (size_t)(t0 - 1) * NPA + c0), a); unpack8f(*(const GAS v4u*)(PA + (size_t)(t0 - 1) * NPA + 1024 + c0), b);
#pragma unroll
            for (int i = 0; i < 8; ++i) um1[i] = a[i] * b[i];
        }
#pragma unroll 4
        for (int r = 0; r < 16; ++r) {
            const bf16* row = PA + (size_t)(t0 + r) * NPA + c0;
            float xin[8], bg[8], cgv[8], o[8];
            unpack8f(*(const GAS v4u*)(row), xin); unpack8f(*(const GAS v4u*)(row + 512), bg); unpack8f(*(const GAS v4u*)(row + 1024), cgv);
#pragma unroll
            for (int i = 0; i < 8; ++i) { const float u = cgv[i] * xin[i]; o[i] = bg[i] * (w0[i] * um2[i] + w1[i] * um1[i] + w2[i] * u); um2[i] = um1[i]; um1[i] = u; }
            *(GAS v4u*)(UA + (size_t)(t0 + r) * DCONV + c0) = pack8f(o);
        }
    }
}

typedef float f32x16 __attribute__((ext_vector_type(16)));
__device__ __forceinline__ void attn_mfma(const bf16* QF, const bf16* KF, const bf16* VF, bf16* UB, int gw, int NGW, int lane) {
    const int q = lane & 31, hh = lane >> 5;
    constexpr int NU = BATCH * NHEAD * (SEQ / 32);
    bf16x8 qf[4], kf[4], vf[4];
    if (gw < NU) {
        const size_t o = (size_t)gw * 2048 + lane * 8;
#pragma unroll
        for (int i = 0; i < 4; ++i) { qf[i] = *(const GAS bf16x8*)(QF + o + i * 512); kf[i] = *(const GAS bf16x8*)(KF + o + i * 512); vf[i] = *(const GAS bf16x8*)(VF + o + i * 512); }
    }
#pragma unroll 1
    for (int u = gw; u < NU; u += NGW) {
        const int qb = u & 127, bh = u >> 7, h = bh & 7, b = bh >> 3;
        const size_t rowb = (size_t)b * SEQ;
        bf16x8 qN[4], kN[4], vN[4];
        {
            const int un = (u + NGW < NU) ? u + NGW : u; const size_t o = (size_t)un * 2048 + lane * 8;
#pragma unroll
            for (int i = 0; i < 4; ++i) { qN[i] = *(const GAS bf16x8*)(QF + o + i * 512); kN[i] = *(const GAS bf16x8*)(KF + o + i * 512); vN[i] = *(const GAS bf16x8*)(VF + o + i * 512); }
        }
        __builtin_amdgcn_sched_barrier(0);
        const bf16* const kbase = KF + (size_t)(bh * 128) * 2048 + lane * 8;
        const bf16* const vbase = VF + (size_t)(bh * 128) * 2048 + lane * 8;
        f32x16 o0, o1;
#pragma unroll
        for (int r = 0; r < 16; ++r) { o0[r] = 0.f; o1[r] = 0.f; }
        float R = 1.f;
        bf16x8 kn[4], vn[4];
        const bf16x8 (&qfr)[4] = qf;
        auto block = [&](const bf16x8 (&KF)[4], const bf16x8 (&VF)[4], bf16x8 (&KN)[4], bf16x8 (&VN)[4], const int kb) __attribute__((always_inline)) -> bool {
            {
                const int kbn = kb > 0 ? kb - 1 : 0;
                const bf16* kp = kbase + (size_t)kbn * 2048; const bf16* vp = vbase + (size_t)kbn * 2048;
#pragma unroll
                for (int i = 0; i < 4; ++i) { KN[i] = *(const GAS bf16x8*)(kp + i * 512); VN[i] = *(const GAS bf16x8*)(vp + i * 512); }
            }
            __builtin_amdgcn_sched_barrier(0);
            f32x16 p;
#pragma unroll
            for (int r = 0; r < 16; ++r) p[r] = 0.f;
#pragma unroll
            for (int d0 = 0; d0 < 4; ++d0) p = __builtin_amdgcn_mfma_f32_32x32x16_bf16(KF[d0], qfr[d0], p, 0, 0, 0);
            float rr[16];
            const bool diag = (kb == qb);
#pragma unroll
            for (int r = 0; r < 16; ++r) {
                float e = __builtin_amdgcn_exp2f(p[r]);
                if (diag) { const int kl = (r & 7) + 8 * hh + 16 * (r >> 3); e = (kl < q) ? e : 0.f; }
                rr[r] = __builtin_amdgcn_rcpf(1.0f + e);
            }
            bf16x8 af[2];
#pragma unroll
            for (int s = 1; s >= 0; --s) {
                float g = rr[8 * s];
#pragma unroll
                for (int j = 1; j < 8; ++j) g *= rr[8 * s + j];
                const auto sw = __builtin_amdgcn_permlane32_swap(__float_as_uint(g), __float_as_uint(g), false, false);
                const float g_lo = __uint_as_float(sw[0]), g_hi = __uint_as_float(sw[1]);
                float c = hh ? R : R * g_hi;
                float a[8];
#pragma unroll
                for (int j = 7; j >= 0; --j) { const float cn = c * rr[8 * s + j]; a[j] = c - cn; c = cn; }
                R = R * (g_lo * g_hi);
                typedef unsigned u4 __attribute__((ext_vector_type(4)));
                u4 w; w.x = cvt_pk_bf16(a[0], a[1]); w.y = cvt_pk_bf16(a[2], a[3]); w.z = cvt_pk_bf16(a[4], a[5]); w.w = cvt_pk_bf16(a[6], a[7]);
                af[s] = __builtin_bit_cast(bf16x8, w);
            }
            o0 = __builtin_amdgcn_mfma_f32_32x32x16_bf16(VF[0], af[0], o0, 0, 0, 0);
            o0 = __builtin_amdgcn_mfma_f32_32x32x16_bf16(VF[1], af[1], o0, 0, 0, 0);
            o1 = __builtin_amdgcn_mfma_f32_32x32x16_bf16(VF[2], af[0], o1, 0, 0, 0);
            o1 = __builtin_amdgcn_mfma_f32_32x32x16_bf16(VF[3], af[1], o1, 0, 0, 0);
            return kb == 0 || __builtin_amdgcn_ballot_w64(R != 0.f) == 0ull;
        };
#pragma unroll 1
        for (int kb = qb;; kb -= 2) {
            if (block(kf, vf, kn, vn, kb)) break;
            if (block(kn, vn, kf, vf, kb - 1)) break;
        }
        bf16* op = UB + (rowb + 32 * qb + q) * DATTN + h * 64 + 4 * hh;
#pragma unroll
        for (int g4 = 0; g4 < 4; ++g4) {
            u32x2v w0, w1;
            w0.x = cvt_pk_bf16(o0[4 * g4], o0[4 * g4 + 1]); w0.y = cvt_pk_bf16(o0[4 * g4 + 2], o0[4 * g4 + 3]);
            w1.x = cvt_pk_bf16(o1[4 * g4], o1[4 * g4 + 1]); w1.y = cvt_pk_bf16(o1[4 * g4 + 2], o1[4 * g4 + 3]);
            *(GAS u32x2v*)(op + 8 * g4) = w0; *(GAS u32x2v*)(op + 32 + 8 * g4) = w1;
        }
#pragma unroll
        for (int i = 0; i < 4; ++i) { qf[i] = qN[i]; kf[i] = kN[i]; vf[i] = vN[i]; }
    }
}

#ifndef REP_P0
#define REP_P0 1
#endif
#ifndef REP_P1
#define REP_P1 1
#endif
#ifndef REP_P2
#define REP_P2 1
#endif
#ifndef REP_ATT
#define REP_ATT 1
#endif
#ifndef REP_R1A
#define REP_R1A 1
#endif
struct Args { const float* in[16]; float* out; unsigned char* ws; };
typedef const __attribute__((address_space(4))) Args* KArgP;
__device__ __forceinline__ KArgP launder_k(KArgP p) { asm volatile("" : "+s"(p)); return p; }
__device__ __forceinline__ int launder_s(int v) { asm volatile("" : "+s"(v)); return v; }
__device__ __forceinline__ int launder_v(int v) { asm volatile("" : "+v"(v)); return v; }
#ifndef STG_TICKS
#define STG_TICKS 150
#endif
__device__ __forceinline__ void stagger(int bx) { const unsigned long long t0 = __builtin_amdgcn_s_memrealtime(); const unsigned long long want = (unsigned long long)(((bx >> 3) & 3) * STG_TICKS); while (__builtin_amdgcn_s_memrealtime() - t0 < want) __builtin_amdgcn_s_sleep(2); }
#define PH_BEGIN { const KArgP ap = launder_k(kp0); unsigned char* const ws = ap->ws; const int bx = launder_s(bx0), G = launder_s(G0); const int tid = launder_v(tid0), lane = tid & 63, wave = __builtin_amdgcn_readfirstlane(tid >> 6); \
    const int gid = bx * (NWAVES * 64) + tid, nthr = G * NWAVES * 64, gw = bx * NWAVES + wave, NGW = G * NWAVES; (void)gid; (void)nthr; (void)gw; (void)NGW; (void)lane; \
    LAS float* const scr = (LAS float*)(lds + RING_OFF + wave * 16384); (void)scr; (void)ws;
#define PH_END(BARRIER) if (BARRIER) xcd_barrier(bar); }
#define WSP(T_, off) ((T_*)(ws + (off)))

__global__ void __launch_bounds__(NWAVES * 64, 2) mega_fwd(Args args) {
    extern __shared__ __attribute__((aligned(16))) unsigned char lds_raw[];
    LAS unsigned char* const lds = (LAS unsigned char*)lds_raw;
    volatile LAS unsigned* const MISC = (volatile LAS unsigned*)(lds + MISC_OFF);
    const KArgP kp0 = (KArgP)__builtin_amdgcn_kernarg_segment_ptr();
    const int tid0 = threadIdx.x, G0 = gridDim.x, bx0 = blockIdx.x;
    for (int u = tid0; u < (LDS_BYTES - LDSCTL_OFF) / 4; u += NWAVES * 64) ((LAS unsigned*)(lds + LDSCTL_OFF))[u] = 0u;
    __syncthreads();
#ifdef PROBE_CLK
    long long probe_cycles = 0;
#endif
    XcdBarrier bar = xcd_barrier_post((unsigned*)(args.ws + WS_CTL) + CW_BAR, MISC + 8);

#pragma unroll 1
    for (int rep = 0; rep < REP_P0; ++rep)
    PH_BEGIN
        constexpr int I_IN = 16 * 160, I_BR = 8 * 32, I_O = 16 * 32, I_GU = 16 * 88, I_D = 44 * 32;
        constexpr int PER_L = I_IN + 2 * I_BR + I_O, NITEMS = 2 * PER_L + 2 * I_GU + I_D;
#pragma unroll 1
        for (int it = gw; it < NITEMS; it += NGW) {
            int r = it;
            if (r < 2 * PER_L) {
                const int l = r / PER_L; r -= l * PER_L; unsigned char* wl = ws + WS_WL + (size_t)l * WL_STRIDE;
                if (r < I_IN) { tr_item<1>(ap->in[2] + (size_t)l * D * NIN, D, NIN, (bf16*)(wl + WL_WIN), (bf16*)(wl + WL_WV), scr, r, lane); continue; } r -= I_IN;
                if (r < I_BR) { tr_item<0>(ap->in[4] + (size_t)l * DCONV * D, DCONV, D, (bf16*)(wl + WL_WA), nullptr, scr, r, lane); continue; } r -= I_BR;
                if (r < I_BR) { tr_item<0>(ap->in[5] + (size_t)l * DATTN * D, DATTN, D, (bf16*)(wl + WL_WB), nullptr, scr, r, lane); continue; } r -= I_BR;
                tr_item<0>(ap->in[6] + (size_t)l * D * D, D, D, (bf16*)(wl + WL_WO), nullptr, scr, r, lane); continue;
            }
            r -= 2 * PER_L;
            if (r < I_GU) { tr_item<2>(ap->in[8], D, DFF, WSP(bf16, WS_WGU), nullptr, scr, r, lane); continue; } r -= I_GU;
            if (r < I_GU) { tr_item<3>(ap->in[9], D, DFF, WSP(bf16, WS_WGU), nullptr, scr, r, lane); continue; } r -= I_GU;
            tr_item<0>(ap->in[10], DFF, D, WSP(bf16, WS_WD), nullptr, scr, r, lane);
        }
#pragma unroll 1
        for (int m = gw; m < T; m += NGW) rms_row_to_bf16(ap->in[0] + (size_t)m * D, ap->in[1], WSP(bf16, WS_H) + (size_t)m * D, lane);
    PH_END(true)

#pragma unroll 1
    for (int l = 0; l < DEPTH; ++l) {
#pragma unroll 1
        for (int rep = 0; rep < REP_P1; ++rep) {
        PH_BEGIN
            unsigned char* wl = ws + WS_WL + (size_t)l * WL_STRIDE;
            pg8::Gemm g{WSP(bf16, WS_H), (const bf16*)(wl + WL_WIN), T, NPROJ, D}; pg8::StaticOrder S; S.init(T, NPROJ, G, bx);
#ifdef PROBE_NULL
            if (rep == 0) { pg8::EpiNull E0; pg8::gemm_phase<pg8::EpiNull, pg8::StaticOrder, true, true>(lds + RING_OFF, g, S, E0, tid); } else
#endif
#ifdef PROBE_L2
            if (rep == 0) { pg8::EpiL2 E0{WSP(bf16, 440 * MiB), bx}; pg8::gemm_phase<pg8::EpiL2, pg8::StaticOrder, true, true>(lds + RING_OFF, g, S, E0, tid); } else
#endif
            {
#ifdef PROBE_CLK
            long long c0_ = clock64();
#endif
            pg8::EpiProj E{WSP(bf16, WS_PA), WSP(bf16, WS_QF), WSP(bf16, WS_KF), WSP(bf16, WS_GT), QSCALE};
            pg8::gemm_phase<pg8::EpiProj, pg8::StaticOrder, true, true>(lds + RING_OFF, g, S, E, tid);
#ifdef PROBE_CLK
            if (l == 0) probe_cycles = clock64() - c0_;
#endif
            }
        PH_END(false)
        PH_BEGIN
            unsigned char* wl = ws + WS_WL + (size_t)l * WL_STRIDE;
            pg8::Gemm g{(const bf16*)(wl + WL_WV), WSP(bf16, WS_H), DATTN, T, D}; pg8::StaticOrder S; S.init(DATTN, T, G, bx);
#ifdef PROBE_NULL
            if (rep == 0) { pg8::EpiNull E0; pg8::gemm_phase<pg8::EpiNull, pg8::StaticOrder, true, true>(lds + RING_OFF, g, S, E0, tid); } else
#endif
#ifdef PROBE_L2
            if (rep == 0) { pg8::EpiL2 E0{WSP(bf16, 440 * MiB), bx}; pg8::gemm_phase<pg8::EpiL2, pg8::StaticOrder, true, true>(lds + RING_OFF, g, S, E0, tid); } else
#endif
            { pg8::EpiVT E{WSP(bf16, WS_VT)};
            pg8::gemm_phase<pg8::EpiVT, pg8::StaticOrder, true, true>(lds + RING_OFF, g, S, E, tid); }
        PH_END(true)
        }
#pragma unroll 1
        for (int rep = 0; rep < REP_P2; ++rep) {
        PH_BEGIN
            conv_phase(WSP(bf16, WS_PA), ap->in[3] + (size_t)l * 3 * DCONV, WSP(bf16, WS_UA), gid, nthr);
        PH_END(false)
#pragma unroll 1
        for (int rep2 = 0; rep2 < REP_ATT; ++rep2) {
        PH_BEGIN
            attn_mfma(WSP(bf16, WS_QF), WSP(bf16, WS_KF), WSP(bf16, WS_VT), WSP(bf16, WS_UB), gw, NGW, lane);
        PH_END(rep2 == REP_ATT - 1)
        }
        }
        PH_BEGIN
            unsigned char* wl = ws + WS_WL + (size_t)l * WL_STRIDE;
            pg8::Gemm g{WSP(bf16, WS_UA), (const bf16*)(wl + WL_WA), T, D, DCONV}; pg8::StaticOrder S; S.init(T, D, G, bx);
            pg8::EpiGateA E{WSP(bf16, WS_GT), WSP(bf16, WS_TMP)};
            pg8::gemm_phase<pg8::EpiGateA, pg8::StaticOrder, true, true>(lds + RING_OFF, g, S, E, tid);
        PH_END(false)
        PH_BEGIN
            unsigned char* wl = ws + WS_WL + (size_t)l * WL_STRIDE;
            pg8::Gemm g{WSP(bf16, WS_UB), (const bf16*)(wl + WL_WB), T, D, DATTN}; pg8::StaticOrder S; S.init(T, D, G, bx);
            pg8::EpiGateB E{WSP(bf16, WS_GT), WSP(bf16, WS_TMP), WSP(bf16, WS_MIX)};
            pg8::gemm_phase<pg8::EpiGateB, pg8::StaticOrder, true, true>(lds + RING_OFF, g, S, E, tid);
        PH_END(true)
        PH_BEGIN
            unsigned char* wl = ws + WS_WL + (size_t)l * WL_STRIDE;
            pg8::Gemm g{WSP(bf16, WS_MIX), (const bf16*)(wl + WL_WO), T, D, D}; pg8::StaticOrder S; S.init(T, D, G, bx);
            pg8::EpiRes E{l == 0 ? ap->in[0] : (const float*)ap->out, ap->out, D};
            pg8::gemm_phase<pg8::EpiRes, pg8::StaticOrder, true, true>(lds + RING_OFF, g, S, E, tid);
        PH_END(true)
        if (l == 0) {
            PH_BEGIN
#pragma unroll 1
                for (int m = gw; m < T; m += NGW) rms_row_to_bf16(ap->out + (size_t)m * D, ap->in[7], WSP(bf16, WS_H) + (size_t)m * D, lane);
            PH_END(true)
            PH_BEGIN
                pg8::Gemm g{WSP(bf16, WS_H), WSP(bf16, WS_WGU), T, 2 * DFF, D}; pg8::StaticOrder S; S.init(T, 2 * DFF, G, bx);
                pg8::EpiSwiGLU E{WSP(bf16, WS_G0), DFF};
                pg8::gemm_phase<pg8::EpiSwiGLU, pg8::StaticOrder, true, true>(lds + RING_OFF, g, S, E, tid);
            PH_END(true)
            PH_BEGIN
                pg8::Gemm g{WSP(bf16, WS_G0), WSP(bf16, WS_WD), T, D, DFF}; pg8::StaticOrder S; S.init(T, D, G, bx);
#ifdef PROBE_P7NULL
                { pg8::EpiNull E0; pg8::gemm_phase<pg8::EpiNull, pg8::StaticOrder, true, true>(lds + RING_OFF, g, S, E0, tid); }
#endif
                pg8::EpiRes E{ap->out, ap->out, D};
                pg8::gemm_phase<pg8::EpiRes, pg8::StaticOrder, true, true>(lds + RING_OFF, g, S, E, tid);
            PH_END(true)
            PH_BEGIN
#pragma unroll 1
                for (int m = gw; m < T; m += NGW) rms_row_to_bf16(ap->out + (size_t)m * D, ap->in[1] + D, WSP(bf16, WS_H) + (size_t)m * D, lane);
            PH_END(true)
        } else {
            volatile LAS int* const lcnt = (volatile LAS int*)(MISC + 32);
            volatile LAS unsigned* const loff = MISC + 16;
            volatile LAS int* const lbase = (volatile LAS int*)(MISC + 48);
#pragma unroll 1
            for (int rep = 0; rep < REP_R1A; ++rep)
            PH_BEGIN
                constexpr int I_E = 16 * 64;
#pragma unroll 1
                for (int it = gw; it < NEXP * 3 * I_E; it += NGW) {
                    const int e = it / (3 * I_E); int r = it - e * 3 * I_E;
                    if (r < I_E) { tr_item8<2>(ap->in[12] + (size_t)e * D * DFFE, D, DFFE, WSP(unsigned char, WS_WEG) + (size_t)e * 2 * DFFE * D, WSCALE, scr, r, lane); continue; } r -= I_E;
                    if (r < I_E) { tr_item8<3>(ap->in[13] + (size_t)e * D * DFFE, D, DFFE, WSP(unsigned char, WS_WEG) + (size_t)e * 2 * DFFE * D, WSCALE, scr, r, lane); continue; } r -= I_E;
                    tr_item8<0>(ap->in[14] + (size_t)e * DFFE * D, DFFE, D, WSP(unsigned char, WS_WED) + (size_t)e * D * DFFE, WSCALE, scr, r, lane);
                }
            PH_END(false)
            PH_BEGIN
                int4* route = WSP(int4, WS_ROUTE); int* wgcnt = WSP(int, WS_WGCNT); gu32* ctl = (gu32*)(ws + WS_CTL);
                const int rpw = T / G, r0 = bx * rpw, r1 = r0 + rpw;
                const float* xres = ap->out; const float* gf = ap->in[7] + D; const float* w_router = ap->in[11];
                if (tid < 8) lcnt[tid] = 0;
                __syncthreads();
#pragma unroll 1
                for (int m = r0 + wave; m < r1; m += NWAVES) {
                    const GAS f32x4* xr = (const GAS f32x4*)(xres + (size_t)m * D) + lane; const GAS f32x4* gr = (const GAS f32x4*)gf + lane;
                    f32x4 v[4]; float s = 0.f;
#pragma unroll
                    for (int j = 0; j < 4; ++j) { v[j] = xr[64 * j]; s += (v[j].x * v[j].x + v[j].y * v[j].y) + (v[j].z * v[j].z + v[j].w * v[j].w); }
                    const float rstd = 1.0f / sqrtf(wave_sum(s) * (1.f / D) + EPS);
                    float lg[8];
#pragma unroll
                    for (int e = 0; e < 8; ++e) lg[e] = 0.f;
#pragma unroll
                    for (int j = 0; j < 4; ++j) { const f32x4 gg = gr[64 * j];
#pragma unroll
                        for (int c = 0; c < 4; ++c) { const float hn = v[j][c] * rstd * gg[c]; const int i = 256 * j + 4 * lane + c;
                            const f32x4 wa = *(const GAS f32x4*)(w_router + (size_t)i * 8), wb = *(const GAS f32x4*)(w_router + (size_t)i * 8 + 4);
                            lg[0] += hn * wa.x; lg[1] += hn * wa.y; lg[2] += hn * wa.z; lg[3] += hn * wa.w; lg[4] += hn * wb.x; lg[5] += hn * wb.y; lg[6] += hn * wb.z; lg[7] += hn * wb.w; } }
#pragma unroll
                    for (int e = 0; e < 8; ++e) lg[e] = wave_sum(lg[e]);
                    int e1 = 0; float v1 = lg[0];
#pragma unroll
                    for (int e = 1; e < 8; ++e) if (lg[e] > v1) { v1 = lg[e]; e1 = e; }
                    int e2 = -1; float v2 = -INFINITY;
#pragma unroll
                    for (int e = 0; e < 8; ++e) if (e != e1 && lg[e] > v2) { v2 = lg[e]; e2 = e; }
                    if (e2 < 0) e2 = (e1 + 1) & 7;
                    const float ex = __expf(v2 - v1), w1 = 1.0f / (1.0f + ex), w2 = ex * w1;
                    if (lane == 0) { route[m] = make_int4(e1, e2, __float_as_int(w1), __float_as_int(w2)); atomicAdd((int*)(lcnt + e1), 1); atomicAdd((int*)(lcnt + e2), 1); }
                }
                __syncthreads();
                if (tid < 8) { const int c = lcnt[tid]; wgcnt[bx * 8 + tid] = c; __hip_atomic_fetch_add((unsigned*)(ctl + CW_CNT + tid), (unsigned)c, RLX_AGENT); }
            PH_END(true)
            PH_BEGIN
                int4* route = WSP(int4, WS_ROUTE); int2* slots = WSP(int2, WS_SLOTS); int* wgcnt = WSP(int, WS_WGCNT); gu32* ctl = (gu32*)(ws + WS_CTL); unsigned char* HP = WSP(unsigned char, WS_HP);
                const int rpw = T / G, r0 = bx * rpw, r1 = r0 + rpw;
                const float* xres = ap->out; const float* gf = ap->in[7] + D;
                { int s = 0; for (int w = lane; w < bx; w += 64) s += wgcnt[w * 8 + wave]; s = (int)wave_sum((float)s);
                  if (lane == 0) { lbase[wave] = s; lcnt[wave] = 0; } }
                if (tid == 0) { unsigned off = 0; for (int e = 0; e < 8; ++e) { loff[e] = off; off += (__hip_atomic_load((unsigned*)(ctl + CW_CNT + e), RLX_AGENT) + 255u) & ~255u; } loff[8] = off; }
                __syncthreads();
#pragma unroll 1
                for (int m = r0 + wave; m < r1; m += NWAVES) {
                    int s1 = 0, s2 = 0;
                    if (lane == 0) { const int4 rt = route[m]; s1 = (int)loff[rt.x] + lbase[rt.x] + atomicAdd((int*)(lcnt + rt.x), 1); s2 = (int)loff[rt.y] + lbase[rt.y] + atomicAdd((int*)(lcnt + rt.y), 1); slots[m] = make_int2(s1, s2); }
                    s1 = __builtin_amdgcn_readfirstlane(s1); s2 = __builtin_amdgcn_readfirstlane(s2);
                    const GAS f32x4* xr = (const GAS f32x4*)(xres + (size_t)m * D) + lane; const GAS f32x4* gr = (const GAS f32x4*)gf + lane;
                    f32x4 v[4]; float s = 0.f;
#pragma unroll
                    for (int j = 0; j < 4; ++j) { v[j] = xr[64 * j]; s += (v[j].x * v[j].x + v[j].y * v[j].y) + (v[j].z * v[j].z + v[j].w * v[j].w); }
                    const float rstd = 1.0f / sqrtf(wave_sum(s) * (1.f / D) + EPS);
                    GAS unsigned* o1 = (GAS unsigned*)(HP + (size_t)s1 * D) + lane; GAS unsigned* o2 = (GAS unsigned*)(HP + (size_t)s2 * D) + lane;
#pragma unroll
                    for (int j = 0; j < 4; ++j) { const f32x4 gg = gr[64 * j]; const unsigned w = pg8::pk4_fp8(v[j].x * rstd * gg.x, v[j].y * rstd * gg.y, v[j].z * rstd * gg.z, v[j].w * rstd * gg.w); o1[64 * j] = w; o2[64 * j] = w; }
                }
            PH_END(true)
            PH_BEGIN
                const int mrows = (int)loff[8];
                pg8::Gemm g{WSP(bf16, WS_HP), WSP(bf16, WS_WEG), mrows, 2 * DFFE, D / 2}; pg8::MoeOrder S; S.init(mrows, 2 * DFFE, G, bx); S.offs = loff; S.ntn = 2 * DFFE / 256;
                pg8::EpiSwiGLU8 E{WSP(unsigned char, WS_G1), DFFE, 1.0f / WSCALE, GSCALE};
                pg8::gemm_phase<pg8::EpiSwiGLU8, pg8::MoeOrder, true, true, true>(lds + RING_OFF, g, S, E, tid);
            PH_END(true)
            PH_BEGIN
                const int mrows = (int)loff[8];
                pg8::Gemm g{WSP(bf16, WS_G1), WSP(bf16, WS_WED), mrows, D, DFFE / 2}; pg8::MoeOrder S; S.init(mrows, D, G, bx); S.offs = loff; S.ntn = D / 256;
                pg8::EpiPlainS E{WSP(bf16, WS_Y), D, 1.0f / (WSCALE * GSCALE)};
                pg8::gemm_phase<pg8::EpiPlainS, pg8::MoeOrder, true, true, true>(lds + RING_OFF, g, S, E, tid);
            PH_END(true)
            PH_BEGIN
                const int4* route = WSP(int4, WS_ROUTE); const int2* slots = WSP(int2, WS_SLOTS); const bf16* HP = WSP(bf16, WS_Y); float* xres = ap->out; const float* g_final = ap->in[15];
#pragma unroll 1
                for (int m = gw; m < T; m += NGW) {
                    const int4 rt = route[m]; const int2 sl = slots[m]; const float w1 = __int_as_float(rt.z), w2 = __int_as_float(rt.w);
                    GAS f32x4* xr = (GAS f32x4*)(xres + (size_t)m * D) + lane; const GAS f32x4* gr = (const GAS f32x4*)g_final + lane;
                    const GAS u32x2v* y1 = (const GAS u32x2v*)(HP + (size_t)sl.x * D) + lane; const GAS u32x2v* y2 = (const GAS u32x2v*)(HP + (size_t)sl.y * D) + lane;
                    f32x4 v[4]; float s = 0.f;
#pragma unroll
                    for (int j = 0; j < 4; ++j) { v[j] = xr[64 * j]; const u32x2v a = y1[64 * j], b = y2[64 * j];
                        v[j].x += w1 * __builtin_bit_cast(float, a.x << 16) + w2 * __builtin_bit_cast(float, b.x << 16);
                        v[j].y += w1 * __builtin_bit_cast(float, a.x & 0xffff0000u) + w2 * __builtin_bit_cast(float, b.x & 0xffff0000u);
                        v[j].z += w1 * __builtin_bit_cast(float, a.y << 16) + w2 * __builtin_bit_cast(float, b.y << 16);
                        v[j].w += w1 * __builtin_bit_cast(float, a.y & 0xffff0000u) + w2 * __builtin_bit_cast(float, b.y & 0xffff0000u);
                        s += (v[j].x * v[j].x + v[j].y * v[j].y) + (v[j].z * v[j].z + v[j].w * v[j].w); }
                    const float rstd = 1.0f / sqrtf(wave_sum(s) * (1.f / D) + EPS);
#pragma unroll
                    for (int j = 0; j < 4; ++j) { const f32x4 gg = gr[64 * j]; xr[64 * j] = (f32x4){v[j].x * rstd * gg.x, v[j].y * rstd * gg.y, v[j].z * rstd * gg.z, v[j].w * rstd * gg.w}; }
                }
            PH_END(false)
        }
    }
#ifdef PROBE_CLK
    if (blockIdx.x == 0) { const unsigned long long t0_ = __builtin_amdgcn_s_memrealtime(); const unsigned long long want = (unsigned long long)(probe_cycles / 64); while (__builtin_amdgcn_s_memrealtime() - t0_ < want) __builtin_amdgcn_s_sleep(4); }
#endif
}

extern "C" void kernel_launch(void* const* d_in, const int* in_sizes, int n_in, void* d_out, int out_size, void* d_ws, size_t ws_size, hipStream_t stream) {
    static int grid = 0;
    if (grid == 0) {
        if (n_in != 16 || in_sizes[0] != T * D || out_size != T * D || ws_size < WS_END) { fprintf(stderr, "kernel_launch: unexpected shapes (n_in %d, in0 %d, out %d, ws %zu); nothing launched\n", n_in, n_in > 0 ? in_sizes[0] : -1, out_size, ws_size); grid = -1; return; }
        int dev = 0, cus = 0, per_cu = 0;
        if (hipGetDevice(&dev) != hipSuccess || hipDeviceGetAttribute(&cus, hipDeviceAttributeMultiprocessorCount, dev) != hipSuccess) { grid = -1; return; }
        if (hipFuncSetAttribute((const void*)mega_fwd, hipFuncAttributeMaxDynamicSharedMemorySize, LDS_BYTES) != hipSuccess) { fprintf(stderr, "kernel_launch: hipFuncSetAttribute failed\n"); grid = -1; return; }
        if (hipOccupancyMaxActiveBlocksPerMultiprocessor(&per_cu, (const void*)mega_fwd, NWAVES * 64, LDS_BYTES) != hipSuccess || per_cu < 1) { fprintf(stderr, "kernel_launch: occupancy query reports %d workgroups per CU\n", per_cu); }
        (void)hipGetLastError();
        grid = cus;
        while (grid > 1 && (T % grid) != 0) --grid;
    }
    if (grid < 0) return;
    if (hipMemsetAsync((char*)d_ws + WS_CTL, 0, CTL_ZERO_BYTES, stream) != hipSuccess) return;
    Args a{};
    for (int i = 0; i < 16; ++i) a.in[i] = (const float*)d_in[i];
    a.out = (float*)d_out; a.ws = (unsigned char*)d_ws;
    hipLaunchKernelGGL(mega_fwd, dim3(grid), dim3(NWAVES * 64), LDS_BYTES, stream, a);
}
```

```cpp
#include <hip/hip_runtime.h>
#include <cstdio>
#include <cstdint>
#include <cmath>
#ifndef PG8_RELAX
#define PG8_RELAX 1
#endif
namespace pg8 {
#define PG8_LAS __attribute__((address_space(3)))
typedef unsigned short bf16_t;
typedef short bf16x8 __attribute__((ext_vector_type(8)));
typedef float f32x4 __attribute__((ext_vector_type(4)));
typedef unsigned u32x4 __attribute__((ext_vector_type(4)));
constexpr int BM = 256, BK = 64, HALF = 128, HTB = HALF * BK * 2  , STAGE_BYTES = 8 * HTB, NXCD = 8, WGM = 8;

__host__ __device__ __forceinline__ int lds_byte(int r, int c) { const int st = (r >> 4) * 2 + (c >> 5), rr = r & 15, cc = c & 31, ob = rr * 64 + cc * 2; return st * 1024 + (ob ^ (((ob >> 9) & 1) << 5)); }
__host__ __device__ __forceinline__ void stage_rc(int b, int& R, int& C) { const int st = b / 1024, sb = b % 1024, swz = sb ^ (((sb >> 9) & 1) << 5); R = (st >> 1) * 16 + swz / 64; C = (st & 1) * 32 + (swz % 64) / 2; }
__host__ __device__ __forceinline__ int perm32(int rho) { const int n = rho >> 4, i = rho & 15; return 8 * (i >> 2) + 4 * n + (i & 3); }

struct Unit { int pm, pn, pb; };
struct Gemm { const bf16_t* A; const bf16_t* Bt; int M, N, K; };

struct StaticOrder {
    int nM, nN, nwg, G, c;
    __host__ __device__ void init(int M, int N, int G_, int c_) { nM = M / BM; nN = N / BM; nwg = nM * nN; G = G_; c = c_; }
    __host__ __device__ bool next(int i, Unit& u) const {
        const long L = (long)i * G + c; if (L >= nwg) return false;
        int wgid = (int)L; { const int q = nwg / NXCD, r = nwg % NXCD, xcd = wgid % NXCD, off = wgid / NXCD; wgid = (xcd < r ? xcd * (q + 1) : r * (q + 1) + (xcd - r) * q) + off; }
        const int nig = WGM * nN, gid = wgid / nig, fm = gid * WGM, gsz = (nM - fm) < WGM ? (nM - fm) : WGM;
        u.pm = fm + ((wgid % nig) % gsz); u.pn = (wgid % nig) / gsz; u.pb = u.pn; return true;
    }
    __device__ __forceinline__ void a_ready(const Unit&) const {}
    __device__ __forceinline__ void done(const Unit&) const {}
};

__device__ __forceinline__ unsigned cvt_pk_bf16(float lo, float hi) { unsigned r; asm volatile("v_cvt_pk_bf16_f32 %0, %1, %2" : "=v"(r) : "v"(lo), "v"(hi)); return r; }
typedef float f32x2 __attribute__((ext_vector_type(2)));

__device__ __forceinline__ float sigmoidf_fast(float x) { return __builtin_amdgcn_rcpf(1.0f + __builtin_amdgcn_exp2f(-1.4426950408889634f * x)); }
__device__ __forceinline__ float bf_lo(unsigned w) { return __builtin_bit_cast(float, w << 16); }
__device__ __forceinline__ float bf_hi(unsigned w) { return __builtin_bit_cast(float, w & 0xffff0000u); }
__device__ __forceinline__ void unpack8(const u32x4 w, float (&f)[8]) { f[0] = bf_lo(w.x); f[1] = bf_hi(w.x); f[2] = bf_lo(w.y); f[3] = bf_hi(w.y); f[4] = bf_lo(w.z); f[5] = bf_hi(w.z); f[6] = bf_lo(w.w); f[7] = bf_hi(w.w); }
__device__ __forceinline__ u32x4 pack8(const float (&f)[8]) { u32x4 w; w.x = cvt_pk_bf16(f[0], f[1]); w.y = cvt_pk_bf16(f[2], f[3]); w.z = cvt_pk_bf16(f[4], f[5]); w.w = cvt_pk_bf16(f[6], f[7]); return w; }

struct EpiProj {
    static constexpr int NVMEM = 16;
    static constexpr bool PERM = true, AFTER_DRAIN = false;
    bf16_t* PA; bf16_t* QF; bf16_t* KF; bf16_t* GT; float qscale;
    __device__ __forceinline__ void operator()(const f32x4 (&acc)[2][2][4][2], const Unit& u, int wr, int wc, int fr, int fq) const {
        const int row0 = u.pm * BM + wr * 64 + fr;
        if (u.pn >= 6 && u.pn < 10) {
            const bool isq = u.pn < 8; const float sc = isq ? qscale : 1.f; bf16_t* base = isq ? QF : KF;
            const int hc0 = (u.pn - (isq ? 6 : 8)) * BM + wc * 32 + 8 * fq;
#pragma unroll
            for (int ai = 0; ai < 2; ++ai)
#pragma unroll
                for (int m = 0; m < 4; ++m) { const int row = row0 + ai * HALF + m * 16; const int b = row >> 12, t = row & 4095, blk = t >> 5, tl = t & 31;
                    const int li = isq ? tl : ((tl & 19) | ((tl & 4) << 1) | ((tl & 8) >> 1));
#pragma unroll
                    for (int bj = 0; bj < 2; ++bj) { const int hc = hc0 + bj * HALF, h = hc >> 6, c = (hc & 63) >> 3, d0 = c >> 1, hg = c & 1;
                        const f32x4 v0 = acc[ai][bj][m][0] * sc, v1 = acc[ai][bj][m][1] * sc;
                        u32x4 w; w.x = cvt_pk_bf16(v0[0], v0[1]); w.y = cvt_pk_bf16(v0[2], v0[3]); w.z = cvt_pk_bf16(v1[0], v1[1]); w.w = cvt_pk_bf16(v1[2], v1[3]);
                        *(u32x4*)(base + ((((size_t)(b * 8 + h) * 128 + blk) * 4 + d0) * 64 + hg * 32 + li) * 8) = w; } }
            return;
        }
        bf16_t* base; int ldc, colt;
        if (u.pn < 6) { base = PA; ldc = 1536; colt = u.pn * BM; } else { base = GT; ldc = 2048; colt = (u.pn - 10) * BM; }
        const int col0 = colt + wc * 32 + 8 * fq;
#pragma unroll
        for (int ai = 0; ai < 2; ++ai)
#pragma unroll
            for (int m = 0; m < 4; ++m) { bf16_t* rowp = base + (size_t)(row0 + ai * HALF + m * 16) * ldc + col0;
#pragma unroll
                for (int bj = 0; bj < 2; ++bj) { const f32x4 v0 = acc[ai][bj][m][0], v1 = acc[ai][bj][m][1];
                    u32x4 w; w.x = cvt_pk_bf16(v0[0], v0[1]); w.y = cvt_pk_bf16(v0[2], v0[3]); w.z = cvt_pk_bf16(v1[0], v1[1]); w.w = cvt_pk_bf16(v1[2], v1[3]);
                    *(u32x4*)(rowp + bj * HALF) = w; } }
    }
};
struct EpiVT {
    static constexpr int NVMEM = 16;
    static constexpr bool PERM = true, AFTER_DRAIN = false;
    bf16_t* VF;
    __device__ __forceinline__ void operator()(const f32x4 (&acc)[2][2][4][2], const Unit& u, int wr, int wc, int fr, int fq) const {
        const int row0 = u.pm * BM + wr * 64 + fr, tok0 = u.pn * BM + wc * 32 + 8 * fq;
#pragma unroll
        for (int ai = 0; ai < 2; ++ai)
#pragma unroll
            for (int m = 0; m < 4; ++m) { const int hd = row0 + ai * HALF + m * 16, h = hd >> 6, dblk = (hd >> 5) & 1, dl = hd & 31;
#pragma unroll
                for (int bj = 0; bj < 2; ++bj) { const int tok = tok0 + bj * HALF, b = tok >> 12, t = tok & 4095, blk = t >> 5, s = (t >> 4) & 1, hg = (t >> 3) & 1;
                    const f32x4 v0 = acc[ai][bj][m][0], v1 = acc[ai][bj][m][1];
                    u32x4 w; w.x = cvt_pk_bf16(v0[0], v0[1]); w.y = cvt_pk_bf16(v0[2], v0[3]); w.z = cvt_pk_bf16(v1[0], v1[1]); w.w = cvt_pk_bf16(v1[2], v1[3]);
                    *(u32x4*)(VF + ((((size_t)(b * 8 + h) * 128 + blk) * 4 + dblk * 2 + s) * 64 + hg * 32 + dl) * 8) = w; } }
    }
};
struct EpiPlain {
    static constexpr int NVMEM = 16;
    static constexpr bool PERM = true, AFTER_DRAIN = false;
    bf16_t* O; int ldc;
    __device__ __forceinline__ void operator()(const f32x4 (&acc)[2][2][4][2], const Unit& u, int wr, int wc, int fr, int fq) const {
        const int row0 = u.pm * BM + wr * 64 + fr, col0 = u.pn * BM + wc * 32 + 8 * fq;
#pragma unroll
        for (int ai = 0; ai < 2; ++ai)
#pragma unroll
            for (int m = 0; m < 4; ++m) { bf16_t* rowp = O + (size_t)(row0 + ai * HALF + m * 16) * ldc + col0;
#pragma unroll
                for (int bj = 0; bj < 2; ++bj) { const f32x4 v0 = acc[ai][bj][m][0], v1 = acc[ai][bj][m][1];
                    u32x4 w; w.x = cvt_pk_bf16(v0[0], v0[1]); w.y = cvt_pk_bf16(v0[2], v0[3]); w.z = cvt_pk_bf16(v1[0], v1[1]); w.w = cvt_pk_bf16(v1[2], v1[3]);
                    *(u32x4*)(rowp + bj * HALF) = w; } }
    }
};
struct EpiSwiGLU {
    static constexpr int NVMEM = 8;
    static constexpr bool PERM = true, AFTER_DRAIN = false;
    bf16_t* O; int ldc;
    __device__ __forceinline__ void operator()(const f32x4 (&acc)[2][2][4][2], const Unit& u, int wr, int wc, int fr, int fq) const {
        const int row0 = u.pm * BM + wr * 64 + fr, col0 = u.pn * HALF + wc * 32 + 8 * fq;
#pragma unroll
        for (int ai = 0; ai < 2; ++ai)
#pragma unroll
            for (int m = 0; m < 4; ++m) { bf16_t* rowp = O + (size_t)(row0 + ai * HALF + m * 16) * ldc + col0;
                float o[8];
#pragma unroll
                for (int n = 0; n < 2; ++n)
#pragma unroll
                    for (int i = 0; i < 4; ++i) { const float g = acc[ai][0][m][n][i], up = acc[ai][1][m][n][i]; o[4 * n + i] = g * sigmoidf_fast(g) * up; }
                *(u32x4*)rowp = pack8(o); }
    }
};
struct EpiGateA {
    static constexpr int NVMEM = 16;
    static constexpr bool PERM = true, AFTER_DRAIN = false;
    const bf16_t* GT; bf16_t* TMP;
    __device__ __forceinline__ void operator()(const f32x4 (&acc)[2][2][4][2], const Unit& u, int wr, int wc, int fr, int fq) const {
        const int row0 = u.pm * BM + wr * 64 + fr, col0 = u.pn * BM + wc * 32 + 8 * fq;
#pragma unroll
        for (int ai = 0; ai < 2; ++ai)
#pragma unroll
            for (int m = 0; m < 4; ++m) { const size_t r = (size_t)(row0 + ai * HALF + m * 16);
#pragma unroll
                for (int bj = 0; bj < 2; ++bj) { const int c = col0 + bj * HALF;
                    float g[8], o[8]; unpack8(*(const u32x4*)(GT + r * 2048 + c), g);
#pragma unroll
                    for (int n = 0; n < 2; ++n)
#pragma unroll
                        for (int i = 0; i < 4; ++i) o[4 * n + i] = sigmoidf_fast(g[4 * n + i]) * acc[ai][bj][m][n][i];
                    *(u32x4*)(TMP + r * 1024 + c) = pack8(o); } }
    }
};
struct EpiGateB {
    static constexpr int NVMEM = 16;
    static constexpr bool PERM = true, AFTER_DRAIN = false;
    const bf16_t* GT; const bf16_t* TMP; bf16_t* MIX;
    __device__ __forceinline__ void operator()(const f32x4 (&acc)[2][2][4][2], const Unit& u, int wr, int wc, int fr, int fq) const {
        const int row0 = u.pm * BM + wr * 64 + fr, col0 = u.pn * BM + wc * 32 + 8 * fq;
#pragma unroll
        for (int ai = 0; ai < 2; ++ai)
#pragma unroll
            for (int m = 0; m < 4; ++m) { const size_t r = (size_t)(row0 + ai * HALF + m * 16);
#pragma unroll
                for (int bj = 0; bj < 2; ++bj) { const int c = col0 + bj * HALF;
                    float g[8], t[8], o[8]; unpack8(*(const u32x4*)(GT + r * 2048 + 1024 + c), g); unpack8(*(const u32x4*)(TMP + r * 1024 + c), t);
#pragma unroll
                    for (int n = 0; n < 2; ++n)
#pragma unroll
                        for (int i = 0; i < 4; ++i) o[4 * n + i] = t[4 * n + i] + sigmoidf_fast(g[4 * n + i]) * acc[ai][bj][m][n][i];
                    *(u32x4*)(MIX + r * 1024 + c) = pack8(o); } }
    }
};
struct EpiRes {
    static constexpr int NVMEM = 32;
    static constexpr bool PERM = false, AFTER_DRAIN = false;
    const float* base; float* out; int ldc; float sc;
    __device__ __forceinline__ void operator()(const f32x4 (&acc)[2][2][4][2], const Unit& u, int wr, int wc, int fr, int fq) const {
        const int row0 = u.pm * BM + wr * 64 + fr, col0 = u.pn * BM + wc * 32 + 4 * fq;
#pragma unroll
        for (int ai = 0; ai < 2; ++ai)
#pragma unroll
            for (int m = 0; m < 4; ++m) { const size_t off = (size_t)(row0 + ai * HALF + m * 16) * ldc + col0;
#pragma unroll
                for (int bj = 0; bj < 2; ++bj)
#pragma unroll
                    for (int n = 0; n < 2; ++n) { const f32x4 b = *(const f32x4*)(base + off + bj * HALF + n * 16); *(f32x4*)(out + off + bj * HALF + n * 16) = b + acc[ai][bj][m][n] * sc; } }
    }
};
__device__ __forceinline__ unsigned pk4_fp8(float a, float b, float c, float d) {
    a = __builtin_amdgcn_fmed3f(a, -448.f, 448.f); b = __builtin_amdgcn_fmed3f(b, -448.f, 448.f); c = __builtin_amdgcn_fmed3f(c, -448.f, 448.f); d = __builtin_amdgcn_fmed3f(d, -448.f, 448.f);
    int w = 0; w = __builtin_amdgcn_cvt_pk_fp8_f32(a, b, w, false); w = __builtin_amdgcn_cvt_pk_fp8_f32(c, d, w, true); return (unsigned)w;
}
struct EpiSwiGLU8 {
    static constexpr int NVMEM = 8;
    static constexpr bool PERM = true, AFTER_DRAIN = false;
    unsigned char* O; int ldc; float wsc, osc;
    __device__ __forceinline__ void operator()(const f32x4 (&acc)[2][2][4][2], const Unit& u, int wr, int wc, int fr, int fq) const {
        const int row0 = u.pm * BM + wr * 64 + fr, col0 = u.pn * HALF + wc * 32 + 8 * fq;
        typedef unsigned u32x2 __attribute__((ext_vector_type(2)));
#pragma unroll
        for (int ai = 0; ai < 2; ++ai)
#pragma unroll
            for (int m = 0; m < 4; ++m) { unsigned char* rowp = O + (size_t)(row0 + ai * HALF + m * 16) * ldc + col0;
                float o[8];
#pragma unroll
                for (int n = 0; n < 2; ++n)
#pragma unroll
                    for (int i = 0; i < 4; ++i) { const float g = acc[ai][0][m][n][i] * wsc, up = acc[ai][1][m][n][i] * wsc; o[4 * n + i] = g * sigmoidf_fast(g) * up * osc; }
                u32x2 w; w.x = pk4_fp8(o[0], o[1], o[2], o[3]); w.y = pk4_fp8(o[4], o[5], o[6], o[7]);
                *(u32x2*)rowp = w; }
    }
};
struct EpiPlainS {
    static constexpr int NVMEM = 16;
    static constexpr bool PERM = true, AFTER_DRAIN = false;
    bf16_t* O; int ldc; float sc;
    __device__ __forceinline__ void operator()(const f32x4 (&acc)[2][2][4][2], const Unit& u, int wr, int wc, int fr, int fq) const {
        const int row0 = u.pm * BM + wr * 64 + fr, col0 = u.pn * BM + wc * 32 + 8 * fq;
#pragma unroll
        for (int ai = 0; ai < 2; ++ai)
#pragma unroll
            for (int m = 0; m < 4; ++m) { bf16_t* rowp = O + (size_t)(row0 + ai * HALF + m * 16) * ldc + col0;
#pragma unroll
                for (int bj = 0; bj < 2; ++bj) { const f32x4 v0 = acc[ai][bj][m][0] * sc, v1 = acc[ai][bj][m][1] * sc;
                    u32x4 w; w.x = cvt_pk_bf16(v0[0], v0[1]); w.y = cvt_pk_bf16(v0[2], v0[3]); w.z = cvt_pk_bf16(v1[0], v1[1]); w.w = cvt_pk_bf16(v1[2], v1[3]);
                    *(u32x4*)(rowp + bj * HALF) = w; } }
    }
};
struct EpiNull {
    static constexpr int NVMEM = 0;
    static constexpr bool PERM = true, AFTER_DRAIN = false;
    __device__ __forceinline__ void operator()(const f32x4 (&acc)[2][2][4][2], const Unit& u, int wr, int wc, int fr, int fq) const {
#pragma unroll
        for (int ai = 0; ai < 2; ++ai)
#pragma unroll
            for (int bj = 0; bj < 2; ++bj)
#pragma unroll
                for (int m = 0; m < 4; ++m)
#pragma unroll
                    for (int n = 0; n < 2; ++n) asm volatile("" :: "v"(acc[ai][bj][m][n]));
    }
};
struct EpiL2 {
    static constexpr int NVMEM = 16;
    static constexpr bool PERM = true, AFTER_DRAIN = false;
    bf16_t* S; int bx;
    __device__ __forceinline__ void operator()(const f32x4 (&acc)[2][2][4][2], const Unit& u, int wr, int wc, int fr, int fq) const {
        const int row0 = wr * 64 + fr, col0 = wc * 32 + 8 * fq; bf16_t* base = S + (size_t)bx * 65536;
#pragma unroll
        for (int ai = 0; ai < 2; ++ai)
#pragma unroll
            for (int m = 0; m < 4; ++m) {
#ifdef PROBE_L2W
                bf16_t* rowp = base + (size_t)(wr * 64 + (fr >> 1) + ai * HALF + m * 16) * 256 + wc * 64 + (fr & 1) * 32 + 8 * fq;
#else
                bf16_t* rowp = base + (size_t)(row0 + ai * HALF + m * 16) * 256 + col0;
#endif
#pragma unroll
                for (int bj = 0; bj < 2; ++bj) { const f32x4 v0 = acc[ai][bj][m][0], v1 = acc[ai][bj][m][1];
                    u32x4 w; w.x = cvt_pk_bf16(v0[0], v0[1]); w.y = cvt_pk_bf16(v0[2], v0[3]); w.z = cvt_pk_bf16(v1[0], v1[1]); w.w = cvt_pk_bf16(v1[2], v1[3]);
#ifdef PROBE_L2ONE
                    if (ai == 0 && m == 0 && bj == 0) *(u32x4*)(rowp + bj * HALF) = w; else asm volatile("" :: "v"(w));
#else
                    *(u32x4*)(rowp + bj * HALF) = w;
#endif
                    } }
    }
};
struct MoeOrder : StaticOrder {
    const volatile PG8_LAS unsigned* offs; int ntn;
    __device__ __forceinline__ bool next(int i, Unit& u) const {
        if (!StaticOrder::next(i, u)) return false;
        const unsigned row = (unsigned)u.pm * BM; int e = 0;
#pragma unroll
        for (int k = 1; k < 8; ++k) e += (row >= offs[k]) ? 1 : 0;
        u.pb = e * ntn + u.pn; return true;
    }
};
typedef int i32x8 __attribute__((ext_vector_type(8))); typedef int i32x4 __attribute__((ext_vector_type(4)));
__device__ __forceinline__ i32x8 cat8(const bf16x8 lo, const bf16x8 hi) { const i32x4 a = __builtin_bit_cast(i32x4, lo), b = __builtin_bit_cast(i32x4, hi); return (i32x8){a.x, a.y, a.z, a.w, b.x, b.y, b.z, b.w}; }
template <class Epi, class Sched, bool ALIGN_EPI = false, bool SP2 = false, bool FP8 = false>
__device__ __forceinline__ void gemm_phase(PG8_LAS unsigned char* lds, const Gemm g, const Sched& S, const Epi& E, const int tid) {
    const int wid = __builtin_amdgcn_readfirstlane(tid >> 6), lane = tid & 63, wr = wid >> 2, wc = wid & 3, fr = lane & 15, fq = lane >> 4;
    const int K = g.K, nt = K / BK;
    unsigned voffA[2], voffB[2];
#pragma unroll
    for (int i = 0; i < 2; ++i) { int R, C; stage_rc(tid * 16 + i * 8192, R, C); const int Rb = Epi::PERM ? ((R & ~31) + perm32(R & 31)) : R;
        voffA[i] = (unsigned)(R * K + C) * 2u; voffB[i] = (unsigned)(Rb * K + C) * 2u; }
    const size_t kstep = (size_t)(BK * 2);
    const size_t hstep = (size_t)HALF * K * 2;
    const size_t tstep = 2 * hstep;
    const unsigned ldsw = (unsigned)wid * 1024u;
    const int aoff = lds_byte(wr * 64 + fr, fq * 8), boff = lds_byte(wc * 32 + fr, fq * 8);
#define PG8_SA(b, h) (((b) * 2 + (h)) * HTB)
#define PG8_SB(b, h) ((4 + (b) * 2 + (h)) * HTB)
#define PG8_STAGE(bufoff, gbase, voff) do { _Pragma("unroll") for (int _i = 0; _i < 2; ++_i) \
        __builtin_amdgcn_global_load_lds((const unsigned*)((const char*)(gbase) + (voff)[_i]), (PG8_LAS unsigned*)(lds + (bufoff) + ldsw + _i * 8192), 16, 0, 0); } while (0)
#define PG8_LDA(dst, b, h) do { if constexpr (FP8) { _Pragma("unroll") for (int m = 0; m < 4; ++m) { const i32x4 l_ = *(const PG8_LAS i32x4*)(lds + PG8_SA(b, h) + aoff + m * 2048), h_ = *(const PG8_LAS i32x4*)(lds + PG8_SA(b, h) + aoff + m * 2048 + 1024); dst##8[m] = (i32x8){l_.x, l_.y, l_.z, l_.w, h_.x, h_.y, h_.z, h_.w}; } } \
        else { _Pragma("unroll") for (int m = 0; m < 4; ++m) _Pragma("unroll") for (int k = 0; k < 2; ++k) dst[m][k] = *(const PG8_LAS i32x4*)(lds + PG8_SA(b, h) + aoff + m * 2048 + k * 1024); } } while (0)
#define PG8_LDB(dst, b, h) do { if constexpr (FP8) { _Pragma("unroll") for (int n = 0; n < 2; ++n) { const i32x4 l_ = *(const PG8_LAS i32x4*)(lds + PG8_SB(b, h) + boff + n * 2048), h_ = *(const PG8_LAS i32x4*)(lds + PG8_SB(b, h) + boff + n * 2048 + 1024); dst##8[n] = (i32x8){l_.x, l_.y, l_.z, l_.w, h_.x, h_.y, h_.z, h_.w}; } } \
        else { _Pragma("unroll") for (int n = 0; n < 2; ++n) _Pragma("unroll") for (int k = 0; k < 2; ++k) dst[n][k] = *(const PG8_LAS i32x4*)(lds + PG8_SB(b, h) + boff + n * 2048 + k * 1024); } } while (0)
#define PG8_MMA(ai, bj, At, Bt) do { __builtin_amdgcn_s_setprio(1); \
        if constexpr (FP8) { _Pragma("unroll") for (int m = 0; m < 4; ++m) _Pragma("unroll") for (int n = 0; n < 2; ++n) \
            asm volatile("v_mfma_scale_f32_16x16x128_f8f6f4 %0, %1, %2, %0, %3, %3 op_sel_hi:[0,0,0]" : "+v"(acc[ai][bj][m][n]) : "v"(Bt##8[n]), "v"(At##8[m]), "v"(sc1_)); } \
        else { _Pragma("unroll") for (int m = 0; m < 4; ++m) _Pragma("unroll") for (int n = 0; n < 2; ++n) _Pragma("unroll") for (int k = 0; k < 2; ++k) \
            acc[ai][bj][m][n] = __builtin_amdgcn_mfma_f32_16x16x32_bf16(__builtin_bit_cast(bf16x8, Bt[n][k]), __builtin_bit_cast(bf16x8, At[m][k]), acc[ai][bj][m][n], 0, 0, 0); } \
        __builtin_amdgcn_s_setprio(0); } while (0)
#define PG8_WAIT_V(n) asm volatile("s_waitcnt vmcnt(" #n ")" ::: "memory")
#define PG8_WAIT_V8R(rel) asm volatile("s_cmp_lg_u32 %0, 0\n\ts_cbranch_scc1 1\n\ts_waitcnt vmcnt(8)\n\ts_waitcnt vmcnt(%1)" :: "s"(rel), "n"(8 + (Epi::NVMEM > 55 ? 55 : Epi::NVMEM)) : "memory", "scc")
#define PG8_WAIT_L(n) asm volatile("s_waitcnt lgkmcnt(" #n ")" ::: "memory")
#define PG8_BAR __builtin_amdgcn_s_barrier()
#define PG8_SCHED __builtin_amdgcn_sched_barrier(0)
    Unit cur, nxt; int ui = 0;
    if (!S.next(0, cur)) return;
    f32x4 acc[2][2][4][2];
#pragma unroll
    for (int a = 0; a < 2; ++a)
#pragma unroll
        for (int b = 0; b < 2; ++b)
#pragma unroll
            for (int m = 0; m < 4; ++m)
#pragma unroll
                for (int n = 0; n < 2; ++n) acc[a][b][m][n] = (f32x4){0.f, 0.f, 0.f, 0.f};
    int sc1_ = 0x7f7f7f7f; asm volatile("" : "+v"(sc1_));
    typedef i32x4 frag_t; frag_t At[4][2], B0[2][2], B1[2][2]; i32x8 At8[4], B08[2], B18[2];
    const char* cA = (const char*)g.A + (size_t)cur.pm * tstep; const char* cB = (const char*)g.Bt + (size_t)cur.pb * tstep;
    S.a_ready(cur);
    if constexpr (SP2) {
        PG8_STAGE(PG8_SB(0, 0), cB, voffB); PG8_STAGE(PG8_SB(0, 1), cB + hstep, voffB); PG8_STAGE(PG8_SA(0, 0), cA, voffA); PG8_STAGE(PG8_SA(0, 1), cA + hstep, voffA);
        if (wr == 1) PG8_BAR;
        PG8_WAIT_V(2); PG8_BAR;
        PG8_STAGE(PG8_SB(1, 0), cB + kstep, voffB); PG8_STAGE(PG8_SA(1, 0), cA + kstep, voffA); PG8_STAGE(PG8_SB(1, 1), cB + hstep + kstep, voffB);
        PG8_WAIT_V(6); PG8_BAR;
    } else {
        PG8_STAGE(PG8_SB(0, 0), cB, voffB); PG8_STAGE(PG8_SA(0, 0), cA, voffA); PG8_STAGE(PG8_SB(0, 1), cB + hstep, voffB); PG8_STAGE(PG8_SA(0, 1), cA + hstep, voffA);
        if (wr == 1) PG8_BAR;
        PG8_WAIT_V(4); PG8_BAR;
        PG8_STAGE(PG8_SB(1, 0), cB + kstep, voffB); PG8_STAGE(PG8_SA(1, 0), cA + kstep, voffA); PG8_STAGE(PG8_SB(1, 1), cB + hstep + kstep, voffB);
        PG8_WAIT_V(6); PG8_BAR;
    }
    for (;;) {
        const bool has_next = S.next(ui + 1, nxt);
        const char* nA = has_next ? (const char*)g.A + (size_t)nxt.pm * tstep : cA; const char* nB = has_next ? (const char*)g.Bt + (size_t)nxt.pb * tstep : cB;
        for (int t = 0; t < nt; t += 2) {
            const bool last = (t == nt - 2);
            const int relax = __builtin_amdgcn_readfirstlane((PG8_RELAX && (t == 0) && (ui > 0)) ? 1 : 0);
            const char* a1 = cA + (size_t)(t + 1) * kstep;
            const char* a2 = last ? nA : cA + (size_t)(t + 2) * kstep; const char* b2 = last ? nB : cB + (size_t)(t + 2) * kstep;
            const char* a3 = a2 + kstep; const char* b3 = b2 + kstep;
            if (last && has_next) S.a_ready(nxt);
            if constexpr (SP2) {
            PG8_LDB(B0, 0, 0); PG8_LDB(B1, 0, 1); PG8_SCHED; PG8_LDA(At, 0, 0); PG8_STAGE(PG8_SA(1, 1), a1 + hstep, voffA);
            PG8_WAIT_V8R(relax); PG8_WAIT_L(0); PG8_BAR; PG8_MMA(0, 0, At, B0); PG8_MMA(0, 1, At, B1); PG8_BAR; PG8_SCHED;
            PG8_LDA(At, 0, 1); PG8_STAGE(PG8_SB(0, 0), b2, voffB); PG8_STAGE(PG8_SB(0, 1), b2 + hstep, voffB); PG8_STAGE(PG8_SA(0, 0), a2, voffA);
            PG8_WAIT_V8R(relax); PG8_WAIT_L(0); PG8_BAR; PG8_MMA(1, 0, At, B0); PG8_MMA(1, 1, At, B1); PG8_BAR; PG8_SCHED;
            PG8_LDB(B0, 1, 0); PG8_LDB(B1, 1, 1); PG8_SCHED; PG8_LDA(At, 1, 0); PG8_STAGE(PG8_SA(0, 1), a2 + hstep, voffA);
            PG8_WAIT_V(8); PG8_WAIT_L(0); PG8_BAR; PG8_MMA(0, 0, At, B0); PG8_MMA(0, 1, At, B1); PG8_BAR; PG8_SCHED;
            PG8_LDA(At, 1, 1); PG8_STAGE(PG8_SB(1, 0), b3, voffB); PG8_STAGE(PG8_SB(1, 1), b3 + hstep, voffB); PG8_STAGE(PG8_SA(1, 0), a3, voffA);
            PG8_WAIT_V(8); PG8_WAIT_L(0); PG8_BAR; PG8_MMA(1, 0, At, B0); PG8_MMA(1, 1, At, B1); PG8_BAR; PG8_SCHED;
            } else {
            PG8_LDB(B0, 0, 0); PG8_SCHED; PG8_LDA(At, 0, 0); PG8_STAGE(PG8_SA(1, 1), a1 + hstep, voffA);
            PG8_WAIT_L(8); PG8_BAR; PG8_WAIT_L(0); PG8_MMA(0, 0, At, B0); PG8_BAR; PG8_SCHED;
            PG8_LDB(B1, 0, 1); PG8_STAGE(PG8_SB(0, 0), b2, voffB);
            PG8_BAR; PG8_WAIT_L(0); PG8_MMA(0, 1, At, B1); PG8_BAR;
            PG8_LDA(At, 0, 1); PG8_STAGE(PG8_SA(0, 0), a2, voffA);
            PG8_BAR; PG8_WAIT_L(0); PG8_MMA(1, 0, At, B0); PG8_BAR; PG8_SCHED;
            PG8_STAGE(PG8_SB(0, 1), b2 + hstep, voffB);
            PG8_WAIT_V(6); PG8_BAR; PG8_MMA(1, 1, At, B1); PG8_BAR;
            PG8_LDB(B0, 1, 0); PG8_SCHED; PG8_LDA(At, 1, 0); PG8_STAGE(PG8_SA(0, 1), a2 + hstep, voffA);
            PG8_WAIT_L(8); PG8_BAR; PG8_WAIT_L(0); PG8_MMA(0, 0, At, B0); PG8_BAR; PG8_SCHED;
            PG8_LDB(B1, 1, 1); PG8_STAGE(PG8_SB(1, 0), b3, voffB);
            PG8_BAR; PG8_WAIT_L(0); PG8_MMA(0, 1, At, B1); PG8_BAR;
            PG8_LDA(At, 1, 1); PG8_STAGE(PG8_SA(1, 0), a3, voffA);
            PG8_BAR; PG8_WAIT_L(0); PG8_MMA(1, 0, At, B0); PG8_BAR; PG8_SCHED;
            PG8_STAGE(PG8_SB(1, 1), b3 + hstep, voffB);
            PG8_WAIT_V(6); PG8_BAR; PG8_MMA(1, 1, At, B1); PG8_BAR;
            }
        }
        if constexpr (FP8) asm volatile("s_nop 15\n\ts_nop 15" ::: "memory");
        if constexpr (ALIGN_EPI) { if (wr == 0) PG8_BAR; }
        if constexpr (!Epi::AFTER_DRAIN) { E(acc, cur, wr, wc, fr, fq); S.done(cur); }
        if (!has_next) break;
#pragma unroll
        for (int a = 0; a < 2; ++a)
#pragma unroll
            for (int b = 0; b < 2; ++b)
#pragma unroll
                for (int m = 0; m < 4; ++m)
#pragma unroll
                    for (int n = 0; n < 2; ++n) acc[a][b][m][n] = (f32x4){0.f, 0.f, 0.f, 0.f};
        cur = nxt; cA = nA; cB = nB; ++ui;
        if constexpr (ALIGN_EPI) { if (wr == 1) PG8_BAR; }
    }
    PG8_WAIT_V(0);
    if constexpr (!ALIGN_EPI) { if (wr == 0) PG8_BAR; }
    PG8_BAR;
    if constexpr (Epi::AFTER_DRAIN) { E.fused(acc, cur, wr, wc, fr, fq, lds, wid, lane); S.done(cur); }
#undef PG8_SA
#undef PG8_SB
#undef PG8_STAGE
#undef PG8_LDA
#undef PG8_LDB
#undef PG8_MMA
#undef PG8_WAIT_V
#undef PG8_WAIT_V8R
#undef PG8_WAIT_L
#undef PG8_BAR
#undef PG8_SCHED
}
}
#define GAS __attribute__((address_space(1)))
#define LAS __attribute__((address_space(3)))
typedef unsigned short bf16;
typedef unsigned v4u __attribute__((ext_vector_type(4)));
typedef float f32x4 __attribute__((ext_vector_type(4)));
typedef short bf16x8 __attribute__((ext_vector_type(8)));
typedef GAS unsigned gu32;
typedef GAS unsigned long long gu64;
#define RLX_AGENT __ATOMIC_RELAXED, __HIP_MEMORY_SCOPE_AGENT
#define LDS_WAIT() asm volatile("s_waitcnt lgkmcnt(0)" ::: "memory")
#define VM_WAIT() asm volatile("s_waitcnt vmcnt(0)" ::: "memory")
__device__ __forceinline__ unsigned long long rt() { return __builtin_amdgcn_s_memrealtime(); }
__device__ __forceinline__ unsigned f2bf(float f) { unsigned u = __builtin_bit_cast(unsigned, f); return (u + 0x7fffu + ((u >> 16) & 1u)) >> 16; }
__device__ __forceinline__ unsigned pk2(float lo, float hi) { return f2bf(lo) | (f2bf(hi) << 16); }

#define XB_TMO      128
#define XB_XCNT(j)  (256  + 64 * (j))
#define XB_XSUB(j)  (1280 + 64 * (j))
#define XB_XGEN(j)  (2304 + 64 * (j))
#define XB_TOP      3328
#define XB_TOPGEN   3392
#define XCD_BAR_WORDS 3456
#define XB_SPIN_CAP (1u << 18)

__device__ __forceinline__ unsigned xb_ld(unsigned* p)              { return __hip_atomic_load(p, __ATOMIC_RELAXED, __HIP_MEMORY_SCOPE_AGENT); }
__device__ __forceinline__ unsigned xb_add(unsigned* p, unsigned v) { return __hip_atomic_fetch_add(p, v, __ATOMIC_RELAXED, __HIP_MEMORY_SCOPE_AGENT); }
__device__ __forceinline__ unsigned xb_xcc_id() { return (unsigned)__builtin_amdgcn_s_getreg((3 << 11) | 20) & 0xFu; }
#define XB_SPIN(cond, bar) do { unsigned _sp = 0; while (cond) { __builtin_amdgcn_s_sleep(1); \
    if ((++_sp & 255u) == 0u) { if (xb_ld(&(bar)[XB_TMO])) break; if (_sp > XB_SPIN_CAP) { atomicAdd(&(bar)[XB_TMO], 1u); break; } } } } while (0)

struct XcdBarrier {
    unsigned* bar; unsigned x;
    volatile LAS unsigned* st;
};

__device__ __forceinline__ XcdBarrier xcd_barrier_post(unsigned* bar, volatile LAS unsigned* st) {
    XcdBarrier b; b.bar = bar; b.x = xb_xcc_id(); b.st = st;
    if (threadIdx.x == 0) (void)xb_add(&bar[XB_XCNT(b.x)], 1u);
    return b;
}
__device__ __forceinline__ void xcd_barrier_complete(unsigned* bar, unsigned x, unsigned& nloc, unsigned& nx) {
    const unsigned G = gridDim.x * gridDim.y * gridDim.z;
    unsigned sum, cnt, mine, sp = 0u;
    for (;;) {
        sum = 0u; cnt = 0u; mine = 0u;
#pragma unroll
        for (unsigned j = 0; j < 16; ++j) { const unsigned c = xb_ld(&bar[XB_XCNT(j)]); sum += c; cnt += (c > 0u) ? 1u : 0u; mine = (j == x) ? c : mine; }
        if (sum == G) break;
        __builtin_amdgcn_s_sleep(1);
        if ((++sp & 255u) == 0u) { if (xb_ld(&bar[XB_TMO])) break; if (sp > XB_SPIN_CAP) { atomicAdd(&bar[XB_TMO], 1u); break; } }
    }
    nloc = mine > 0u ? mine : 1u; nx = cnt > 0u ? cnt : 1u;
}

__device__ __forceinline__ void xcd_barrier(const XcdBarrier& b) {
    asm volatile("s_waitcnt vmcnt(0)" ::: "memory");
    __syncthreads();
    if (threadIdx.x == 0) {
        unsigned* bar = b.bar;
        __builtin_amdgcn_s_waitcnt(0);
        unsigned nloc = b.st[0], nx = b.st[1];
        if (nloc == 0u) { xcd_barrier_complete(bar, b.x, nloc, nx); b.st[0] = nloc; b.st[1] = nx; }
        const unsigned old = xb_add(&bar[XB_XSUB(b.x)], 1u);
        const unsigned gen = old / nloc;
        if (old + 1u == (gen + 1u) * nloc) {
            __builtin_amdgcn_fence(__ATOMIC_RELEASE, "agent");
            asm volatile("s_waitcnt vmcnt(0)" ::: "memory");
            const unsigned og = xb_add(&bar[XB_TOP], 1u);
            const unsigned tg = og / nx;
            if (og + 1u == (tg + 1u) * nx) xb_add(&bar[XB_TOPGEN], 1u);
            else XB_SPIN(xb_ld(&bar[XB_TOPGEN]) == tg, bar);
            __builtin_amdgcn_fence(__ATOMIC_ACQUIRE, "agent");
            xb_add(&bar[XB_XGEN(b.x)], 1u);
            asm volatile("s_waitcnt vmcnt(0)" ::: "memory");
        } else {
            XB_SPIN(xb_ld(&bar[XB_XGEN(b.x)]) == gen, bar);
            __builtin_amdgcn_fence(__ATOMIC_ACQUIRE, "agent");
            asm volatile("s_waitcnt vmcnt(0)" ::: "memory");
        }
    }
    __syncthreads();
}

constexpr int NWAVES = 8;
constexpr int BATCH = 8, SEQ = 4096, D = 1024, T = BATCH * SEQ, DEPTH = 2;
constexpr int DCONV = 512, NHEAD = 8, HD = 64, DATTN = 512, DFF = 2816, NEXP = 8, DFFE = 2048;
constexpr int NIN = 5120, NPA = 1536, NQK = 1024, NGT = 2048, NPROJ = NPA + NQK + NGT;
constexpr float EPS = 1e-6f;
constexpr float QSCALE = 0.125f * 1.4426950408889634f;
constexpr int MPAD = 2 * T + NEXP * 256;
constexpr int VTP = T + 64;

constexpr size_t MiB = 1u << 20;
constexpr size_t WS_CTL = 0, CTL_ZERO_BYTES = 1 * MiB;
constexpr size_t WS_ROUTE = 1 * MiB;
constexpr size_t WS_SLOTS = WS_ROUTE + 512 * 1024, WS_WGCNT = WS_ROUTE + 768 * 1024;
constexpr size_t WS_WL = 4 * MiB, WL_STRIDE = 14 * MiB;
constexpr size_t WL_WIN = 0, WL_WV = 9 * MiB, WL_WA = 10 * MiB, WL_WB = 11 * MiB, WL_WO = 12 * MiB;
constexpr size_t WS_WGU = 32 * MiB, WS_WD = 43 * MiB;
constexpr size_t WS_H = 50 * MiB;
constexpr size_t WS_UA = WS_H, WS_UB = WS_H + 32 * MiB;
constexpr size_t WS_VT = 114 * MiB;
constexpr size_t WS_GT = 146 * MiB;
constexpr size_t WS_PA = 274 * MiB;
constexpr size_t WS_QF = WS_PA + 96 * MiB, WS_KF = WS_PA + 128 * MiB;
constexpr size_t WS_TMP = 274 * MiB, WS_MIX = 338 * MiB;
constexpr size_t WS_G0 = 146 * MiB;
constexpr size_t WS_WEG = 4 * MiB, WS_WED = 36 * MiB;
constexpr size_t WS_HP = 52 * MiB;
constexpr size_t WS_G1 = 118 * MiB;
constexpr size_t WS_Y = 250 * MiB;
constexpr float WSCALE = 32.f, GSCALE = 8.f;
constexpr size_t WS_END = 512 * MiB;
static_assert(WS_G1 + (size_t)MPAD * DFFE <= WS_Y && WS_HP + (size_t)MPAD * D <= WS_G1 && WS_Y + (size_t)MPAD * D * 2 <= WS_END && WS_KF + 32 * MiB <= WS_END, "d_ws map");
constexpr int CW_TMO = 0, CW_CODE = 1, CW_BAR = 4096, CW_CNT = 8192;

constexpr int RING_OFF = 0, RING_BYTES = 131072, LDSCTL_OFF = RING_BYTES, MISC_OFF = LDSCTL_OFF + 320, LDS_BYTES = 147456;

typedef unsigned u32x2v __attribute__((ext_vector_type(2)));
__device__ __forceinline__ float wave_sum(float v) {
#pragma unroll
    for (int o = 1; o < 64; o <<= 1) v += __shfl_xor(v, o);
    return v;
}
using pg8::cvt_pk_bf16;
__device__ __forceinline__ void tr_block(const float* W, int K, int N, bf16* dst, int drow, int k0, int n0, LAS float* scr, int lane) {
    { f32x4 t[8];
#pragma unroll
      for (int i = 0; i < 8; ++i) t[i] = *(const GAS f32x4*)(W + (size_t)(k0 + 8 * i + (lane >> 3)) * N + n0 + 4 * (lane & 7));
#pragma unroll
      for (int i = 0; i < 8; ++i) { LAS float* p = scr + (8 * i + (lane >> 3)) * 33 + 4 * (lane & 7); p[0] = t[i].x; p[1] = t[i].y; p[2] = t[i].z; p[3] = t[i].w; } }
    LDS_WAIT(); asm volatile("" ::: "memory");
    const int c = lane & 7;
#pragma unroll
    for (int j = 0; j < 4; ++j) { const int n = (lane >> 3) + 8 * j; const LAS float* s = scr + (8 * c) * 33 + n;
        v4u o; o.x = cvt_pk_bf16(s[0 * 33], s[1 * 33]); o.y = cvt_pk_bf16(s[2 * 33], s[3 * 33]); o.z = cvt_pk_bf16(s[4 * 33], s[5 * 33]); o.w = cvt_pk_bf16(s[6 * 33], s[7 * 33]);
        *(GAS v4u*)(dst + (size_t)(drow + n) * K + k0 + 8 * c) = o; }
    LDS_WAIT(); asm volatile("" ::: "memory");
}
__device__ __forceinline__ void tr_block8(const float* W, int K, int N, unsigned char* dst, int drow, int k0, int n0, float sc, LAS float* scr, int lane) {
    { f32x4 t[8];
#pragma unroll
      for (int i = 0; i < 8; ++i) t[i] = *(const GAS f32x4*)(W + (size_t)(k0 + 8 * i + (lane >> 3)) * N + n0 + 4 * (lane & 7));
#pragma unroll
      for (int i = 0; i < 8; ++i) { LAS float* p = scr + (8 * i + (lane >> 3)) * 33 + 4 * (lane & 7); p[0] = t[i].x; p[1] = t[i].y; p[2] = t[i].z; p[3] = t[i].w; } }
    LDS_WAIT(); asm volatile("" ::: "memory");
    const int c = lane & 7;
#pragma unroll
    for (int j = 0; j < 4; ++j) { const int n = (lane >> 3) + 8 * j; const LAS float* s = scr + (8 * c) * 33 + n;
        u32x2v o; o.x = pg8::pk4_fp8(s[0 * 33] * sc, s[1 * 33] * sc, s[2 * 33] * sc, s[3 * 33] * sc); o.y = pg8::pk4_fp8(s[4 * 33] * sc, s[5 * 33] * sc, s[6 * 33] * sc, s[7 * 33] * sc);
        *(GAS u32x2v*)(dst + (size_t)(drow + n) * K + k0 + 8 * c) = o; }
    LDS_WAIT(); asm volatile("" ::: "memory");
}
template <int KIND> __device__ __forceinline__ void tr_item8(const float* W, int K, int N, unsigned char* dst, float sc, LAS float* scr, int item, int lane) {
    const int nblk = N / 32, kb = item / nblk, nb = item % nblk, k0 = 64 * kb, n0 = 32 * nb;
    int drow = n0;
    if (KIND == 2) drow = 256 * (n0 / 128) + (n0 % 128);
    if (KIND == 3) drow = 256 * (n0 / 128) + 128 + (n0 % 128);
    tr_block8(W, K, N, dst, drow, k0, n0, sc, scr, lane);
}
template <int KIND> __device__ __forceinline__ void tr_item(const float* W, int K, int N, bf16* dst, bf16* dst2, LAS float* scr, int item, int lane) {
    const int nblk = N / 32, kb = item / nblk, nb = item % nblk, k0 = 64 * kb, n0 = 32 * nb;
    bf16* d = dst; int drow = n0;
    if (KIND == 1) { if (n0 >= 3072) drow = n0 - 512; else if (n0 >= 2560) { d = dst2; drow = n0 - 2560; } }
    if (KIND == 2) drow = 256 * (n0 / 128) + (n0 % 128);
    if (KIND == 3) drow = 256 * (n0 / 128) + 128 + (n0 % 128);
    tr_block(W, K, N, d, drow, k0, n0, scr, lane);
}
__device__ __forceinline__ void rms_row_to_bf16(const float* xrow, const float* g, bf16* orow, int lane) {
    const GAS f32x4* xr = (const GAS f32x4*)xrow + lane; const GAS f32x4* gr = (const GAS f32x4*)g + lane;
    f32x4 v[4]; float s = 0.f;
#pragma unroll
    for (int j = 0; j < 4; ++j) { v[j] = xr[64 * j]; s += (v[j].x * v[j].x + v[j].y * v[j].y) + (v[j].z * v[j].z + v[j].w * v[j].w); }
    const float rstd = 1.0f / sqrtf(wave_sum(s) * (1.f / D) + EPS);
    GAS u32x2v* o8 = (GAS u32x2v*)orow + lane;
#pragma unroll
    for (int j = 0; j < 4; ++j) { const f32x4 gg = gr[64 * j]; u32x2v w; w.x = cvt_pk_bf16(v[j].x * rstd * gg.x, v[j].y * rstd * gg.y); w.y = cvt_pk_bf16(v[j].z * rstd * gg.z, v[j].w * rstd * gg.w); o8[64 * j] = w; }
}
__device__ __forceinline__ void rms_row_to_fp8(const float* xrow, const float* g, unsigned char* orow, int lane) {
    const GAS f32x4* xr = (const GAS f32x4*)xrow + lane; const GAS f32x4* gr = (const GAS f32x4*)g + lane;
    f32x4 v[4]; float s = 0.f;
#pragma unroll
    for (int j = 0; j < 4; ++j) { v[j] = xr[64 * j]; s += (v[j].x * v[j].x + v[j].y * v[j].y) + (v[j].z * v[j].z + v[j].w * v[j].w); }
    const float rstd = 1.0f / sqrtf(wave_sum(s) * (1.f / D) + EPS);
    GAS unsigned* o4 = (GAS unsigned*)orow + lane;
#pragma unroll
    for (int j = 0; j < 4; ++j) { const f32x4 gg = gr[64 * j]; o4[64 * j] = pg8::pk4_fp8(v[j].x * rstd * gg.x, v[j].y * rstd * gg.y, v[j].z * rstd * gg.z, v[j].w * rstd * gg.w); }
}
__device__ __forceinline__ void unpack8f(const v4u w, float (&f)[8]) {
    f[0] = __builtin_bit_cast(float, w.x << 16); f[1] = __builtin_bit_cast(float, w.x & 0xffff0000u); f[2] = __builtin_bit_cast(float, w.y << 16); f[3] = __builtin_bit_cast(float, w.y & 0xffff0000u);
    f[4] = __builtin_bit_cast(float, w.z << 16); f[5] = __builtin_bit_cast(float, w.z & 0xffff0000u); f[6] = __builtin_bit_cast(float, w.w << 16); f[7] = __builtin_bit_cast(float, w.w & 0xffff0000u);
}
__device__ __forceinline__ v4u pack8f(const float (&f)[8]) { v4u w; w.x = cvt_pk_bf16(f[0], f[1]); w.y = cvt_pk_bf16(f[2], f[3]); w.z = cvt_pk_bf16(f[4], f[5]); w.w = cvt_pk_bf16(f[6], f[7]); return w; }

__device__ __forceinline__ void conv_phase(const bf16* PA, const float* cw, bf16* UA, int gid, int nthr) {
    for (int it = gid; it < (T / 16) * 64; it += nthr) {
        const int cg = it & 63, t0 = (it >> 6) * 16, c0 = cg * 8;
        float w0[8], w1[8], w2[8];
#pragma unroll
        for (int i = 0; i < 8; ++i) { w0[i] = cw[c0 + i]; w1[i] = cw[DCONV + c0 + i]; w2[i] = cw[2 * DCONV + c0 + i]; }
        float um2[8], um1[8];
        if ((t0 & (SEQ - 1)) == 0) {
#pragma unroll
            for (int i = 0; i < 8; ++i) { um2[i] = 0.f; um1[i] = 0.f; }
        } else {
            float a[8], b[8];
            unpack8f(*(const GAS v4u*)(PA + (size_t)(t0 - 2) * NPA + c0), a); unpack8f(*(const GAS v4u*)(PA + (size_t)(t0 - 2) * NPA + 1024 + c0), b);
#pragma unroll
            for (int i = 0; i < 8; ++i) um2[i] = a[i] * b[i];
            unpack8f(*(const GAS v4u*)(PA + (size_t)(t0 - 1) * NPA + c0), a); unpack8f(*(const GAS v4u*)(PA + (size_t)(t0 - 1) * NPA + 1024 + c0), b);
#pragma unroll
            for (int i = 0; i < 8; ++i) um1[i] = a[i] * b[i];
        }
#pragma unroll 4
        for (int r = 0; r < 16; ++r) {
            const bf16* row = PA + (size_t)(t0 + r) * NPA + c0;
            float xin[8], bg[8], cgv[8], o[8];
            unpack8f(*(const GAS v4u*)(row), xin); unpack8f(*(const GAS v4u*)(row + 512), bg); unpack8f(*(const GAS v4u*)(row + 1024), cgv);
#pragma unroll
            for (int i = 0; i < 8; ++i) { const float u = cgv[i] * xin[i]; o[i] = bg[i] * (w0[i] * um2[i] + w1[i] * um1[i] + w2[i] * u); um2[i] = um1[i]; um1[i] = u; }
            *(GAS v4u*)(UA + (size_t)(t0 + r) * DCONV + c0) = pack8f(o);
        }
    }
}

typedef float f32x16 __attribute__((ext_vector_type(16)));
__device__ __forceinline__ void attn_mfma(const bf16* QF, const bf16* KF, const bf16* VF, bf16* UB, int gw, int NGW, int lane) {
    const int q = lane & 31, hh = lane >> 5;
    constexpr int NU = BATCH * NHEAD * (SEQ / 32);
    bf16x8 qf[4];
    if (gw < NU) {
        const size_t o = (size_t)gw * 2048 + lane * 8;
#pragma unroll
        for (int i = 0; i < 4; ++i) qf[i] = *(const GAS bf16x8*)(QF + o + i * 512);
    }
#pragma unroll 1
    for (int u = gw; u < NU; u += NGW) {
        const int qb = u & 127, bh = u >> 7, h = bh & 7, b = bh >> 3;
        const size_t rowb = (size_t)b * SEQ;
        const bf16* const kbase = KF + (size_t)(bh * 128) * 2048 + lane * 8;
        const bf16* const vbase = VF + (size_t)(bh * 128) * 2048 + lane * 8;
        bf16x8 k0[4], v0[4], k1[4], v1[4], k2[4], v2[4];
        auto fill = [&](bf16x8 (&KB)[4], bf16x8 (&VB)[4], int kbn) __attribute__((always_inline)) {
            kbn = kbn > 0 ? kbn : 0;
            const bf16* kp = kbase + (size_t)kbn * 2048; const bf16* vp = vbase + (size_t)kbn * 2048;
#pragma unroll
            for (int i = 0; i < 4; ++i) { KB[i] = *(const GAS bf16x8*)(kp + i * 512); VB[i] = *(const GAS bf16x8*)(vp + i * 512); }
        };
        fill(k0, v0, qb); fill(k1, v1, qb - 1); fill(k2, v2, qb - 2);
        bf16x8 qN[4];
        {
            const int un = (u + NGW < NU) ? u + NGW : u; const size_t o = (size_t)un * 2048 + lane * 8;
#pragma unroll
            for (int i = 0; i < 4; ++i) qN[i] = *(const GAS bf16x8*)(QF + o + i * 512);
        }
        __builtin_amdgcn_sched_barrier(0);
        f32x16 o0, o1;
#pragma unroll
        for (int r = 0; r < 16; ++r) { o0[r] = 0.f; o1[r] = 0.f; }
        float R = 1.f;
        const bf16x8 (&qfr)[4] = qf;
        auto block = [&](bf16x8 (&KB)[4], bf16x8 (&VB)[4], const int kb) __attribute__((always_inline)) -> bool {
            f32x16 p;
#pragma unroll
            for (int r = 0; r < 16; ++r) p[r] = 0.f;
#pragma unroll
            for (int d0 = 0; d0 < 4; ++d0) p = __builtin_amdgcn_mfma_f32_32x32x16_bf16(KB[d0], qfr[d0], p, 0, 0, 0);
            float rr[16];
            const bool diag = (kb == qb);
#pragma unroll
            for (int r = 0; r < 16; ++r) {
                float e = __builtin_amdgcn_exp2f(p[r]);
                if (diag) { const int kl = (r & 7) + 8 * hh + 16 * (r >> 3); e = (kl < q) ? e : 0.f; }
                rr[r] = __builtin_amdgcn_rcpf(1.0f + e);
            }
            bf16x8 af[2];
#pragma unroll
            for (int s = 1; s >= 0; --s) {
                float g = rr[8 * s];
#pragma unroll
                for (int j = 1; j < 8; ++j) g *= rr[8 * s + j];
                const auto sw = __builtin_amdgcn_permlane32_swap(__float_as_uint(g), __float_as_uint(g), false, false);
                const float g_lo = __uint_as_float(sw[0]), g_hi = __uint_as_float(sw[1]);
                float c = hh ? R : R * g_hi;
                float a[8];
#pragma unroll
                for (int j = 7; j >= 0; --j) { const float cn = c * rr[8 * s + j]; a[j] = c - cn; c = cn; }
                R = R * (g_lo * g_hi);
                typedef unsigned u4 __attribute__((ext_vector_type(4)));
                u4 w; w.x = cvt_pk_bf16(a[0], a[1]); w.y = cvt_pk_bf16(a[2], a[3]); w.z = cvt_pk_bf16(a[4], a[5]); w.w = cvt_pk_bf16(a[6], a[7]);
                af[s] = __builtin_bit_cast(bf16x8, w);
            }
            o0 = __builtin_amdgcn_mfma_f32_32x32x16_bf16(VB[0], af[0], o0, 0, 0, 0);
            o0 = __builtin_amdgcn_mfma_f32_32x32x16_bf16(VB[1], af[1], o0, 0, 0, 0);
            o1 = __builtin_amdgcn_mfma_f32_32x32x16_bf16(VB[2], af[0], o1, 0, 0, 0);
            o1 = __builtin_amdgcn_mfma_f32_32x32x16_bf16(VB[3], af[1], o1, 0, 0, 0);
            if (kb == 0 || __builtin_amdgcn_ballot_w64(R != 0.f) == 0ull) return true;
            fill(KB, VB, kb - 3);
            __builtin_amdgcn_sched_barrier(0);
            return false;
        };
#pragma unroll 1
        for (int kb = qb;; kb -= 3) {
            if (block(k0, v0, kb)) break;
            if (block(k1, v1, kb - 1)) break;
            if (block(k2, v2, kb - 2)) break;
        }
        bf16* op = UB + (rowb + 32 * qb + q) * DATTN + h * 64 + 4 * hh;
#pragma unroll
        for (int g4 = 0; g4 < 4; ++g4) {
            u32x2v w0, w1;
            w0.x = cvt_pk_bf16(o0[4 * g4], o0[4 * g4 + 1]); w0.y = cvt_pk_bf16(o0[4 * g4 + 2], o0[4 * g4 + 3]);
            w1.x = cvt_pk_bf16(o1[4 * g4], o1[4 * g4 + 1]); w1.y = cvt_pk_bf16(o1[4 * g4 + 2], o1[4 * g4 + 3]);
            *(GAS u32x2v*)(op + 8 * g4) = w0; *(GAS u32x2v*)(op + 32 + 8 * g4) = w1;
        }
#pragma unroll
        for (int i = 0; i < 4; ++i) qf[i] = qN[i];
    }
}

#ifndef FFN8
#define FFN8 0
#endif
#ifndef REP_P0
#define REP_P0 1
#endif
#ifndef REP_P1
#define REP_P1 1
#endif
#ifndef REP_P2
#define REP_P2 1
#endif
#ifndef REP_ATT
#define REP_ATT 1
#endif
#ifndef REP_R1A
#define REP_R1A 1
#endif
struct Args { const float* in[16]; float* out; unsigned char* ws; };
typedef const __attribute__((address_space(4))) Args* KArgP;
__device__ __forceinline__ KArgP launder_k(KArgP p) { asm volatile("" : "+s"(p)); return p; }
__device__ __forceinline__ int launder_s(int v) { asm volatile("" : "+s"(v)); return v; }
__device__ __forceinline__ int launder_v(int v) { asm volatile("" : "+v"(v)); return v; }
#ifndef STG_TICKS
#define STG_TICKS 150
#endif
__device__ __forceinline__ void stagger(int bx) { const unsigned long long t0 = __builtin_amdgcn_s_memrealtime(); const unsigned long long want = (unsigned long long)(((bx >> 3) & 3) * STG_TICKS); while (__builtin_amdgcn_s_memrealtime() - t0 < want) __builtin_amdgcn_s_sleep(2); }
#define PH_BEGIN { const KArgP ap = launder_k(kp0); unsigned char* const ws = ap->ws; const int bx = launder_s(bx0), G = launder_s(G0); const int tid = launder_v(tid0), lane = tid & 63, wave = __builtin_amdgcn_readfirstlane(tid >> 6); \
    const int gid = bx * (NWAVES * 64) + tid, nthr = G * NWAVES * 64, gw = bx * NWAVES + wave, NGW = G * NWAVES; (void)gid; (void)nthr; (void)gw; (void)NGW; (void)lane; \
    LAS float* const scr = (LAS float*)(lds + RING_OFF + wave * 16384); (void)scr; (void)ws;
#define PH_END(BARRIER) if (BARRIER) xcd_barrier(bar); }
#define WSP(T_, off) ((T_*)(ws + (off)))

__global__ void __launch_bounds__(NWAVES * 64, 2) mega_fwd(Args args) {
    extern __shared__ __attribute__((aligned(16))) unsigned char lds_raw[];
    LAS unsigned char* const lds = (LAS unsigned char*)lds_raw;
    volatile LAS unsigned* const MISC = (volatile LAS unsigned*)(lds + MISC_OFF);
    const KArgP kp0 = (KArgP)__builtin_amdgcn_kernarg_segment_ptr();
    const int tid0 = threadIdx.x, G0 = gridDim.x, bx0 = blockIdx.x;
    for (int u = tid0; u < (LDS_BYTES - LDSCTL_OFF) / 4; u += NWAVES * 64) ((LAS unsigned*)(lds + LDSCTL_OFF))[u] = 0u;
    __syncthreads();
#ifdef PROBE_CLK
    long long probe_cycles = 0;
#endif
    XcdBarrier bar = xcd_barrier_post((unsigned*)(args.ws + WS_CTL) + CW_BAR, MISC + 8);

#pragma unroll 1
    for (int rep = 0; rep < REP_P0; ++rep)
    PH_BEGIN
        constexpr int I_IN = 16 * 160, I_BR = 8 * 32, I_O = 16 * 32, I_GU = 16 * 88, I_D = 44 * 32;
        constexpr int PER_L = I_IN + 2 * I_BR + I_O, NITEMS = 2 * PER_L + 2 * I_GU + I_D;
#pragma unroll 1
        for (int it = gw; it < NITEMS; it += NGW) {
            int r = it;
            if (r < 2 * PER_L) {
                const int l = r / PER_L; r -= l * PER_L; unsigned char* wl = ws + WS_WL + (size_t)l * WL_STRIDE;
                if (r < I_IN) { tr_item<1>(ap->in[2] + (size_t)l * D * NIN, D, NIN, (bf16*)(wl + WL_WIN), (bf16*)(wl + WL_WV), scr, r, lane); continue; } r -= I_IN;
                if (r < I_BR) { tr_item<0>(ap->in[4] + (size_t)l * DCONV * D, DCONV, D, (bf16*)(wl + WL_WA), nullptr, scr, r, lane); continue; } r -= I_BR;
                if (r < I_BR) { tr_item<0>(ap->in[5] + (size_t)l * DATTN * D, DATTN, D, (bf16*)(wl + WL_WB), nullptr, scr, r, lane); continue; } r -= I_BR;
                tr_item<0>(ap->in[6] + (size_t)l * D * D, D, D, (bf16*)(wl + WL_WO), nullptr, scr, r, lane); continue;
            }
            r -= 2 * PER_L;
#if FFN8
            if (r < I_GU) { tr_item8<2>(ap->in[8], D, DFF, WSP(unsigned char, WS_WGU), WSCALE, scr, r, lane); continue; } r -= I_GU;
            if (r < I_GU) { tr_item8<3>(ap->in[9], D, DFF, WSP(unsigned char, WS_WGU), WSCALE, scr, r, lane); continue; } r -= I_GU;
            tr_item8<0>(ap->in[10], DFF, D, WSP(unsigned char, WS_WD), WSCALE, scr, r, lane);
#else
            if (r < I_GU) { tr_item<2>(ap->in[8], D, DFF, WSP(bf16, WS_WGU), nullptr, scr, r, lane); continue; } r -= I_GU;
            if (r < I_GU) { tr_item<3>(ap->in[9], D, DFF, WSP(bf16, WS_WGU), nullptr, scr, r, lane); continue; } r -= I_GU;
            tr_item<0>(ap->in[10], DFF, D, WSP(bf16, WS_WD), nullptr, scr, r, lane);
#endif
        }
#pragma unroll 1
        for (int m = gw; m < T; m += NGW) rms_row_to_bf16(ap->in[0] + (size_t)m * D, ap->in[1], WSP(bf16, WS_H) + (size_t)m * D, lane);
    PH_END(true)

#pragma unroll 1
    for (int l = 0; l < DEPTH; ++l) {
#pragma unroll 1
        for (int rep = 0; rep < REP_P1; ++rep) {
        PH_BEGIN
            unsigned char* wl = ws + WS_WL + (size_t)l * WL_STRIDE;
            pg8::Gemm g{WSP(bf16, WS_H), (const bf16*)(wl + WL_WIN), T, NPROJ, D}; pg8::StaticOrder S; S.init(T, NPROJ, G, bx);
#ifdef PROBE_NULL
            if (rep == 0) { pg8::EpiNull E0; pg8::gemm_phase<pg8::EpiNull, pg8::StaticOrder, true, true>(lds + RING_OFF, g, S, E0, tid); } else
#endif
#ifdef PROBE_L2
            if (rep == 0) { pg8::EpiL2 E0{WSP(bf16, 440 * MiB), bx}; pg8::gemm_phase<pg8::EpiL2, pg8::StaticOrder, true, true>(lds + RING_OFF, g, S, E0, tid); } else
#endif
            {
#ifdef PROBE_CLK
            long long c0_ = clock64();
#endif
            pg8::EpiProj E{WSP(bf16, WS_PA), WSP(bf16, WS_QF), WSP(bf16, WS_KF), WSP(bf16, WS_GT), QSCALE};
            pg8::gemm_phase<pg8::EpiProj, pg8::StaticOrder, true, true>(lds + RING_OFF, g, S, E, tid);
#ifdef PROBE_CLK
            if (l == 0) probe_cycles = clock64() - c0_;
#endif
            }
        PH_END(false)
        PH_BEGIN
            unsigned char* wl = ws + WS_WL + (size_t)l * WL_STRIDE;
            pg8::Gemm g{(const bf16*)(wl + WL_WV), WSP(bf16, WS_H), DATTN, T, D}; pg8::StaticOrder S; S.init(DATTN, T, G, bx);
#ifdef PROBE_NULL
            if (rep == 0) { pg8::EpiNull E0; pg8::gemm_phase<pg8::EpiNull, pg8::StaticOrder, true, true>(lds + RING_OFF, g, S, E0, tid); } else
#endif
#ifdef PROBE_L2
            if (rep == 0) { pg8::EpiL2 E0{WSP(bf16, 440 * MiB), bx}; pg8::gemm_phase<pg8::EpiL2, pg8::StaticOrder, true, true>(lds + RING_OFF, g, S, E0, tid); } else
#endif
            { pg8::EpiVT E{WSP(bf16, WS_VT)};
            pg8::gemm_phase<pg8::EpiVT, pg8::StaticOrder, true, true>(lds + RING_OFF, g, S, E, tid); }
        PH_END(true)
        }
#pragma unroll 1
        for (int rep = 0; rep < REP_P2; ++rep) {
        PH_BEGIN
            conv_phase(WSP(bf16, WS_PA), ap->in[3] + (size_t)l * 3 * DCONV, WSP(bf16, WS_UA), gid, nthr);
        PH_END(false)
#pragma unroll 1
        for (int rep2 = 0; rep2 < REP_ATT; ++rep2) {
        PH_BEGIN
            attn_mfma(WSP(bf16, WS_QF), WSP(bf16, WS_KF), WSP(bf16, WS_VT), WSP(bf16, WS_UB), gw, NGW, lane);
        PH_END(rep2 == REP_ATT - 1)
        }
        }
        PH_BEGIN
            unsigned char* wl = ws + WS_WL + (size_t)l * WL_STRIDE;
            pg8::Gemm g{WSP(bf16, WS_UA), (const bf16*)(wl + WL_WA), T, D, DCONV}; pg8::StaticOrder S; S.init(T, D, G, bx);
            pg8::EpiGateA E{WSP(bf16, WS_GT), WSP(bf16, WS_TMP)};
            pg8::gemm_phase<pg8::EpiGateA, pg8::StaticOrder, true, true>(lds + RING_OFF, g, S, E, tid);
        PH_END(false)
        PH_BEGIN
            unsigned char* wl = ws + WS_WL + (size_t)l * WL_STRIDE;
            pg8::Gemm g{WSP(bf16, WS_UB), (const bf16*)(wl + WL_WB), T, D, DATTN}; pg8::StaticOrder S; S.init(T, D, G, bx);
            pg8::EpiGateB E{WSP(bf16, WS_GT), WSP(bf16, WS_TMP), WSP(bf16, WS_MIX)};
            pg8::gemm_phase<pg8::EpiGateB, pg8::StaticOrder, true, true>(lds + RING_OFF, g, S, E, tid);
        PH_END(true)
        PH_BEGIN
            unsigned char* wl = ws + WS_WL + (size_t)l * WL_STRIDE;
            pg8::Gemm g{WSP(bf16, WS_MIX), (const bf16*)(wl + WL_WO), T, D, D}; pg8::StaticOrder S; S.init(T, D, G, bx);
            pg8::EpiRes E{l == 0 ? ap->in[0] : (const float*)ap->out, ap->out, D, 1.f};
            pg8::gemm_phase<pg8::EpiRes, pg8::StaticOrder, true, true>(lds + RING_OFF, g, S, E, tid);
        PH_END(true)
        if (l == 0) {
            PH_BEGIN
#pragma unroll 1
#if FFN8
                for (int m = gw; m < T; m += NGW) rms_row_to_fp8(ap->out + (size_t)m * D, ap->in[7], WSP(unsigned char, WS_H) + (size_t)m * D, lane);
#else
                for (int m = gw; m < T; m += NGW) rms_row_to_bf16(ap->out + (size_t)m * D, ap->in[7], WSP(bf16, WS_H) + (size_t)m * D, lane);
#endif
            PH_END(true)
            PH_BEGIN
#if FFN8
                pg8::Gemm g{WSP(bf16, WS_H), WSP(bf16, WS_WGU), T, 2 * DFF, D / 2}; pg8::StaticOrder S; S.init(T, 2 * DFF, G, bx);
                pg8::EpiSwiGLU8 E{WSP(unsigned char, WS_G0), DFF, 1.0f / WSCALE, GSCALE};
                pg8::gemm_phase<pg8::EpiSwiGLU8, pg8::StaticOrder, true, true, true>(lds + RING_OFF, g, S, E, tid);
#else
                pg8::Gemm g{WSP(bf16, WS_H), WSP(bf16, WS_WGU), T, 2 * DFF, D}; pg8::StaticOrder S; S.init(T, 2 * DFF, G, bx);
                pg8::EpiSwiGLU E{WSP(bf16, WS_G0), DFF};
                pg8::gemm_phase<pg8::EpiSwiGLU, pg8::StaticOrder, true, true>(lds + RING_OFF, g, S, E, tid);
#endif
            PH_END(true)
            PH_BEGIN
#if FFN8
                pg8::Gemm g{WSP(bf16, WS_G0), WSP(bf16, WS_WD), T, D, DFF / 2}; pg8::StaticOrder S; S.init(T, D, G, bx);
                pg8::EpiRes E{ap->out, ap->out, D, 1.0f / (WSCALE * GSCALE)};
                pg8::gemm_phase<pg8::EpiRes, pg8::StaticOrder, true, true, true>(lds + RING_OFF, g, S, E, tid);
#else
                pg8::Gemm g{WSP(bf16, WS_G0), WSP(bf16, WS_WD), T, D, DFF}; pg8::StaticOrder S; S.init(T, D, G, bx);
                pg8::EpiRes E{ap->out, ap->out, D, 1.f};
                pg8::gemm_phase<pg8::EpiRes, pg8::StaticOrder, true, true>(lds + RING_OFF, g, S, E, tid);
#endif
            PH_END(true)
            PH_BEGIN
#pragma unroll 1
                for (int m = gw; m < T; m += NGW) rms_row_to_bf16(ap->out + (size_t)m * D, ap->in[1] + D, WSP(bf16, WS_H) + (size_t)m * D, lane);
            PH_END(true)
        } else {
            volatile LAS int* const lcnt = (volatile LAS int*)(MISC + 32);
            volatile LAS unsigned* const loff = MISC + 16;
            volatile LAS int* const lbase = (volatile LAS int*)(MISC + 48);
#pragma unroll 1
            for (int rep = 0; rep < REP_R1A; ++rep)
            PH_BEGIN
                constexpr int I_E = 16 * 64;
#pragma unroll 1
                for (int it = gw; it < NEXP * 3 * I_E; it += NGW) {
                    const int e = it / (3 * I_E); int r = it - e * 3 * I_E;
                    if (r < I_E) { tr_item8<2>(ap->in[12] + (size_t)e * D * DFFE, D, DFFE, WSP(unsigned char, WS_WEG) + (size_t)e * 2 * DFFE * D, WSCALE, scr, r, lane); continue; } r -= I_E;
                    if (r < I_E) { tr_item8<3>(ap->in[13] + (size_t)e * D * DFFE, D, DFFE, WSP(unsigned char, WS_WEG) + (size_t)e * 2 * DFFE * D, WSCALE, scr, r, lane); continue; } r -= I_E;
                    tr_item8<0>(ap->in[14] + (size_t)e * DFFE * D, DFFE, D, WSP(unsigned char, WS_WED) + (size_t)e * D * DFFE, WSCALE, scr, r, lane);
                }
            PH_END(false)
            PH_BEGIN
                int4* route = WSP(int4, WS_ROUTE); int* wgcnt = WSP(int, WS_WGCNT); gu32* ctl = (gu32*)(ws + WS_CTL);
                const int rpw = T / G, r0 = bx * rpw, r1 = r0 + rpw;
                const float* xres = ap->out; const float* gf = ap->in[7] + D; const float* w_router = ap->in[11];
                if (tid < 8) lcnt[tid] = 0;
                __syncthreads();
#pragma unroll 1
                for (int m = r0 + wave; m < r1; m += NWAVES) {
                    const GAS f32x4* xr = (const GAS f32x4*)(xres + (size_t)m * D) + lane; const GAS f32x4* gr = (const GAS f32x4*)gf + lane;
                    f32x4 v[4]; float s = 0.f;
#pragma unroll
                    for (int j = 0; j < 4; ++j) { v[j] = xr[64 * j]; s += (v[j].x * v[j].x + v[j].y * v[j].y) + (v[j].z * v[j].z + v[j].w * v[j].w); }
                    const float rstd = 1.0f / sqrtf(wave_sum(s) * (1.f / D) + EPS);
                    float lg[8];
#pragma unroll
                    for (int e = 0; e < 8; ++e) lg[e] = 0.f;
#pragma unroll
                    for (int j = 0; j < 4; ++j) { const f32x4 gg = gr[64 * j];
#pragma unroll
                        for (int c = 0; c < 4; ++c) { const float hn = v[j][c] * rstd * gg[c]; const int i = 256 * j + 4 * lane + c;
                            const f32x4 wa = *(const GAS f32x4*)(w_router + (size_t)i * 8), wb = *(const GAS f32x4*)(w_router + (size_t)i * 8 + 4);
                            lg[0] += hn * wa.x; lg[1] += hn * wa.y; lg[2] += hn * wa.z; lg[3] += hn * wa.w; lg[4] += hn * wb.x; lg[5] += hn * wb.y; lg[6] += hn * wb.z; lg[7] += hn * wb.w; } }
#pragma unroll
                    for (int e = 0; e < 8; ++e) lg[e] = wave_sum(lg[e]);
                    int e1 = 0; float v1 = lg[0];
#pragma unroll
                    for (int e = 1; e < 8; ++e) if (lg[e] > v1) { v1 = lg[e]; e1 = e; }
                    int e2 = -1; float v2 = -INFINITY;
#pragma unroll
                    for (int e = 0; e < 8; ++e) if (e != e1 && lg[e] > v2) { v2 = lg[e]; e2 = e; }
                    if (e2 < 0) e2 = (e1 + 1) & 7;
                    const float ex = __expf(v2 - v1), w1 = 1.0f / (1.0f + ex), w2 = ex * w1;
                    if (lane == 0) { route[m] = make_int4(e1, e2, __float_as_int(w1), __float_as_int(w2)); atomicAdd((int*)(lcnt + e1), 1); atomicAdd((int*)(lcnt + e2), 1); }
                }
                __syncthreads();
                if (tid < 8) { const int c = lcnt[tid]; wgcnt[bx * 8 + tid] = c; __hip_atomic_fetch_add((unsigned*)(ctl + CW_CNT + tid), (unsigned)c, RLX_AGENT); }
            PH_END(true)
            PH_BEGIN
                int4* route = WSP(int4, WS_ROUTE); int2* slots = WSP(int2, WS_SLOTS); int* wgcnt = WSP(int, WS_WGCNT); gu32* ctl = (gu32*)(ws + WS_CTL); unsigned char* HP = WSP(unsigned char, WS_HP);
                const int rpw = T / G, r0 = bx * rpw, r1 = r0 + rpw;
                const float* xres = ap->out; const float* gf = ap->in[7] + D;
                { int s = 0; for (int w = lane; w < bx; w += 64) s += wgcnt[w * 8 + wave]; s = (int)wave_sum((float)s);
                  if (lane == 0) { lbase[wave] = s; lcnt[wave] = 0; } }
                if (tid == 0) { unsigned off = 0; for (int e = 0; e < 8; ++e) { loff[e] = off; off += (__hip_atomic_load((unsigned*)(ctl + CW_CNT + e), RLX_AGENT) + 255u) & ~255u; } loff[8] = off; }
                __syncthreads();
#pragma unroll 1
                for (int m = r0 + wave; m < r1; m += NWAVES) {
                    int s1 = 0, s2 = 0;
                    if (lane == 0) { const int4 rt = route[m]; s1 = (int)loff[rt.x] + lbase[rt.x] + atomicAdd((int*)(lcnt + rt.x), 1); s2 = (int)loff[rt.y] + lbase[rt.y] + atomicAdd((int*)(lcnt + rt.y), 1); slots[m] = make_int2(s1, s2); }
                    s1 = __builtin_amdgcn_readfirstlane(s1); s2 = __builtin_amdgcn_readfirstlane(s2);
                    const GAS f32x4* xr = (const GAS f32x4*)(xres + (size_t)m * D) + lane; const GAS f32x4* gr = (const GAS f32x4*)gf + lane;
                    f32x4 v[4]; float s = 0.f;
#pragma unroll
                    for (int j = 0; j < 4; ++j) { v[j] = xr[64 * j]; s += (v[j].x * v[j].x + v[j].y * v[j].y) + (v[j].z * v[j].z + v[j].w * v[j].w); }
                    const float rstd = 1.0f / sqrtf(wave_sum(s) * (1.f / D) + EPS);
                    GAS unsigned* o1 = (GAS unsigned*)(HP + (size_t)s1 * D) + lane; GAS unsigned* o2 = (GAS unsigned*)(HP + (size_t)s2 * D) + lane;
#pragma unroll
                    for (int j = 0; j < 4; ++j) { const f32x4 gg = gr[64 * j]; const unsigned w = pg8::pk4_fp8(v[j].x * rstd * gg.x, v[j].y * rstd * gg.y, v[j].z * rstd * gg.z, v[j].w * rstd * gg.w); o1[64 * j] = w; o2[64 * j] = w; }
                }
            PH_END(true)
            PH_BEGIN
                const int mrows = (int)loff[8];
                pg8::Gemm g{WSP(bf16, WS_HP), WSP(bf16, WS_WEG), mrows, 2 * DFFE, D / 2}; pg8::MoeOrder S; S.init(mrows, 2 * DFFE, G, bx); S.offs = loff; S.ntn = 2 * DFFE / 256;
                pg8::EpiSwiGLU8 E{WSP(unsigned char, WS_G1), DFFE, 1.0f / WSCALE, GSCALE};
                pg8::gemm_phase<pg8::EpiSwiGLU8, pg8::MoeOrder, true, true, true>(lds + RING_OFF, g, S, E, tid);
            PH_END(true)
            PH_BEGIN
                const int mrows = (int)loff[8];
                pg8::Gemm g{WSP(bf16, WS_G1), WSP(bf16, WS_WED), mrows, D, DFFE / 2}; pg8::MoeOrder S; S.init(mrows, D, G, bx); S.offs = loff; S.ntn = D / 256;
                pg8::EpiPlainS E{WSP(bf16, WS_Y), D, 1.0f / (WSCALE * GSCALE)};
                pg8::gemm_phase<pg8::EpiPlainS, pg8::MoeOrder, true, true, true>(lds + RING_OFF, g, S, E, tid);
            PH_END(true)
            PH_BEGIN
                const int4* route = WSP(int4, WS_ROUTE); const int2* slots = WSP(int2, WS_SLOTS); const bf16* HP = WSP(bf16, WS_Y); float* xres = ap->out; const float* g_final = ap->in[15];
#pragma unroll 1
                for (int m = gw; m < T; m += NGW) {
                    const int4 rt = route[m]; const int2 sl = slots[m]; const float w1 = __int_as_float(rt.z), w2 = __int_as_float(rt.w);
                    GAS f32x4* xr = (GAS f32x4*)(xres + (size_t)m * D) + lane; const GAS f32x4* gr = (const GAS f32x4*)g_final + lane;
                    const GAS u32x2v* y1 = (const GAS u32x2v*)(HP + (size_t)sl.x * D) + lane; const GAS u32x2v* y2 = (const GAS u32x2v*)(HP + (size_t)sl.y * D) + lane;
                    f32x4 v[4]; float s = 0.f;
#pragma unroll
                    for (int j = 0; j < 4; ++j) { v[j] = xr[64 * j]; const u32x2v a = y1[64 * j], b = y2[64 * j];
                        v[j].x += w1 * __builtin_bit_cast(float, a.x << 16) + w2 * __builtin_bit_cast(float, b.x << 16);
                        v[j].y += w1 * __builtin_bit_cast(float, a.x & 0xffff0000u) + w2 * __builtin_bit_cast(float, b.x & 0xffff0000u);
                        v[j].z += w1 * __builtin_bit_cast(float, a.y << 16) + w2 * __builtin_bit_cast(float, b.y << 16);
                        v[j].w += w1 * __builtin_bit_cast(float, a.y & 0xffff0000u) + w2 * __builtin_bit_cast(float, b.y & 0xffff0000u);
                        s += (v[j].x * v[j].x + v[j].y * v[j].y) + (v[j].z * v[j].z + v[j].w * v[j].w); }
                    const float rstd = 1.0f / sqrtf(wave_sum(s) * (1.f / D) + EPS);
#pragma unroll
                    for (int j = 0; j < 4; ++j) { const f32x4 gg = gr[64 * j]; xr[64 * j] = (f32x4){v[j].x * rstd * gg.x, v[j].y * rstd * gg.y, v[j].z * rstd * gg.z, v[j].w * rstd * gg.w}; }
                }
            PH_END(false)
        }
    }
#ifdef PROBE_CLK
    if (blockIdx.x == 0) { const unsigned long long t0_ = __builtin_amdgcn_s_memrealtime(); const unsigned long long want = (unsigned long long)(probe_cycles / 64); while (__builtin_amdgcn_s_memrealtime() - t0_ < want) __builtin_amdgcn_s_sleep(4); }
#endif
}

extern "C" void kernel_launch(void* const* d_in, const int* in_sizes, int n_in, void* d_out, int out_size, void* d_ws, size_t ws_size, hipStream_t stream) {
    static int grid = 0;
    if (grid == 0) {
        if (n_in != 16 || in_sizes[0] != T * D || out_size != T * D || ws_size < WS_END) { fprintf(stderr, "kernel_launch: unexpected shapes (n_in %d, in0 %d, out %d, ws %zu); nothing launched\n", n_in, n_in > 0 ? in_sizes[0] : -1, out_size, ws_size); grid = -1; return; }
        int dev = 0, cus = 0, per_cu = 0;
        if (hipGetDevice(&dev) != hipSuccess || hipDeviceGetAttribute(&cus, hipDeviceAttributeMultiprocessorCount, dev) != hipSuccess) { grid = -1; return; }
        if (hipFuncSetAttribute((const void*)mega_fwd, hipFuncAttributeMaxDynamicSharedMemorySize, LDS_BYTES) != hipSuccess) { fprintf(stderr, "kernel_launch: hipFuncSetAttribute failed\n"); grid = -1; return; }
        if (hipOccupancyMaxActiveBlocksPerMultiprocessor(&per_cu, (const void*)mega_fwd, NWAVES * 64, LDS_BYTES) != hipSuccess || per_cu < 1) { fprintf(stderr, "kernel_launch: occupancy query reports %d workgroups per CU\n", per_cu); }
        (void)hipGetLastError();
        grid = cus;
        while (grid > 1 && (T % grid) != 0) --grid;
    }
    if (grid < 0) return;
    if (hipMemsetAsync((char*)d_ws + WS_CTL, 0, CTL_ZERO_BYTES, stream) != hipSuccess) return;
    Args a{};
    for (int i = 0; i < 16; ++i) a.in[i] = (const float*)d_in[i];
    a.out = (float*)d_out; a.ws = (unsigned char*)d_ws;
    hipLaunchKernelGGL(mega_fwd, dim3(grid), dim3(NWAVES * 64), LDS_BYTES, stream, a);
}
```

```cpp
#include <hip/hip_runtime.h>
#include <cstdio>
#include <cstdint>
#include <cmath>
#ifndef PG8_RELAX
#define PG8_RELAX 1
#endif
namespace pg8 {
#define PG8_LAS __attribute__((address_space(3)))
typedef unsigned short bf16_t;
typedef short bf16x8 __attribute__((ext_vector_type(8)));
typedef float f32x4 __attribute__((ext_vector_type(4)));
typedef unsigned u32x4 __attribute__((ext_vector_type(4)));
constexpr int BM = 256, BK = 64, HALF = 128, HTB = HALF * BK * 2  , STAGE_BYTES = 8 * HTB, NXCD = 8, WGM = 8;

__host__ __device__ __forceinline__ int lds_byte(int r, int c) { const int st = (r >> 4) * 2 + (c >> 5), rr = r & 15, cc = c & 31, ob = rr * 64 + cc * 2; return st * 1024 + (ob ^ (((ob >> 9) & 1) << 5)); }
__host__ __device__ __forceinline__ void stage_rc(int b, int& R, int& C) { const int st = b / 1024, sb = b % 1024, swz = sb ^ (((sb >> 9) & 1) << 5); R = (st >> 1) * 16 + swz / 64; C = (st & 1) * 32 + (swz % 64) / 2; }
__host__ __device__ __forceinline__ int perm32(int rho) { const int n = rho >> 4, i = rho & 15; return 8 * (i >> 2) + 4 * n + (i & 3); }

struct Unit { int pm, pn, pb; };
struct Gemm { const bf16_t* A; const bf16_t* Bt; int M, N, K; };

struct StaticOrder {
    int nM, nN, nwg, G, c;
    __host__ __device__ void init(int M, int N, int G_, int c_) { nM = M / BM; nN = N / BM; nwg = nM * nN; G = G_; c = c_; }
    __host__ __device__ bool next(int i, Unit& u) const {
        const long L = (long)i * G + c; if (L >= nwg) return false;
        int wgid = (int)L; { const int q = nwg / NXCD, r = nwg % NXCD, xcd = wgid % NXCD, off = wgid / NXCD; wgid = (xcd < r ? xcd * (q + 1) : r * (q + 1) + (xcd - r) * q) + off; }
        const int nig = WGM * nN, gid = wgid / nig, fm = gid * WGM, gsz = (nM - fm) < WGM ? (nM - fm) : WGM;
        u.pm = fm + ((wgid % nig) % gsz); u.pn = (wgid % nig) / gsz; u.pb = u.pn; return true;
    }
    __device__ __forceinline__ void a_ready(const Unit&) const {}
    __device__ __forceinline__ void done(const Unit&) const {}
};

__device__ __forceinline__ unsigned cvt_pk_bf16(float lo, float hi) { unsigned r; asm volatile("v_cvt_pk_bf16_f32 %0, %1, %2" : "=v"(r) : "v"(lo), "v"(hi)); return r; }
typedef float f32x2 __attribute__((ext_vector_type(2)));

__device__ __forceinline__ float sigmoidf_fast(float x) { return __builtin_amdgcn_rcpf(1.0f + __builtin_amdgcn_exp2f(-1.4426950408889634f * x)); }
__device__ __forceinline__ float bf_lo(unsigned w) { return __builtin_bit_cast(float, w << 16); }
__device__ __forceinline__ float bf_hi(unsigned w) { return __builtin_bit_cast(float, w & 0xffff0000u); }
__device__ __forceinline__ void unpack8(const u32x4 w, float (&f)[8]) { f[0] = bf_lo(w.x); f[1] = bf_hi(w.x); f[2] = bf_lo(w.y); f[3] = bf_hi(w.y); f[4] = bf_lo(w.z); f[5] = bf_hi(w.z); f[6] = bf_lo(w.w); f[7] = bf_hi(w.w); }
__device__ __forceinline__ u32x4 pack8(const float (&f)[8]) { u32x4 w; w.x = cvt_pk_bf16(f[0], f[1]); w.y = cvt_pk_bf16(f[2], f[3]); w.z = cvt_pk_bf16(f[4], f[5]); w.w = cvt_pk_bf16(f[6], f[7]); return w; }

constexpr int XS_WAVE_BYTES = 2048;
__device__ __forceinline__ int xs_acc_off(int fr, int fq) { return fr * 64 + (((fq + fr) & 3) << 4); }
__device__ __forceinline__ int xs_lin_off(int lane) { const int r = lane >> 2, p = lane & 3; return r * 64 + (((p + r) & 3) << 4); }
typedef unsigned u32x2 __attribute__((ext_vector_type(2)));
__device__ __forceinline__ int xl_acc(int fr, int q) { return fr * 128 + (((q + fr) & 7) << 4); }
__device__ __forceinline__ int xl_lin(int lane, int t) { const int r = 8 * t + (lane >> 3), q = lane & 7; return r * 128 + (((q + r) & 7) << 4); }
struct EpiProj {
    static constexpr int NVMEM = 16;
    static constexpr bool PERM = true, AFTER_DRAIN = false;
    bf16_t* PA; bf16_t* QF; bf16_t* KF; bf16_t* GT; float qscale; PG8_LAS unsigned char* xs;
    __device__ __forceinline__ void operator()(const f32x4 (&acc)[2][2][4][2], const Unit& u, int wr, int wc, int fr, int fq) const {
        const int row0 = u.pm * BM + wr * 64 + fr;
        if (u.pn >= 6 && u.pn < 10) {
            const bool isq = u.pn < 8; const float sc = isq ? qscale : 1.f; bf16_t* base = isq ? QF : KF;
            const int hc0 = (u.pn - (isq ? 6 : 8)) * BM + wc * 64 + 8 * fq;
#pragma unroll
            for (int ai = 0; ai < 2; ++ai)
#pragma unroll
                for (int m = 0; m < 4; ++m) { const int row = row0 + ai * HALF + m * 16; const int b = row >> 12, t = row & 4095, blk = t >> 5, tl = t & 31;
                    const int li = isq ? tl : ((tl & 19) | ((tl & 4) << 1) | ((tl & 8) >> 1));
#pragma unroll
                    for (int bj = 0; bj < 2; ++bj) { const int hc = hc0 + bj * 32, h = hc >> 6, c = (hc & 63) >> 3, d0 = c >> 1, hg = c & 1;
                        const f32x4 v0 = acc[ai][bj][m][0] * sc, v1 = acc[ai][bj][m][1] * sc;
                        u32x4 w; w.x = cvt_pk_bf16(v0[0], v0[1]); w.y = cvt_pk_bf16(v0[2], v0[3]); w.z = cvt_pk_bf16(v1[0], v1[1]); w.w = cvt_pk_bf16(v1[2], v1[3]);
                        *(u32x4*)(base + ((((size_t)(b * 8 + h) * 128 + blk) * 4 + d0) * 64 + hg * 32 + li) * 8) = w; } }
            return;
        }
        bf16_t* base; int ldc, colt;
        if (u.pn < 6) { base = PA; ldc = 1536; colt = u.pn * BM; } else { base = GT; ldc = 2048; colt = (u.pn - 10) * BM; }
        const int lane = fr + 16 * fq;
        PG8_LAS unsigned char* xw = xs + (wr * 4 + wc) * XS_WAVE_BYTES;
        bf16_t* lbase = base + (size_t)(u.pm * BM + wr * 64 + (lane >> 3)) * ldc + colt + wc * 64 + (lane & 7) * 8;
#pragma unroll
        for (int ai = 0; ai < 2; ++ai)
#pragma unroll
            for (int m = 0; m < 4; ++m) {
#pragma unroll
                for (int bj = 0; bj < 2; ++bj) { const f32x4 v0 = acc[ai][bj][m][0], v1 = acc[ai][bj][m][1];
                    u32x4 w; w.x = cvt_pk_bf16(v0[0], v0[1]); w.y = cvt_pk_bf16(v0[2], v0[3]); w.z = cvt_pk_bf16(v1[0], v1[1]); w.w = cvt_pk_bf16(v1[2], v1[3]);
                    *(PG8_LAS u32x4*)(xw + xl_acc(fr, 4 * bj + fq)) = w; }
#pragma unroll
                for (int t = 0; t < 2; ++t) *(u32x4*)(lbase + (size_t)(ai * HALF + m * 16 + 8 * t) * ldc) = *(const PG8_LAS u32x4*)(xw + xl_lin(lane, t)); }
    }
};
struct EpiVT {
    static constexpr int NVMEM = 16;
    static constexpr bool PERM = true, AFTER_DRAIN = false;
    bf16_t* VF;
    __device__ __forceinline__ void operator()(const f32x4 (&acc)[2][2][4][2], const Unit& u, int wr, int wc, int fr, int fq) const {
        const int row0 = u.pm * BM + wr * 64 + fr, tok0 = u.pn * BM + wc * 64 + 8 * fq;
#pragma unroll
        for (int ai = 0; ai < 2; ++ai)
#pragma unroll
            for (int m = 0; m < 4; ++m) { const int hd = row0 + ai * HALF + m * 16, h = hd >> 6, dblk = (hd >> 5) & 1, dl = hd & 31;
#pragma unroll
                for (int bj = 0; bj < 2; ++bj) { const int tok = tok0 + bj * 32, b = tok >> 12, t = tok & 4095, blk = t >> 5, s = (t >> 4) & 1, hg = (t >> 3) & 1;
                    const f32x4 v0 = acc[ai][bj][m][0], v1 = acc[ai][bj][m][1];
                    u32x4 w; w.x = cvt_pk_bf16(v0[0], v0[1]); w.y = cvt_pk_bf16(v0[2], v0[3]); w.z = cvt_pk_bf16(v1[0], v1[1]); w.w = cvt_pk_bf16(v1[2], v1[3]);
                    *(u32x4*)(VF + ((((size_t)(b * 8 + h) * 128 + blk) * 4 + dblk * 2 + s) * 64 + hg * 32 + dl) * 8) = w; } }
    }
};
struct EpiPlain {
    static constexpr int NVMEM = 16;
    static constexpr bool PERM = true, AFTER_DRAIN = false;
    bf16_t* O; int ldc;
    __device__ __forceinline__ void operator()(const f32x4 (&acc)[2][2][4][2], const Unit& u, int wr, int wc, int fr, int fq) const {
        const int row0 = u.pm * BM + wr * 64 + fr, col0 = u.pn * BM + wc * 32 + 8 * fq;
#pragma unroll
        for (int ai = 0; ai < 2; ++ai)
#pragma unroll
            for (int m = 0; m < 4; ++m) { bf16_t* rowp = O + (size_t)(row0 + ai * HALF + m * 16) * ldc + col0;
#pragma unroll
                for (int bj = 0; bj < 2; ++bj) { const f32x4 v0 = acc[ai][bj][m][0], v1 = acc[ai][bj][m][1];
                    u32x4 w; w.x = cvt_pk_bf16(v0[0], v0[1]); w.y = cvt_pk_bf16(v0[2], v0[3]); w.z = cvt_pk_bf16(v1[0], v1[1]); w.w = cvt_pk_bf16(v1[2], v1[3]);
                    *(u32x4*)(rowp + bj * HALF) = w; } }
    }
};
struct EpiSwiGLU {
    static constexpr int NVMEM = 8;
    static constexpr bool PERM = true, AFTER_DRAIN = false;
    bf16_t* O; int ldc; PG8_LAS unsigned char* xs;
    __device__ __forceinline__ void operator()(const f32x4 (&acc)[2][2][4][2], const Unit& u, int wr, int wc, int fr, int fq) const {
        const int lane = fr + 16 * fq, lr = lane >> 2, lp = lane & 3, oa = xs_acc_off(fr, fq), ol = xs_lin_off(lane);
        PG8_LAS unsigned char* xw = xs + (wr * 4 + wc) * XS_WAVE_BYTES;
        bf16_t* lbase = O + (size_t)(u.pm * BM + wr * 64 + lr) * ldc + u.pn * HALF + wc * 32 + lp * 8;
#pragma unroll
        for (int ai = 0; ai < 2; ++ai)
#pragma unroll
            for (int mp = 0; mp < 2; ++mp) {
#pragma unroll
                for (int mm = 0; mm < 2; ++mm) { const int m = 2 * mp + mm; float o[8];
#pragma unroll
                    for (int n = 0; n < 2; ++n)
#pragma unroll
                        for (int i = 0; i < 4; ++i) { const float g = acc[ai][0][m][n][i], up = acc[ai][1][m][n][i]; o[4 * n + i] = g * sigmoidf_fast(g) * up; }
                    *(PG8_LAS u32x4*)(xw + mm * 1024 + oa) = pack8(o); }
#pragma unroll
                for (int mm = 0; mm < 2; ++mm) *(u32x4*)(lbase + (size_t)(ai * HALF + (2 * mp + mm) * 16) * ldc) = *(const PG8_LAS u32x4*)(xw + mm * 1024 + ol); }
    }
};
struct EpiGateA {
    static constexpr int NVMEM = 16;
    static constexpr bool PERM = true, AFTER_DRAIN = false;
    const bf16_t* GT; bf16_t* TMP; PG8_LAS unsigned char* xs;
    __device__ __forceinline__ void operator()(const f32x4 (&acc)[2][2][4][2], const Unit& u, int wr, int wc, int fr, int fq) const {
        const int lane = fr + 16 * fq;
        PG8_LAS unsigned char* xw = xs + (wr * 4 + wc) * XS_WAVE_BYTES;
        const size_t lrow = (size_t)(u.pm * BM + wr * 64 + (lane >> 3)); const int lcol = u.pn * BM + wc * 64 + (lane & 7) * 8;
#pragma unroll
        for (int ai = 0; ai < 2; ++ai)
#pragma unroll
            for (int m = 0; m < 4; ++m) { const size_t r = lrow + ai * HALF + m * 16;
#pragma unroll
                for (int t = 0; t < 2; ++t) *(PG8_LAS u32x4*)(xw + xl_lin(lane, t)) = *(const u32x4*)(GT + (r + 8 * t) * 2048 + lcol);
#pragma unroll
                for (int bj = 0; bj < 2; ++bj) { float g[8], o[8]; unpack8(*(const PG8_LAS u32x4*)(xw + xl_acc(fr, 4 * bj + fq)), g);
#pragma unroll
                    for (int n = 0; n < 2; ++n)
#pragma unroll
                        for (int i = 0; i < 4; ++i) o[4 * n + i] = sigmoidf_fast(g[4 * n + i]) * acc[ai][bj][m][n][i];
                    *(PG8_LAS u32x4*)(xw + xl_acc(fr, 4 * bj + fq)) = pack8(o); }
#pragma unroll
                for (int t = 0; t < 2; ++t) *(u32x4*)(TMP + (r + 8 * t) * 1024 + lcol) = *(const PG8_LAS u32x4*)(xw + xl_lin(lane, t)); }
    }
};
struct EpiGateB {
    static constexpr int NVMEM = 16;
    static constexpr bool PERM = true, AFTER_DRAIN = false;
    const bf16_t* GT; const bf16_t* TMP; bf16_t* MIX; PG8_LAS unsigned char* xs;
    __device__ __forceinline__ void operator()(const f32x4 (&acc)[2][2][4][2], const Unit& u, int wr, int wc, int fr, int fq) const {
        const int lane = fr + 16 * fq;
        PG8_LAS unsigned char* xw = xs + (wr * 4 + wc) * XS_WAVE_BYTES;
        const size_t lrow = (size_t)(u.pm * BM + wr * 64 + (lane >> 3)); const int lcol = u.pn * BM + wc * 64 + (lane & 7) * 8;
#pragma unroll
        for (int ai = 0; ai < 2; ++ai)
#pragma unroll
            for (int m = 0; m < 4; ++m) { const size_t r = lrow + ai * HALF + m * 16;
                u32x4 tl[2]; float g[2][8];
#pragma unroll
                for (int t = 0; t < 2; ++t) { *(PG8_LAS u32x4*)(xw + xl_lin(lane, t)) = *(const u32x4*)(GT + (r + 8 * t) * 2048 + 1024 + lcol); tl[t] = *(const u32x4*)(TMP + (r + 8 * t) * 1024 + lcol); }
#pragma unroll
                for (int bj = 0; bj < 2; ++bj) unpack8(*(const PG8_LAS u32x4*)(xw + xl_acc(fr, 4 * bj + fq)), g[bj]);
#pragma unroll
                for (int t = 0; t < 2; ++t) *(PG8_LAS u32x4*)(xw + xl_lin(lane, t)) = tl[t];
#pragma unroll
                for (int bj = 0; bj < 2; ++bj) { float tv[8], o[8]; unpack8(*(const PG8_LAS u32x4*)(xw + xl_acc(fr, 4 * bj + fq)), tv);
#pragma unroll
                    for (int n = 0; n < 2; ++n)
#pragma unroll
                        for (int i = 0; i < 4; ++i) o[4 * n + i] = tv[4 * n + i] + sigmoidf_fast(g[bj][4 * n + i]) * acc[ai][bj][m][n][i];
                    *(PG8_LAS u32x4*)(xw + xl_acc(fr, 4 * bj + fq)) = pack8(o); }
#pragma unroll
                for (int t = 0; t < 2; ++t) *(u32x4*)(MIX + (r + 8 * t) * 1024 + lcol) = *(const PG8_LAS u32x4*)(xw + xl_lin(lane, t)); }
    }
};
struct EpiRes {
    static constexpr int NVMEM = 32;
    static constexpr bool PERM = false, AFTER_DRAIN = false;
    const float* base; float* out; int ldc; float sc; PG8_LAS unsigned char* xs;
    __device__ __forceinline__ void operator()(const f32x4 (&acc)[2][2][4][2], const Unit& u, int wr, int wc, int fr, int fq) const {
        const int lane = fr + 16 * fq;
        PG8_LAS unsigned char* xw = xs + (wr * 4 + wc) * XS_WAVE_BYTES;
        const size_t loff = (size_t)(u.pm * BM + wr * 64 + (lane >> 3)) * ldc + u.pn * BM + wc * 64 + (lane & 7) * 4;
#pragma unroll
        for (int ai = 0; ai < 2; ++ai)
#pragma unroll
            for (int m = 0; m < 4; ++m)
#pragma unroll
                for (int bj = 0; bj < 2; ++bj) { const size_t o0 = loff + (size_t)(ai * HALF + m * 16) * ldc + bj * 32;
#pragma unroll
                    for (int t = 0; t < 2; ++t) *(PG8_LAS f32x4*)(xw + xl_lin(lane, t)) = *(const f32x4*)(base + o0 + (size_t)(8 * t) * ldc);
#pragma unroll
                    for (int n = 0; n < 2; ++n) { const f32x4 bv = *(const PG8_LAS f32x4*)(xw + xl_acc(fr, 4 * n + fq)); *(PG8_LAS f32x4*)(xw + xl_acc(fr, 4 * n + fq)) = bv + acc[ai][bj][m][n] * sc; }
#pragma unroll
                    for (int t = 0; t < 2; ++t) *(f32x4*)(out + o0 + (size_t)(8 * t) * ldc) = *(const PG8_LAS f32x4*)(xw + xl_lin(lane, t)); }
    }
};
__device__ __forceinline__ unsigned pk4_fp8(float a, float b, float c, float d) {
    a = __builtin_amdgcn_fmed3f(a, -448.f, 448.f); b = __builtin_amdgcn_fmed3f(b, -448.f, 448.f); c = __builtin_amdgcn_fmed3f(c, -448.f, 448.f); d = __builtin_amdgcn_fmed3f(d, -448.f, 448.f);
    int w = 0; w = __builtin_amdgcn_cvt_pk_fp8_f32(a, b, w, false); w = __builtin_amdgcn_cvt_pk_fp8_f32(c, d, w, true); return (unsigned)w;
}
struct EpiSwiGLU8 {
    static constexpr int NVMEM = 8;
    static constexpr bool PERM = true, AFTER_DRAIN = false;
    unsigned char* O; int ldc; float wsc, osc; PG8_LAS unsigned char* xs;
    __device__ __forceinline__ void operator()(const f32x4 (&acc)[2][2][4][2], const Unit& u, int wr, int wc, int fr, int fq) const {
        const int lane = fr + 16 * fq, lr = lane >> 2, lp = lane & 3;
        const int oa = fr * 32 + (((fq + (fr >> 1)) & 3) << 3), ol = lr * 32 + (((lp + (lr >> 1)) & 3) << 3);
        PG8_LAS unsigned char* xw = xs + (wr * 4 + wc) * XS_WAVE_BYTES;
        unsigned char* lbase = O + (size_t)(u.pm * BM + wr * 64 + lr) * ldc + u.pn * HALF + wc * 32 + lp * 8;
#pragma unroll
        for (int ai = 0; ai < 2; ++ai) {
#pragma unroll
            for (int m = 0; m < 4; ++m) { float o[8];
#pragma unroll
                for (int n = 0; n < 2; ++n)
#pragma unroll
                    for (int i = 0; i < 4; ++i) { const float g = acc[ai][0][m][n][i] * wsc, up = acc[ai][1][m][n][i] * wsc; o[4 * n + i] = g * sigmoidf_fast(g) * up * osc; }
                u32x2 w; w.x = pk4_fp8(o[0], o[1], o[2], o[3]); w.y = pk4_fp8(o[4], o[5], o[6], o[7]);
                *(PG8_LAS u32x2*)(xw + m * 512 + oa) = w; }
#pragma unroll
            for (int m = 0; m < 4; ++m) *(u32x2*)(lbase + (size_t)(ai * HALF + m * 16) * ldc) = *(const PG8_LAS u32x2*)(xw + m * 512 + ol); }
    }
};
struct EpiPlainS {
    static constexpr int NVMEM = 16;
    static constexpr bool PERM = true, AFTER_DRAIN = false;
    bf16_t* O; int ldc; float sc; PG8_LAS unsigned char* xs;
    __device__ __forceinline__ void operator()(const f32x4 (&acc)[2][2][4][2], const Unit& u, int wr, int wc, int fr, int fq) const {
        const int lane = fr + 16 * fq;
        PG8_LAS unsigned char* xw = xs + (wr * 4 + wc) * XS_WAVE_BYTES;
        bf16_t* lbase = O + (size_t)(u.pm * BM + wr * 64 + (lane >> 3)) * ldc + u.pn * BM + wc * 64 + (lane & 7) * 8;
#pragma unroll
        for (int ai = 0; ai < 2; ++ai)
#pragma unroll
            for (int m = 0; m < 4; ++m) {
#pragma unroll
                for (int bj = 0; bj < 2; ++bj) { const f32x4 v0 = acc[ai][bj][m][0] * sc, v1 = acc[ai][bj][m][1] * sc;
                    u32x4 w; w.x = cvt_pk_bf16(v0[0], v0[1]); w.y = cvt_pk_bf16(v0[2], v0[3]); w.z = cvt_pk_bf16(v1[0], v1[1]); w.w = cvt_pk_bf16(v1[2], v1[3]);
                    *(PG8_LAS u32x4*)(xw + xl_acc(fr, 4 * bj + fq)) = w; }
#pragma unroll
                for (int t = 0; t < 2; ++t) *(u32x4*)(lbase + (size_t)(ai * HALF + m * 16 + 8 * t) * ldc) = *(const PG8_LAS u32x4*)(xw + xl_lin(lane, t)); }
    }
};
struct EpiNull {
    static constexpr int NVMEM = 0;
    static constexpr bool PERM = true, AFTER_DRAIN = false;
    __device__ __forceinline__ void operator()(const f32x4 (&acc)[2][2][4][2], const Unit& u, int wr, int wc, int fr, int fq) const {
#pragma unroll
        for (int ai = 0; ai < 2; ++ai)
#pragma unroll
            for (int bj = 0; bj < 2; ++bj)
#pragma unroll
                for (int m = 0; m < 4; ++m)
#pragma unroll
                    for (int n = 0; n < 2; ++n) asm volatile("" :: "v"(acc[ai][bj][m][n]));
    }
};
struct EpiL2 {
    static constexpr int NVMEM = 16;
    static constexpr bool PERM = true, AFTER_DRAIN = false;
    bf16_t* S; int bx;
    __device__ __forceinline__ void operator()(const f32x4 (&acc)[2][2][4][2], const Unit& u, int wr, int wc, int fr, int fq) const {
        const int row0 = wr * 64 + fr, col0 = wc * 32 + 8 * fq; bf16_t* base = S + (size_t)(bx & 7) * 64;
#pragma unroll
        for (int ai = 0; ai < 2; ++ai)
#pragma unroll
            for (int m = 0; m < 4; ++m) {
#ifdef PROBE_L2W
                bf16_t* rowp = base + (size_t)(((wr * 4 + wc) * 16 + ai * 8 + m * 2) * 8 + ((fr + 16 * fq) >> 3)) * 4608 + ((fr + 16 * fq) & 7) * 8;
#else
                bf16_t* rowp = base + (size_t)(row0 + ai * HALF + m * 16) * 256 + col0;
#endif
#pragma unroll
                for (int bj = 0; bj < 2; ++bj) { const f32x4 v0 = acc[ai][bj][m][0], v1 = acc[ai][bj][m][1];
                    u32x4 w; w.x = cvt_pk_bf16(v0[0], v0[1]); w.y = cvt_pk_bf16(v0[2], v0[3]); w.z = cvt_pk_bf16(v1[0], v1[1]); w.w = cvt_pk_bf16(v1[2], v1[3]);
#ifdef PROBE_L2ONE
                    if (ai == 0 && m == 0 && bj == 0) *(u32x4*)(rowp + bj * HALF) = w; else asm volatile("" :: "v"(w));
#elif defined(PROBE_L2W)
                    *(u32x4*)(rowp + bj * 8 * 4608) = w;
#else
                    *(u32x4*)(rowp + bj * HALF) = w;
#endif
                    } }
    }
};
struct MoeOrder : StaticOrder {
    const volatile PG8_LAS unsigned* offs; int ntn;
    __device__ __forceinline__ bool next(int i, Unit& u) const {
        if (!StaticOrder::next(i, u)) return false;
        const unsigned row = (unsigned)u.pm * BM; int e = 0;
#pragma unroll
        for (int k = 1; k < 8; ++k) e += (row >= offs[k]) ? 1 : 0;
        u.pb = e * ntn + u.pn; return true;
    }
};
typedef int i32x8 __attribute__((ext_vector_type(8))); typedef int i32x4 __attribute__((ext_vector_type(4)));
__device__ __forceinline__ i32x8 cat8(const bf16x8 lo, const bf16x8 hi) { const i32x4 a = __builtin_bit_cast(i32x4, lo), b = __builtin_bit_cast(i32x4, hi); return (i32x8){a.x, a.y, a.z, a.w, b.x, b.y, b.z, b.w}; }
template <class Epi, class Sched, bool ALIGN_EPI = false, bool SP2 = false, bool FP8 = false>
__device__ __forceinline__ void gemm_phase(PG8_LAS unsigned char* lds, const Gemm g, const Sched& S, const Epi& E, const int tid) {
    const int wid = __builtin_amdgcn_readfirstlane(tid >> 6), lane = tid & 63, wr = wid >> 2, wc = wid & 3, fr = lane & 15, fq = lane >> 4;
    const int K = g.K, nt = K / BK;
    unsigned voffA[2], voffB[2];
#pragma unroll
    for (int i = 0; i < 2; ++i) { int R, C; stage_rc(tid * 16 + i * 8192, R, C); const int Rb = 64 * (R >> 5) + (Epi::PERM ? perm32(R & 31) : (R & 31));
        voffA[i] = (unsigned)(R * K + C) * 2u; voffB[i] = (unsigned)(Rb * K + C) * 2u; }
    const size_t kstep = (size_t)(BK * 2);
    const size_t hstep = (size_t)HALF * K * 2;
    const size_t hstepB = (size_t)32 * K * 2;
    const size_t tstep = 2 * hstep;
    const unsigned ldsw = (unsigned)wid * 1024u;
    const int aoff = lds_byte(wr * 64 + fr, fq * 8), boff = lds_byte(wc * 32 + fr, fq * 8);
#define PG8_SA(b, h) (((b) * 2 + (h)) * HTB)
#define PG8_SB(b, h) ((4 + (b) * 2 + (h)) * HTB)
#define PG8_STAGE(bufoff, gbase, voff) do { _Pragma("unroll") for (int _i = 0; _i < 2; ++_i) \
        __builtin_amdgcn_global_load_lds((const unsigned*)((const char*)(gbase) + (voff)[_i]), (PG8_LAS unsigned*)(lds + (bufoff) + ldsw + _i * 8192), 16, 0, 0); } while (0)
#define PG8_LDA(dst, b, h) do { if constexpr (FP8) { _Pragma("unroll") for (int m = 0; m < 4; ++m) { const i32x4 l_ = *(const PG8_LAS i32x4*)(lds + PG8_SA(b, h) + aoff + m * 2048), h_ = *(const PG8_LAS i32x4*)(lds + PG8_SA(b, h) + aoff + m * 2048 + 1024); dst##8[m] = (i32x8){l_.x, l_.y, l_.z, l_.w, h_.x, h_.y, h_.z, h_.w}; } } \
        else { _Pragma("unroll") for (int m = 0; m < 4; ++m) _Pragma("unroll") for (int k = 0; k < 2; ++k) dst[m][k] = *(const PG8_LAS i32x4*)(lds + PG8_SA(b, h) + aoff + m * 2048 + k * 1024); } } while (0)
#define PG8_LDB(dst, b, h) do { if constexpr (FP8) { _Pragma("unroll") for (int n = 0; n < 2; ++n) { const i32x4 l_ = *(const PG8_LAS i32x4*)(lds + PG8_SB(b, h) + boff + n * 2048), h_ = *(const PG8_LAS i32x4*)(lds + PG8_SB(b, h) + boff + n * 2048 + 1024); dst##8[n] = (i32x8){l_.x, l_.y, l_.z, l_.w, h_.x, h_.y, h_.z, h_.w}; } } \
        else { _Pragma("unroll") for (int n = 0; n < 2; ++n) _Pragma("unroll") for (int k = 0; k < 2; ++k) dst[n][k] = *(const PG8_LAS i32x4*)(lds + PG8_SB(b, h) + boff + n * 2048 + k * 1024); } } while (0)
#define PG8_MMA(ai, bj, At, Bt) do { __builtin_amdgcn_s_setprio(1); \
        if constexpr (FP8) { _Pragma("unroll") for (int m = 0; m < 4; ++m) _Pragma("unroll") for (int n = 0; n < 2; ++n) \
            asm volatile("v_mfma_scale_f32_16x16x128_f8f6f4 %0, %1, %2, %0, %3, %3 op_sel_hi:[0,0,0]" : "+v"(acc[ai][bj][m][n]) : "v"(Bt##8[n]), "v"(At##8[m]), "v"(sc1_)); } \
        else { _Pragma("unroll") for (int m = 0; m < 4; ++m) _Pragma("unroll") for (int n = 0; n < 2; ++n) _Pragma("unroll") for (int k = 0; k < 2; ++k) \
            acc[ai][bj][m][n] = __builtin_amdgcn_mfma_f32_16x16x32_bf16(__builtin_bit_cast(bf16x8, Bt[n][k]), __builtin_bit_cast(bf16x8, At[m][k]), acc[ai][bj][m][n], 0, 0, 0); } \
        __builtin_amdgcn_s_setprio(0); } while (0)
#define PG8_WAIT_V(n) asm volatile("s_waitcnt vmcnt(" #n ")" ::: "memory")
#define PG8_WAIT_V8R(rel) asm volatile("s_cmp_lg_u32 %0, 0\n\ts_cbranch_scc1 1\n\ts_waitcnt vmcnt(8)\n\ts_waitcnt vmcnt(%1)" :: "s"(rel), "n"(8 + (Epi::NVMEM > 55 ? 55 : Epi::NVMEM)) : "memory", "scc")
#define PG8_WAIT_L(n) asm volatile("s_waitcnt lgkmcnt(" #n ")" ::: "memory")
#define PG8_BAR __builtin_amdgcn_s_barrier()
#define PG8_SCHED __builtin_amdgcn_sched_barrier(0)
    Unit cur, nxt; int ui = 0;
    if (!S.next(0, cur)) return;
    f32x4 acc[2][2][4][2];
#pragma unroll
    for (int a = 0; a < 2; ++a)
#pragma unroll
        for (int b = 0; b < 2; ++b)
#pragma unroll
            for (int m = 0; m < 4; ++m)
#pragma unroll
                for (int n = 0; n < 2; ++n) acc[a][b][m][n] = (f32x4){0.f, 0.f, 0.f, 0.f};
    int sc1_ = 0x7f7f7f7f; asm volatile("" : "+v"(sc1_));
    typedef i32x4 frag_t; frag_t At[4][2], B0[2][2], B1[2][2]; i32x8 At8[4], B08[2], B18[2];
    const char* cA = (const char*)g.A + (size_t)cur.pm * tstep; const char* cB = (const char*)g.Bt + (size_t)cur.pb * tstep;
    S.a_ready(cur);
    if constexpr (SP2) {
        PG8_STAGE(PG8_SB(0, 0), cB, voffB); PG8_STAGE(PG8_SB(0, 1), cB + hstepB, voffB); PG8_STAGE(PG8_SA(0, 0), cA, voffA); PG8_STAGE(PG8_SA(0, 1), cA + hstep, voffA);
        if (wr == 1) PG8_BAR;
        PG8_WAIT_V(2); PG8_BAR;
        PG8_STAGE(PG8_SB(1, 0), cB + kstep, voffB); PG8_STAGE(PG8_SA(1, 0), cA + kstep, voffA); PG8_STAGE(PG8_SB(1, 1), cB + hstepB + kstep, voffB);
        PG8_WAIT_V(6); PG8_BAR;
    } else {
        PG8_STAGE(PG8_SB(0, 0), cB, voffB); PG8_STAGE(PG8_SA(0, 0), cA, voffA); PG8_STAGE(PG8_SB(0, 1), cB + hstepB, voffB); PG8_STAGE(PG8_SA(0, 1), cA + hstep, voffA);
        if (wr == 1) PG8_BAR;
        PG8_WAIT_V(4); PG8_BAR;
        PG8_STAGE(PG8_SB(1, 0), cB + kstep, voffB); PG8_STAGE(PG8_SA(1, 0), cA + kstep, voffA); PG8_STAGE(PG8_SB(1, 1), cB + hstepB + kstep, voffB);
        PG8_WAIT_V(6); PG8_BAR;
    }
    for (;;) {
        const bool has_next = S.next(ui + 1, nxt);
        const char* nA = has_next ? (const char*)g.A + (size_t)nxt.pm * tstep : cA; const char* nB = has_next ? (const char*)g.Bt + (size_t)nxt.pb * tstep : cB;
        for (int t = 0; t < nt; t += 2) {
            const bool last = (t == nt - 2);
            const int relax = __builtin_amdgcn_readfirstlane((PG8_RELAX && (t == 0) && (ui > 0)) ? 1 : 0);
            const char* a1 = cA + (size_t)(t + 1) * kstep;
            const char* a2 = last ? nA : cA + (size_t)(t + 2) * kstep; const char* b2 = last ? nB : cB + (size_t)(t + 2) * kstep;
            const char* a3 = a2 + kstep; const char* b3 = b2 + kstep;
            if (last && has_next) S.a_ready(nxt);
            if constexpr (SP2) {
            PG8_LDB(B0, 0, 0); PG8_LDB(B1, 0, 1); PG8_SCHED; PG8_LDA(At, 0, 0); PG8_STAGE(PG8_SA(1, 1), a1 + hstep, voffA);
            PG8_WAIT_V8R(relax); PG8_WAIT_L(0); PG8_BAR; PG8_MMA(0, 0, At, B0); PG8_MMA(0, 1, At, B1); PG8_BAR; PG8_SCHED;
            PG8_LDA(At, 0, 1); PG8_STAGE(PG8_SB(0, 0), b2, voffB); PG8_STAGE(PG8_SB(0, 1), b2 + hstepB, voffB); PG8_STAGE(PG8_SA(0, 0), a2, voffA);
            PG8_WAIT_V8R(relax); PG8_WAIT_L(0); PG8_BAR; PG8_MMA(1, 0, At, B0); PG8_MMA(1, 1, At, B1); PG8_BAR; PG8_SCHED;
            PG8_LDB(B0, 1, 0); PG8_LDB(B1, 1, 1); PG8_SCHED; PG8_LDA(At, 1, 0); PG8_STAGE(PG8_SA(0, 1), a2 + hstep, voffA);
            PG8_WAIT_V(8); PG8_WAIT_L(0); PG8_BAR; PG8_MMA(0, 0, At, B0); PG8_MMA(0, 1, At, B1); PG8_BAR; PG8_SCHED;
            PG8_LDA(At, 1, 1); PG8_STAGE(PG8_SB(1, 0), b3, voffB); PG8_STAGE(PG8_SB(1, 1), b3 + hstepB, voffB); PG8_STAGE(PG8_SA(1, 0), a3, voffA);
            PG8_WAIT_V(8); PG8_WAIT_L(0); PG8_BAR; PG8_MMA(1, 0, At, B0); PG8_MMA(1, 1, At, B1); PG8_BAR; PG8_SCHED;
            } else {
            PG8_LDB(B0, 0, 0); PG8_SCHED; PG8_LDA(At, 0, 0); PG8_STAGE(PG8_SA(1, 1), a1 + hstep, voffA);
            PG8_WAIT_L(8); PG8_BAR; PG8_WAIT_L(0); PG8_MMA(0, 0, At, B0); PG8_BAR; PG8_SCHED;
            PG8_LDB(B1, 0, 1); PG8_STAGE(PG8_SB(0, 0), b2, voffB);
            PG8_BAR; PG8_WAIT_L(0); PG8_MMA(0, 1, At, B1); PG8_BAR;
            PG8_LDA(At, 0, 1); PG8_STAGE(PG8_SA(0, 0), a2, voffA);
            PG8_BAR; PG8_WAIT_L(0); PG8_MMA(1, 0, At, B0); PG8_BAR; PG8_SCHED;
            PG8_STAGE(PG8_SB(0, 1), b2 + hstepB, voffB);
            PG8_WAIT_V(6); PG8_BAR; PG8_MMA(1, 1, At, B1); PG8_BAR;
            PG8_LDB(B0, 1, 0); PG8_SCHED; PG8_LDA(At, 1, 0); PG8_STAGE(PG8_SA(0, 1), a2 + hstep, voffA);
            PG8_WAIT_L(8); PG8_BAR; PG8_WAIT_L(0); PG8_MMA(0, 0, At, B0); PG8_BAR; PG8_SCHED;
            PG8_LDB(B1, 1, 1); PG8_STAGE(PG8_SB(1, 0), b3, voffB);
            PG8_BAR; PG8_WAIT_L(0); PG8_MMA(0, 1, At, B1); PG8_BAR;
            PG8_LDA(At, 1, 1); PG8_STAGE(PG8_SA(1, 0), a3, voffA);
            PG8_BAR; PG8_WAIT_L(0); PG8_MMA(1, 0, At, B0); PG8_BAR; PG8_SCHED;
            PG8_STAGE(PG8_SB(1, 1), b3 + hstepB, voffB);
            PG8_WAIT_V(6); PG8_BAR; PG8_MMA(1, 1, At, B1); PG8_BAR;
            }
        }
        if constexpr (FP8) asm volatile("s_nop 15\n\ts_nop 15" ::: "memory");
        if constexpr (ALIGN_EPI) { if (wr == 0) PG8_BAR; }
        if constexpr (!Epi::AFTER_DRAIN) { E(acc, cur, wr, wc, fr, fq); S.done(cur); }
        if (!has_next) break;
#pragma unroll
        for (int a = 0; a < 2; ++a)
#pragma unroll
            for (int b = 0; b < 2; ++b)
#pragma unroll
                for (int m = 0; m < 4; ++m)
#pragma unroll
                    for (int n = 0; n < 2; ++n) acc[a][b][m][n] = (f32x4){0.f, 0.f, 0.f, 0.f};
        cur = nxt; cA = nA; cB = nB; ++ui;
        if constexpr (ALIGN_EPI) { if (wr == 1) PG8_BAR; }
    }
    PG8_WAIT_V(0);
    if constexpr (!ALIGN_EPI) { if (wr == 0) PG8_BAR; }
    PG8_BAR;
    if constexpr (Epi::AFTER_DRAIN) { E.fused(acc, cur, wr, wc, fr, fq, lds, wid, lane); S.done(cur); }
#undef PG8_SA
#undef PG8_SB
#undef PG8_STAGE
#undef PG8_LDA
#undef PG8_LDB
#undef PG8_MMA
#undef PG8_WAIT_V
#undef PG8_WAIT_V8R
#undef PG8_WAIT_L
#undef PG8_BAR
#undef PG8_SCHED
}
}
#define GAS __attribute__((address_space(1)))
#define LAS __attribute__((address_space(3)))
typedef unsigned short bf16;
typedef unsigned v4u __attribute__((ext_vector_type(4)));
typedef float f32x4 __attribute__((ext_vector_type(4)));
typedef short bf16x8 __attribute__((ext_vector_type(8)));
typedef GAS unsigned gu32;
typedef GAS unsigned long long gu64;
#define RLX_AGENT __ATOMIC_RELAXED, __HIP_MEMORY_SCOPE_AGENT
#define LDS_WAIT() asm volatile("s_waitcnt lgkmcnt(0)" ::: "memory")
#define VM_WAIT() asm volatile("s_waitcnt vmcnt(0)" ::: "memory")
__device__ __forceinline__ unsigned long long rt() { return __builtin_amdgcn_s_memrealtime(); }
__device__ __forceinline__ unsigned f2bf(float f) { unsigned u = __builtin_bit_cast(unsigned, f); return (u + 0x7fffu + ((u >> 16) & 1u)) >> 16; }
__device__ __forceinline__ unsigned pk2(float lo, float hi) { return f2bf(lo) | (f2bf(hi) << 16); }

#define XB_TMO      128
#define XB_XCNT(j)  (256  + 64 * (j))
#define XB_XSUB(j)  (1280 + 64 * (j))
#define XB_XGEN(j)  (2304 + 64 * (j))
#define XB_TOP      3328
#define XB_TOPGEN   3392
#define XCD_BAR_WORDS 3456
#define XB_SPIN_CAP (1u << 18)

__device__ __forceinline__ unsigned xb_ld(unsigned* p)              { return __hip_atomic_load(p, __ATOMIC_RELAXED, __HIP_MEMORY_SCOPE_AGENT); }
__device__ __forceinline__ unsigned xb_add(unsigned* p, unsigned v) { return __hip_atomic_fetch_add(p, v, __ATOMIC_RELAXED, __HIP_MEMORY_SCOPE_AGENT); }
__device__ __forceinline__ unsigned xb_xcc_id() { return (unsigned)__builtin_amdgcn_s_getreg((3 << 11) | 20) & 0xFu; }
#define XB_SPIN(cond, bar) do { unsigned _sp = 0; while (cond) { __builtin_amdgcn_s_sleep(1); \
    if ((++_sp & 255u) == 0u) { if (xb_ld(&(bar)[XB_TMO])) break; if (_sp > XB_SPIN_CAP) { atomicAdd(&(bar)[XB_TMO], 1u); break; } } } } while (0)

struct XcdBarrier {
    unsigned* bar; unsigned x;
    volatile LAS unsigned* st;
};

__device__ __forceinline__ XcdBarrier xcd_barrier_post(unsigned* bar, volatile LAS unsigned* st) {
    XcdBarrier b; b.bar = bar; b.x = xb_xcc_id(); b.st = st;
    if (threadIdx.x == 0) (void)xb_add(&bar[XB_XCNT(b.x)], 1u);
    return b;
}
__device__ __forceinline__ void xcd_barrier_complete(unsigned* bar, unsigned x, unsigned& nloc, unsigned& nx) {
    const unsigned G = gridDim.x * gridDim.y * gridDim.z;
    unsigned sum, cnt, mine, sp = 0u;
    for (;;) {
        sum = 0u; cnt = 0u; mine = 0u;
#pragma unroll
        for (unsigned j = 0; j < 16; ++j) { const unsigned c = xb_ld(&bar[XB_XCNT(j)]); sum += c; cnt += (c > 0u) ? 1u : 0u; mine = (j == x) ? c : mine; }
        if (sum == G) break;
        __builtin_amdgcn_s_sleep(1);
        if ((++sp & 255u) == 0u) { if (xb_ld(&bar[XB_TMO])) break; if (sp > XB_SPIN_CAP) { atomicAdd(&bar[XB_TMO], 1u); break; } }
    }
    nloc = mine > 0u ? mine : 1u; nx = cnt > 0u ? cnt : 1u;
}

__device__ __forceinline__ void xcd_barrier(const XcdBarrier& b) {
    asm volatile("s_waitcnt vmcnt(0)" ::: "memory");
    __syncthreads();
    if (threadIdx.x == 0) {
        unsigned* bar = b.bar;
        __builtin_amdgcn_s_waitcnt(0);
        unsigned nloc = b.st[0], nx = b.st[1];
        if (nloc == 0u) { xcd_barrier_complete(bar, b.x, nloc, nx); b.st[0] = nloc; b.st[1] = nx; }
        const unsigned old = xb_add(&bar[XB_XSUB(b.x)], 1u);
        const unsigned gen = old / nloc;
        if (old + 1u == (gen + 1u) * nloc) {
            __builtin_amdgcn_fence(__ATOMIC_RELEASE, "agent");
            asm volatile("s_waitcnt vmcnt(0)" ::: "memory");
            const unsigned og = xb_add(&bar[XB_TOP], 1u);
            const unsigned tg = og / nx;
            if (og + 1u == (tg + 1u) * nx) xb_add(&bar[XB_TOPGEN], 1u);
            else XB_SPIN(xb_ld(&bar[XB_TOPGEN]) == tg, bar);
            __builtin_amdgcn_fence(__ATOMIC_ACQUIRE, "agent");
            xb_add(&bar[XB_XGEN(b.x)], 1u);
            asm volatile("s_waitcnt vmcnt(0)" ::: "memory");
        } else {
            XB_SPIN(xb_ld(&bar[XB_XGEN(b.x)]) == gen, bar);
            __builtin_amdgcn_fence(__ATOMIC_ACQUIRE, "agent");
            asm volatile("s_waitcnt vmcnt(0)" ::: "memory");
        }
    }
    __syncthreads();
}

constexpr int NWAVES = 8;
constexpr int BATCH = 8, SEQ = 4096, D = 1024, T = BATCH * SEQ, DEPTH = 2;
constexpr int DCONV = 512, NHEAD = 8, HD = 64, DATTN = 512, DFF = 2816, NEXP = 8, DFFE = 2048;
constexpr int NIN = 5120, NPA = 1536, NQK = 1024, NGT = 2048, NPROJ = NPA + NQK + NGT;
constexpr float EPS = 1e-6f;
constexpr float QSCALE = 0.125f * 1.4426950408889634f;
constexpr int MPAD = 2 * T + NEXP * 256;
constexpr int VTP = T + 64;

constexpr size_t MiB = 1u << 20;
constexpr size_t WS_CTL = 0, CTL_ZERO_BYTES = 1 * MiB;
constexpr size_t WS_ROUTE = 1 * MiB;
constexpr size_t WS_SLOTS = WS_ROUTE + 512 * 1024, WS_WGCNT = WS_ROUTE + 768 * 1024;
constexpr size_t WS_WL = 4 * MiB, WL_STRIDE = 14 * MiB;
constexpr size_t WL_WIN = 0, WL_WV = 9 * MiB, WL_WA = 10 * MiB, WL_WB = 11 * MiB, WL_WO = 12 * MiB;
constexpr size_t WS_WGU = 32 * MiB, WS_WD = 43 * MiB;
constexpr size_t WS_H = 50 * MiB;
constexpr size_t WS_UA = WS_H, WS_UB = WS_H + 32 * MiB;
constexpr size_t WS_VT = 114 * MiB;
constexpr size_t WS_GT = 146 * MiB;
constexpr size_t WS_PA = 274 * MiB;
constexpr size_t WS_QF = WS_PA + 96 * MiB, WS_KF = WS_PA + 128 * MiB;
constexpr size_t WS_TMP = 274 * MiB, WS_MIX = 338 * MiB;
constexpr size_t WS_G0 = 146 * MiB;
constexpr size_t WS_WEG = 440 * MiB, WS_WED = 472 * MiB;
constexpr size_t WS_HP = 52 * MiB;
constexpr size_t WS_G1 = 118 * MiB;
constexpr size_t WS_Y = 250 * MiB;
constexpr float WSCALE = 32.f, GSCALE = 8.f;
constexpr size_t WS_END = 512 * MiB;
static_assert(WS_G1 + (size_t)MPAD * DFFE <= WS_Y && WS_HP + (size_t)MPAD * D <= WS_G1 && WS_Y + (size_t)MPAD * D * 2 <= WS_END && WS_KF + 32 * MiB <= WS_END, "d_ws map");
constexpr int CW_TMO = 0, CW_CODE = 1, CW_BAR = 4096, CW_CNT = 8192;

constexpr int RING_OFF = 0, RING_BYTES = 131072, LDSCTL_OFF = RING_BYTES, MISC_OFF = LDSCTL_OFF + 320, XS_OFF = RING_BYTES + 1024, LDS_BYTES = XS_OFF + 8 * pg8::XS_WAVE_BYTES;

typedef unsigned u32x2v __attribute__((ext_vector_type(2)));
__device__ __forceinline__ float wave_sum(float v) {
#pragma unroll
    for (int o = 1; o < 64; o <<= 1) v += __shfl_xor(v, o);
    return v;
}
using pg8::cvt_pk_bf16;
__device__ __forceinline__ void tr_block(const float* W, int K, int N, bf16* dst, int drow, int k0, int n0, LAS float* scr, int lane) {
    { f32x4 t[8];
#pragma unroll
      for (int i = 0; i < 8; ++i) t[i] = *(const GAS f32x4*)(W + (size_t)(k0 + 8 * i + (lane >> 3)) * N + n0 + 4 * (lane & 7));
#pragma unroll
      for (int i = 0; i < 8; ++i) { LAS float* p = scr + (8 * i + (lane >> 3)) * 33 + 4 * (lane & 7); p[0] = t[i].x; p[1] = t[i].y; p[2] = t[i].z; p[3] = t[i].w; } }
    LDS_WAIT(); asm volatile("" ::: "memory");
    const int c = lane & 7;
#pragma unroll
    for (int j = 0; j < 4; ++j) { const int n = (lane >> 3) + 8 * j; const LAS float* s = scr + (8 * c) * 33 + n;
        v4u o; o.x = cvt_pk_bf16(s[0 * 33], s[1 * 33]); o.y = cvt_pk_bf16(s[2 * 33], s[3 * 33]); o.z = cvt_pk_bf16(s[4 * 33], s[5 * 33]); o.w = cvt_pk_bf16(s[6 * 33], s[7 * 33]);
        *(GAS v4u*)(dst + (size_t)(drow + n) * K + k0 + 8 * c) = o; }
    LDS_WAIT(); asm volatile("" ::: "memory");
}
__device__ __forceinline__ void tr_block8(const float* W, int K, int N, unsigned char* dst, int drow, int k0, int n0, float sc, LAS float* scr, int lane) {
    { f32x4 t[8];
#pragma unroll
      for (int i = 0; i < 8; ++i) t[i] = *(const GAS f32x4*)(W + (size_t)(k0 + 8 * i + (lane >> 3)) * N + n0 + 4 * (lane & 7));
#pragma unroll
      for (int i = 0; i < 8; ++i) { LAS float* p = scr + (8 * i + (lane >> 3)) * 33 + 4 * (lane & 7); p[0] = t[i].x; p[1] = t[i].y; p[2] = t[i].z; p[3] = t[i].w; } }
    LDS_WAIT(); asm volatile("" ::: "memory");
    const int c = lane & 7;
#pragma unroll
    for (int j = 0; j < 4; ++j) { const int n = (lane >> 3) + 8 * j; const LAS float* s = scr + (8 * c) * 33 + n;
        u32x2v o; o.x = pg8::pk4_fp8(s[0 * 33] * sc, s[1 * 33] * sc, s[2 * 33] * sc, s[3 * 33] * sc); o.y = pg8::pk4_fp8(s[4 * 33] * sc, s[5 * 33] * sc, s[6 * 33] * sc, s[7 * 33] * sc);
        *(GAS u32x2v*)(dst + (size_t)(drow + n) * K + k0 + 8 * c) = o; }
    LDS_WAIT(); asm volatile("" ::: "memory");
}
template <int KIND> __device__ __forceinline__ void tr_item8(const float* W, int K, int N, unsigned char* dst, float sc, LAS float* scr, int item, int lane) {
    const int nblk = N / 32, kb = item / nblk, nb = item % nblk, k0 = 64 * kb, n0 = 32 * nb;
    int drow = n0;
    if (KIND == 2) drow = 256 * (n0 / 128) + 2 * (n0 % 128);
    if (KIND == 3) drow = 256 * (n0 / 128) + 2 * (n0 % 128) + 32;
    tr_block8(W, K, N, dst, drow, k0, n0, sc, scr, lane);
}
template <int KIND> __device__ __forceinline__ void tr_item(const float* W, int K, int N, bf16* dst, bf16* dst2, LAS float* scr, int item, int lane) {
    const int nblk = N / 32, kb = item / nblk, nb = item % nblk, k0 = 64 * kb, n0 = 32 * nb;
    bf16* d = dst; int drow = n0;
    if (KIND == 1) { if (n0 >= 3072) drow = n0 - 512; else if (n0 >= 2560) { d = dst2; drow = n0 - 2560; } }
    if (KIND == 2) drow = 256 * (n0 / 128) + 2 * (n0 % 128);
    if (KIND == 3) drow = 256 * (n0 / 128) + 2 * (n0 % 128) + 32;
    tr_block(W, K, N, d, drow, k0, n0, scr, lane);
}
__device__ __forceinline__ void rms_row_to_bf16(const float* xrow, const float* g, bf16* orow, int lane) {
    const GAS f32x4* xr = (const GAS f32x4*)xrow + lane; const GAS f32x4* gr = (const GAS f32x4*)g + lane;
    f32x4 v[4]; float s = 0.f;
#pragma unroll
    for (int j = 0; j < 4; ++j) { v[j] = xr[64 * j]; s += (v[j].x * v[j].x + v[j].y * v[j].y) + (v[j].z * v[j].z + v[j].w * v[j].w); }
    const float rstd = 1.0f / sqrtf(wave_sum(s) * (1.f / D) + EPS);
    GAS u32x2v* o8 = (GAS u32x2v*)orow + lane;
#pragma unroll
    for (int j = 0; j < 4; ++j) { const f32x4 gg = gr[64 * j]; u32x2v w; w.x = cvt_pk_bf16(v[j].x * rstd * gg.x, v[j].y * rstd * gg.y); w.y = cvt_pk_bf16(v[j].z * rstd * gg.z, v[j].w * rstd * gg.w); o8[64 * j] = w; }
}
__device__ __forceinline__ void rms_row_to_fp8(const float* xrow, const float* g, unsigned char* orow, int lane) {
    const GAS f32x4* xr = (const GAS f32x4*)xrow + lane; const GAS f32x4* gr = (const GAS f32x4*)g + lane;
    f32x4 v[4]; float s = 0.f;
#pragma unroll
    for (int j = 0; j < 4; ++j) { v[j] = xr[64 * j]; s += (v[j].x * v[j].x + v[j].y * v[j].y) + (v[j].z * v[j].z + v[j].w * v[j].w); }
    const float rstd = 1.0f / sqrtf(wave_sum(s) * (1.f / D) + EPS);
    GAS unsigned* o4 = (GAS unsigned*)orow + lane;
#pragma unroll
    for (int j = 0; j < 4; ++j) { const f32x4 gg = gr[64 * j]; o4[64 * j] = pg8::pk4_fp8(v[j].x * rstd * gg.x, v[j].y * rstd * gg.y, v[j].z * rstd * gg.z, v[j].w * rstd * gg.w); }
}
__device__ __forceinline__ void unpack8f(const v4u w, float (&f)[8]) {
    f[0] = __builtin_bit_cast(float, w.x << 16); f[1] = __builtin_bit_cast(float, w.x & 0xffff0000u); f[2] = __builtin_bit_cast(float, w.y << 16); f[3] = __builtin_bit_cast(float, w.y & 0xffff0000u);
    f[4] = __builtin_bit_cast(float, w.z << 16); f[5] = __builtin_bit_cast(float, w.z & 0xffff0000u); f[6] = __builtin_bit_cast(float, w.w << 16); f[7] = __builtin_bit_cast(float, w.w & 0xffff0000u);
}
__device__ __forceinline__ v4u pack8f(const float (&f)[8]) { v4u w; w.x = cvt_pk_bf16(f[0], f[1]); w.y = cvt_pk_bf16(f[2], f[3]); w.z = cvt_pk_bf16(f[4], f[5]); w.w = cvt_pk_bf16(f[6], f[7]); return w; }

__device__ __forceinline__ void conv_phase(const bf16* PA, const float* cw, bf16* UA, int gid, int nthr) {
    for (int it = gid; it < (T / 16) * 64; it += nthr) {
        const int cg = it & 63, t0 = (it >> 6) * 16, c0 = cg * 8;
        float w0[8], w1[8], w2[8];
#pragma unroll
        for (int i = 0; i < 8; ++i) { w0[i] = cw[c0 + i]; w1[i] = cw[DCONV + c0 + i]; w2[i] = cw[2 * DCONV + c0 + i]; }
        float um2[8], um1[8];
        if ((t0 & (SEQ - 1)) == 0) {
#pragma unroll
            for (int i = 0; i < 8; ++i) { um2[i] = 0.f; um1[i] = 0.f; }
        } else {
            float a[8], b[8];
            unpack8f(*(const GAS v4u*)(PA + (size_t)(t0 - 2) * NPA + c0), a); unpack8f(*(const GAS v4u*)(PA + (size_t)(t0 - 2) * NPA + 1024 + c0), b);
#pragma unroll
            for (int i = 0; i < 8; ++i) um2[i] = a[i] * b[i];
            unpack8f(*(const GAS v4u*)(PA + (size_t)(t0 - 1) * NPA + c0), a); unpack8f(*(const GAS v4u*)(PA + (size_t)(t0 - 1) * NPA + 1024 + c0), b);
#pragma unroll
            for (int i = 0; i < 8; ++i) um1[i] = a[i] * b[i];
        }
#pragma unroll 4
        for (int r = 0; r < 16; ++r) {
            const bf16* row = PA + (size_t)(t0 + r) * NPA + c0;
            float xin[8], bg[8], cgv[8], o[8];
            unpack8f(*(const GAS v4u*)(row), xin); unpack8f(*(const GAS v4u*)(row + 512), bg); unpack8f(*(const GAS v4u*)(row + 1024), cgv);
#pragma unroll
            for (int i = 0; i < 8; ++i) { const float u = cgv[i] * xin[i]; o[i] = bg[i] * (w0[i] * um2[i] + w1[i] * um1[i] + w2[i] * u); um2[i] = um1[i]; um1[i] = u; }
            *(GAS v4u*)(UA + (size_t)(t0 + r) * DCONV + c0) = pack8f(o);
        }
    }
}

typedef float f32x16 __attribute__((ext_vector_type(16)));
__device__ __forceinline__ void attn_mfma(const bf16* QF, const bf16* KF, const bf16* VF, bf16* UB, int gw, int NGW, int lane) {
    const int q = lane & 31, hh = lane >> 5;
    constexpr int NU = BATCH * NHEAD * (SEQ / 32);
    bf16x8 qf[4];
    if (gw < NU) {
        const size_t o = (size_t)gw * 2048 + lane * 8;
#pragma unroll
        for (int i = 0; i < 4; ++i) qf[i] = *(const GAS bf16x8*)(QF + o + i * 512);
    }
#pragma unroll 1
    for (int u = gw; u < NU; u += NGW) {
        const int qb = u & 127, bh = u >> 7, h = bh & 7, b = bh >> 3;
        const size_t rowb = (size_t)b * SEQ;
        const bf16* const kbase = KF + (size_t)(bh * 128) * 2048 + lane * 8;
        const bf16* const vbase = VF + (size_t)(bh * 128) * 2048 + lane * 8;
        bf16x8 k0[4], v0[4], k1[4], v1[4], k2[4], v2[4];
        auto fill = [&](bf16x8 (&KB)[4], bf16x8 (&VB)[4], int kbn) __attribute__((always_inline)) {
            kbn = kbn > 0 ? kbn : 0;
            const bf16* kp = kbase + (size_t)kbn * 2048; const bf16* vp = vbase + (size_t)kbn * 2048;
#pragma unroll
            for (int i = 0; i < 4; ++i) { KB[i] = *(const GAS bf16x8*)(kp + i * 512); VB[i] = *(const GAS bf16x8*)(vp + i * 512); }
        };
        fill(k0, v0, qb); fill(k1, v1, qb - 1); fill(k2, v2, qb - 2);
        bf16x8 qN[4];
        {
            const int un = (u + NGW < NU) ? u + NGW : u; const size_t o = (size_t)un * 2048 + lane * 8;
#pragma unroll
            for (int i = 0; i < 4; ++i) qN[i] = *(const GAS bf16x8*)(QF + o + i * 512);
        }
        __builtin_amdgcn_sched_barrier(0);
        f32x16 o0, o1;
#pragma unroll
        for (int r = 0; r < 16; ++r) { o0[r] = 0.f; o1[r] = 0.f; }
        float R = 1.f;
        const bf16x8 (&qfr)[4] = qf;
        auto block = [&](bf16x8 (&KB)[4], bf16x8 (&VB)[4], const int kb) __attribute__((always_inline)) -> bool {
            f32x16 p;
#pragma unroll
            for (int r = 0; r < 16; ++r) p[r] = 0.f;
#pragma unroll
            for (int d0 = 0; d0 < 4; ++d0) p = __builtin_amdgcn_mfma_f32_32x32x16_bf16(KB[d0], qfr[d0], p, 0, 0, 0);
            float rr[16];
            const bool diag = (kb == qb);
#pragma unroll
            for (int r = 0; r < 16; ++r) {
                float e = __builtin_amdgcn_exp2f(p[r]);
                if (diag) { const int kl = (r & 7) + 8 * hh + 16 * (r >> 3); e = (kl < q) ? e : 0.f; }
                rr[r] = __builtin_amdgcn_rcpf(1.0f + e);
            }
            bf16x8 af[2];
#pragma unroll
            for (int s = 1; s >= 0; --s) {
                float g = rr[8 * s];
#pragma unroll
                for (int j = 1; j < 8; ++j) g *= rr[8 * s + j];
                const auto sw = __builtin_amdgcn_permlane32_swap(__float_as_uint(g), __float_as_uint(g), false, false);
                const float g_lo = __uint_as_float(sw[0]), g_hi = __uint_as_float(sw[1]);
                float c = hh ? R : R * g_hi;
                float a[8];
#pragma unroll
                for (int j = 7; j >= 0; --j) { const float cn = c * rr[8 * s + j]; a[j] = c - cn; c = cn; }
                R = R * (g_lo * g_hi);
                typedef unsigned u4 __attribute__((ext_vector_type(4)));
                u4 w; w.x = cvt_pk_bf16(a[0], a[1]); w.y = cvt_pk_bf16(a[2], a[3]); w.z = cvt_pk_bf16(a[4], a[5]); w.w = cvt_pk_bf16(a[6], a[7]);
                af[s] = __builtin_bit_cast(bf16x8, w);
            }
            o0 = __builtin_amdgcn_mfma_f32_32x32x16_bf16(VB[0], af[0], o0, 0, 0, 0);
            o0 = __builtin_amdgcn_mfma_f32_32x32x16_bf16(VB[1], af[1], o0, 0, 0, 0);
            o1 = __builtin_amdgcn_mfma_f32_32x32x16_bf16(VB[2], af[0], o1, 0, 0, 0);
            o1 = __builtin_amdgcn_mfma_f32_32x32x16_bf16(VB[3], af[1], o1, 0, 0, 0);
            if (kb == 0 || __builtin_amdgcn_ballot_w64(R != 0.f) == 0ull) return true;
            fill(KB, VB, kb - 3);
            __builtin_amdgcn_sched_barrier(0);
            return false;
        };
#pragma unroll 1
        for (int kb = qb;; kb -= 3) {
            if (block(k0, v0, kb)) break;
            if (block(k1, v1, kb - 1)) break;
            if (block(k2, v2, kb - 2)) break;
        }
        bf16* op = UB + (rowb + 32 * qb + q) * DATTN + h * 64 + 4 * hh;
#pragma unroll
        for (int g4 = 0; g4 < 4; ++g4) {
            u32x2v w0, w1;
            w0.x = cvt_pk_bf16(o0[4 * g4], o0[4 * g4 + 1]); w0.y = cvt_pk_bf16(o0[4 * g4 + 2], o0[4 * g4 + 3]);
            w1.x = cvt_pk_bf16(o1[4 * g4], o1[4 * g4 + 1]); w1.y = cvt_pk_bf16(o1[4 * g4 + 2], o1[4 * g4 + 3]);
            *(GAS u32x2v*)(op + 8 * g4) = w0; *(GAS u32x2v*)(op + 32 + 8 * g4) = w1;
        }
#pragma unroll
        for (int i = 0; i < 4; ++i) qf[i] = qN[i];
    }
}

#ifndef FFN8
#define FFN8 0
#endif
#ifndef REP_P0
#define REP_P0 1
#endif
#ifndef REP_P1
#define REP_P1 1
#endif
#ifndef REP_P2
#define REP_P2 1
#endif
#ifndef REP_ATT
#define REP_ATT 1
#endif
#ifndef REP_R1A
#define REP_R1A 1
#endif
struct Args { const float* in[16]; float* out; unsigned char* ws; };
typedef const __attribute__((address_space(4))) Args* KArgP;
__device__ __forceinline__ KArgP launder_k(KArgP p) { asm volatile("" : "+s"(p)); return p; }
__device__ __forceinline__ int launder_s(int v) { asm volatile("" : "+s"(v)); return v; }
__device__ __forceinline__ int launder_v(int v) { asm volatile("" : "+v"(v)); return v; }
#ifndef STG_TICKS
#define STG_TICKS 150
#endif
__device__ __forceinline__ void stagger(int bx) { const unsigned long long t0 = __builtin_amdgcn_s_memrealtime(); const unsigned long long want = (unsigned long long)(((bx >> 3) & 3) * STG_TICKS); while (__builtin_amdgcn_s_memrealtime() - t0 < want) __builtin_amdgcn_s_sleep(2); }
#define PH_BEGIN { const KArgP ap = launder_k(kp0); unsigned char* const ws = ap->ws; const int bx = launder_s(bx0), G = launder_s(G0); const int tid = launder_v(tid0), lane = tid & 63, wave = __builtin_amdgcn_readfirstlane(tid >> 6); \
    const int gid = bx * (NWAVES * 64) + tid, nthr = G * NWAVES * 64, gw = bx * NWAVES + wave, NGW = G * NWAVES; (void)gid; (void)nthr; (void)gw; (void)NGW; (void)lane; \
    LAS float* const scr = (LAS float*)(lds + RING_OFF + wave * 16384); (void)scr; (void)ws;
#define PH_END(BARRIER) if (BARRIER) { XcdBarrier bl_ = bar; asm volatile("" : "+s"(bl_.bar), "+s"(bl_.x)); xcd_barrier(bl_); } }
#define WSP(T_, off) ((T_*)(ws + (off)))

__global__ void __launch_bounds__(NWAVES * 64, 2) mega_fwd(Args args) {
    extern __shared__ __attribute__((aligned(16))) unsigned char lds_raw[];
    LAS unsigned char* const lds = (LAS unsigned char*)lds_raw;
    volatile LAS unsigned* const MISC = (volatile LAS unsigned*)(lds + MISC_OFF);
    const KArgP kp0 = (KArgP)__builtin_amdgcn_kernarg_segment_ptr();
    const int tid0 = threadIdx.x, G0 = gridDim.x, bx0 = blockIdx.x;
    for (int u = tid0; u < 1024 / 4; u += NWAVES * 64) ((LAS unsigned*)(lds + LDSCTL_OFF))[u] = 0u;
    __syncthreads();
#ifdef PROBE_CLK
    long long probe_cycles = 0;
#endif
    XcdBarrier bar = xcd_barrier_post((unsigned*)(args.ws + WS_CTL) + CW_BAR, MISC + 8);

    constexpr int I_IN = 16 * 160, I_BR = 8 * 32, I_O = 16 * 32, I_GU = 16 * 88, I_D = 44 * 32, I_E = 16 * 64;
    constexpr int PER_L = I_IN + 2 * I_BR + I_O, N_FFN = 2 * I_GU + I_D, N_EXPW = NEXP * 3 * I_E;
#define MIXER_W_ITEM(l_, r_) do { int r = (r_); unsigned char* wl = ws + WS_WL + (size_t)(l_) * WL_STRIDE; \
        if (r < I_IN) { tr_item<1>(ap->in[2] + (size_t)(l_) * D * NIN, D, NIN, (bf16*)(wl + WL_WIN), (bf16*)(wl + WL_WV), scr, r, lane); break; } r -= I_IN; \
        if (r < I_BR) { tr_item<0>(ap->in[4] + (size_t)(l_) * DCONV * D, DCONV, D, (bf16*)(wl + WL_WA), nullptr, scr, r, lane); break; } r -= I_BR; \
        if (r < I_BR) { tr_item<0>(ap->in[5] + (size_t)(l_) * DATTN * D, DATTN, D, (bf16*)(wl + WL_WB), nullptr, scr, r, lane); break; } r -= I_BR; \
        tr_item<0>(ap->in[6] + (size_t)(l_) * D * D, D, D, (bf16*)(wl + WL_WO), nullptr, scr, r, lane); } while (0)
#define FFN_W_ITEM(r_) do { int r = (r_); \
        if (r < I_GU) { tr_item<2>(ap->in[8], D, DFF, WSP(bf16, WS_WGU), nullptr, scr, r, lane); break; } r -= I_GU; \
        if (r < I_GU) { tr_item<3>(ap->in[9], D, DFF, WSP(bf16, WS_WGU), nullptr, scr, r, lane); break; } r -= I_GU; \
        tr_item<0>(ap->in[10], DFF, D, WSP(bf16, WS_WD), nullptr, scr, r, lane); } while (0)
#define EXPERT_W_ITEM(it_) do { const int e = (it_) / (3 * I_E); int r = (it_) - e * 3 * I_E; \
        if (r < I_E) { tr_item8<2>(ap->in[12] + (size_t)e * D * DFFE, D, DFFE, WSP(unsigned char, WS_WEG) + (size_t)e * 2 * DFFE * D, WSCALE, scr, r, lane); break; } r -= I_E; \
        if (r < I_E) { tr_item8<3>(ap->in[13] + (size_t)e * D * DFFE, D, DFFE, WSP(unsigned char, WS_WEG) + (size_t)e * 2 * DFFE * D, WSCALE, scr, r, lane); break; } r -= I_E; \
        tr_item8<0>(ap->in[14] + (size_t)e * DFFE * D, DFFE, D, WSP(unsigned char, WS_WED) + (size_t)e * D * DFFE, WSCALE, scr, r, lane); } while (0)

    PH_BEGIN
#pragma unroll 1
        for (int it = gw; it < PER_L; it += NGW) MIXER_W_ITEM(0, it);
#pragma unroll 1
        for (int m = gw; m < T; m += NGW) rms_row_to_bf16(ap->in[0] + (size_t)m * D, ap->in[1], WSP(bf16, WS_H) + (size_t)m * D, lane);
    PH_END(true)

#pragma unroll 1
    for (int l = 0; l < DEPTH; ++l) {
#pragma unroll 1
        for (int rep = 2 - REP_P1; rep < 2; ++rep) {
        PH_BEGIN
            unsigned char* wl = ws + WS_WL + (size_t)l * WL_STRIDE;
            pg8::Gemm g{WSP(bf16, WS_H), (const bf16*)(wl + WL_WIN), T, NPROJ, D}; pg8::StaticOrder S; S.init(T, NPROJ, G, bx);
#ifdef PROBE_NULL
            if (rep == 0) { pg8::EpiNull E0; pg8::gemm_phase<pg8::EpiNull, pg8::StaticOrder, true, true>(lds + RING_OFF, g, S, E0, tid); } else
#endif
#ifdef PROBE_L2
            if (rep == 0) { pg8::EpiL2 E0{WSP(bf16, 440 * MiB), bx}; pg8::gemm_phase<pg8::EpiL2, pg8::StaticOrder, true, true>(lds + RING_OFF, g, S, E0, tid); } else
#endif
            {
#ifdef PROBE_CLK
            long long c0_ = clock64();
#endif
            pg8::EpiProj E{WSP(bf16, WS_PA), WSP(bf16, WS_QF), WSP(bf16, WS_KF), WSP(bf16, WS_GT), QSCALE, lds + XS_OFF};
            pg8::gemm_phase<pg8::EpiProj, pg8::StaticOrder, true, true>(lds + RING_OFF, g, S, E, tid);
#ifdef PROBE_CLK
            if (l == 0) probe_cycles = clock64() - c0_;
#endif
            }
        PH_END(false)
        PH_BEGIN
            unsigned char* wl = ws + WS_WL + (size_t)l * WL_STRIDE;
            pg8::Gemm g{(const bf16*)(wl + WL_WV), WSP(bf16, WS_H), DATTN, T, D}; pg8::StaticOrder S; S.init(DATTN, T, G, bx);
            if (rep == 1) { pg8::EpiVT E{WSP(bf16, WS_VT)};
            pg8::gemm_phase<pg8::EpiVT, pg8::StaticOrder, true, true>(lds + RING_OFF, g, S, E, tid); }
        PH_END(true)
        }
        PH_BEGIN
            conv_phase(WSP(bf16, WS_PA), ap->in[3] + (size_t)l * 3 * DCONV, WSP(bf16, WS_UA), gid, nthr);
        PH_END(false)
        PH_BEGIN
            if (wave < 4) attn_mfma(WSP(bf16, WS_QF), WSP(bf16, WS_KF), WSP(bf16, WS_VT), WSP(bf16, WS_UB), gw, NGW, lane);
        PH_END(false)
        PH_BEGIN
            if (l == 0) {
#pragma unroll 1
                for (int it = gw; it < PER_L + N_FFN; it += NGW) { if (it < PER_L) MIXER_W_ITEM(1, it); else FFN_W_ITEM(it - PER_L); }
            } else {
#pragma unroll 1
                for (int it = gw; it < N_EXPW; it += NGW) EXPERT_W_ITEM(it);
            }
        PH_END(false)
        PH_BEGIN
            if (wave >= 4) attn_mfma(WSP(bf16, WS_QF), WSP(bf16, WS_KF), WSP(bf16, WS_VT), WSP(bf16, WS_UB), gw, NGW, lane);
        PH_END(true)
        PH_BEGIN
            unsigned char* wl = ws + WS_WL + (size_t)l * WL_STRIDE;
            pg8::Gemm g{WSP(bf16, WS_UA), (const bf16*)(wl + WL_WA), T, D, DCONV}; pg8::StaticOrder S; S.init(T, D, G, bx);
            pg8::EpiGateA E{WSP(bf16, WS_GT), WSP(bf16, WS_TMP), lds + XS_OFF};
            pg8::gemm_phase<pg8::EpiGateA, pg8::StaticOrder, true, true>(lds + RING_OFF, g, S, E, tid);
        PH_END(false)
        PH_BEGIN
            unsigned char* wl = ws + WS_WL + (size_t)l * WL_STRIDE;
            pg8::Gemm g{WSP(bf16, WS_UB), (const bf16*)(wl + WL_WB), T, D, DATTN}; pg8::StaticOrder S; S.init(T, D, G, bx);
            pg8::EpiGateB E{WSP(bf16, WS_GT), WSP(bf16, WS_TMP), WSP(bf16, WS_MIX), lds + XS_OFF};
            pg8::gemm_phase<pg8::EpiGateB, pg8::StaticOrder, true, true>(lds + RING_OFF, g, S, E, tid);
        PH_END(true)
        PH_BEGIN
            unsigned char* wl = ws + WS_WL + (size_t)l * WL_STRIDE;
            pg8::Gemm g{WSP(bf16, WS_MIX), (const bf16*)(wl + WL_WO), T, D, D}; pg8::StaticOrder S; S.init(T, D, G, bx);
            pg8::EpiRes E{l == 0 ? ap->in[0] : (const float*)ap->out, ap->out, D, 1.f, lds + XS_OFF};
            pg8::gemm_phase<pg8::EpiRes, pg8::StaticOrder, true, true>(lds + RING_OFF, g, S, E, tid);
        PH_END(true)
        if (l == 0) {
            PH_BEGIN
#pragma unroll 1
#if FFN8
                for (int m = gw; m < T; m += NGW) rms_row_to_fp8(ap->out + (size_t)m * D, ap->in[7], WSP(unsigned char, WS_H) + (size_t)m * D, lane);
#else
                for (int m = gw; m < T; m += NGW) rms_row_to_bf16(ap->out + (size_t)m * D, ap->in[7], WSP(bf16, WS_H) + (size_t)m * D, lane);
#endif
            PH_END(true)
            PH_BEGIN
#if FFN8
                pg8::Gemm g{WSP(bf16, WS_H), WSP(bf16, WS_WGU), T, 2 * DFF, D / 2}; pg8::StaticOrder S; S.init(T, 2 * DFF, G, bx);
                pg8::EpiSwiGLU8 E{WSP(unsigned char, WS_G0), DFF, 1.0f / WSCALE, GSCALE, lds + XS_OFF};
                pg8::gemm_phase<pg8::EpiSwiGLU8, pg8::StaticOrder, true, true, true>(lds + RING_OFF, g, S, E, tid);
#else
                pg8::Gemm g{WSP(bf16, WS_H), WSP(bf16, WS_WGU), T, 2 * DFF, D}; pg8::StaticOrder S; S.init(T, 2 * DFF, G, bx);
                pg8::EpiSwiGLU E{WSP(bf16, WS_G0), DFF, lds + XS_OFF};
                pg8::gemm_phase<pg8::EpiSwiGLU, pg8::StaticOrder, true, true>(lds + RING_OFF, g, S, E, tid);
#endif
            PH_END(true)
            PH_BEGIN
#if FFN8
                pg8::Gemm g{WSP(bf16, WS_G0), WSP(bf16, WS_WD), T, D, DFF / 2}; pg8::StaticOrder S; S.init(T, D, G, bx);
                pg8::EpiRes E{ap->out, ap->out, D, 1.0f / (WSCALE * GSCALE), lds + XS_OFF};
                pg8::gemm_phase<pg8::EpiRes, pg8::StaticOrder, true, true, true>(lds + RING_OFF, g, S, E, tid);
#else
                pg8::Gemm g{WSP(bf16, WS_G0), WSP(bf16, WS_WD), T, D, DFF}; pg8::StaticOrder S; S.init(T, D, G, bx);
                pg8::EpiRes E{ap->out, ap->out, D, 1.f, lds + XS_OFF};
                pg8::gemm_phase<pg8::EpiRes, pg8::StaticOrder, true, true>(lds + RING_OFF, g, S, E, tid);
#endif
            PH_END(true)
            PH_BEGIN
#pragma unroll 1
                for (int m = gw; m < T; m += NGW) rms_row_to_bf16(ap->out + (size_t)m * D, ap->in[1] + D, WSP(bf16, WS_H) + (size_t)m * D, lane);
            PH_END(true)
        } else {
            volatile LAS int* const lcnt = (volatile LAS int*)(MISC + 32);
            volatile LAS unsigned* const loff = MISC + 16;
            volatile LAS int* const lbase = (volatile LAS int*)(MISC + 48);
            PH_BEGIN
                int4* route = WSP(int4, WS_ROUTE); int* wgcnt = WSP(int, WS_WGCNT); gu32* ctl = (gu32*)(ws + WS_CTL);
                const int rpw = T / G, r0 = bx * rpw, r1 = r0 + rpw;
                const float* xres = ap->out; const float* gf = ap->in[7] + D; const float* w_router = ap->in[11];
                if (tid < 8) lcnt[tid] = 0;
                __syncthreads();
#pragma unroll 1
                for (int m = r0 + wave; m < r1; m += NWAVES) {
                    const GAS f32x4* xr = (const GAS f32x4*)(xres + (size_t)m * D) + lane; const GAS f32x4* gr = (const GAS f32x4*)gf + lane;
                    f32x4 v[4]; float s = 0.f;
#pragma unroll
                    for (int j = 0; j < 4; ++j) { v[j] = xr[64 * j]; s += (v[j].x * v[j].x + v[j].y * v[j].y) + (v[j].z * v[j].z + v[j].w * v[j].w); }
                    const float rstd = 1.0f / sqrtf(wave_sum(s) * (1.f / D) + EPS);
                    float lg[8];
#pragma unroll
                    for (int e = 0; e < 8; ++e) lg[e] = 0.f;
#pragma unroll
                    for (int j = 0; j < 4; ++j) { const f32x4 gg = gr[64 * j];
#pragma unroll
                        for (int c = 0; c < 4; ++c) { const float hn = v[j][c] * rstd * gg[c]; const int i = 256 * j + 4 * lane + c;
                            const f32x4 wa = *(const GAS f32x4*)(w_router + (size_t)i * 8), wb = *(const GAS f32x4*)(w_router + (size_t)i * 8 + 4);
                            lg[0] += hn * wa.x; lg[1] += hn * wa.y; lg[2] += hn * wa.z; lg[3] += hn * wa.w; lg[4] += hn * wb.x; lg[5] += hn * wb.y; lg[6] += hn * wb.z; lg[7] += hn * wb.w; } }
#pragma unroll
                    for (int e = 0; e < 8; ++e) lg[e] = wave_sum(lg[e]);
                    int e1 = 0; float v1 = lg[0];
#pragma unroll
                    for (int e = 1; e < 8; ++e) if (lg[e] > v1) { v1 = lg[e]; e1 = e; }
                    int e2 = -1; float v2 = -INFINITY;
#pragma unroll
                    for (int e = 0; e < 8; ++e) if (e != e1 && lg[e] > v2) { v2 = lg[e]; e2 = e; }
                    if (e2 < 0) e2 = (e1 + 1) & 7;
                    const float ex = __expf(v2 - v1), w1 = 1.0f / (1.0f + ex), w2 = ex * w1;
                    if (lane == 0) { route[m] = make_int4(e1, e2, __float_as_int(w1), __float_as_int(w2)); atomicAdd((int*)(lcnt + e1), 1); atomicAdd((int*)(lcnt + e2), 1); }
                }
                __syncthreads();
                if (tid < 8) { const int c = lcnt[tid]; wgcnt[bx * 8 + tid] = c; __hip_atomic_fetch_add((unsigned*)(ctl + CW_CNT + tid), (unsigned)c, RLX_AGENT); }
            PH_END(true)
            PH_BEGIN
                int4* route = WSP(int4, WS_ROUTE); int2* slots = WSP(int2, WS_SLOTS); int* wgcnt = WSP(int, WS_WGCNT); gu32* ctl = (gu32*)(ws + WS_CTL); unsigned char* HP = WSP(unsigned char, WS_HP);
                const int rpw = T / G, r0 = bx * rpw, r1 = r0 + rpw;
                const float* xres = ap->out; const float* gf = ap->in[7] + D;
                { int s = 0; for (int w = lane; w < bx; w += 64) s += wgcnt[w * 8 + wave]; s = (int)wave_sum((float)s);
                  if (lane == 0) { lbase[wave] = s; lcnt[wave] = 0; } }
                if (tid == 0) { unsigned off = 0; for (int e = 0; e < 8; ++e) { loff[e] = off; off += (__hip_atomic_load((unsigned*)(ctl + CW_CNT + e), RLX_AGENT) + 255u) & ~255u; } loff[8] = off; }
                __syncthreads();
#pragma unroll 1
                for (int m = r0 + wave; m < r1; m += NWAVES) {
                    int s1 = 0, s2 = 0;
                    if (lane == 0) { const int4 rt = route[m]; s1 = (int)loff[rt.x] + lbase[rt.x] + atomicAdd((int*)(lcnt + rt.x), 1); s2 = (int)loff[rt.y] + lbase[rt.y] + atomicAdd((int*)(lcnt + rt.y), 1); slots[m] = make_int2(s1, s2); }
                    s1 = __builtin_amdgcn_readfirstlane(s1); s2 = __builtin_amdgcn_readfirstlane(s2);
                    const GAS f32x4* xr = (const GAS f32x4*)(xres + (size_t)m * D) + lane; const GAS f32x4* gr = (const GAS f32x4*)gf + lane;
                    f32x4 v[4]; float s = 0.f;
#pragma unroll
                    for (int j = 0; j < 4; ++j) { v[j] = xr[64 * j]; s += (v[j].x * v[j].x + v[j].y * v[j].y) + (v[j].z * v[j].z + v[j].w * v[j].w); }
                    const float rstd = 1.0f / sqrtf(wave_sum(s) * (1.f / D) + EPS);
                    GAS unsigned* o1 = (GAS unsigned*)(HP + (size_t)s1 * D) + lane; GAS unsigned* o2 = (GAS unsigned*)(HP + (size_t)s2 * D) + lane;
#pragma unroll
                    for (int j = 0; j < 4; ++j) { const f32x4 gg = gr[64 * j]; const unsigned w = pg8::pk4_fp8(v[j].x * rstd * gg.x, v[j].y * rstd * gg.y, v[j].z * rstd * gg.z, v[j].w * rstd * gg.w); o1[64 * j] = w; o2[64 * j] = w; }
                }
            PH_END(true)
            PH_BEGIN
                const int mrows = (int)loff[8];
                pg8::Gemm g{WSP(bf16, WS_HP), WSP(bf16, WS_WEG), mrows, 2 * DFFE, D / 2}; pg8::MoeOrder S; S.init(mrows, 2 * DFFE, G, bx); S.offs = loff; S.ntn = 2 * DFFE / 256;
                pg8::EpiSwiGLU8 E{WSP(unsigned char, WS_G1), DFFE, 1.0f / WSCALE, GSCALE, lds + XS_OFF};
                pg8::gemm_phase<pg8::EpiSwiGLU8, pg8::MoeOrder, true, true, true>(lds + RING_OFF, g, S, E, tid);
            PH_END(true)
            PH_BEGIN
                const int mrows = (int)loff[8];
                pg8::Gemm g{WSP(bf16, WS_G1), WSP(bf16, WS_WED), mrows, D, DFFE / 2}; pg8::MoeOrder S; S.init(mrows, D, G, bx); S.offs = loff; S.ntn = D / 256;
                pg8::EpiPlainS E{WSP(bf16, WS_Y), D, 1.0f / (WSCALE * GSCALE), lds + XS_OFF};
                pg8::gemm_phase<pg8::EpiPlainS, pg8::MoeOrder, true, true, true>(lds + RING_OFF, g, S, E, tid);
            PH_END(true)
            PH_BEGIN
                const int4* route = WSP(int4, WS_ROUTE); const int2* slots = WSP(int2, WS_SLOTS); const bf16* HP = WSP(bf16, WS_Y); float* xres = ap->out; const float* g_final = ap->in[15];
#pragma unroll 1
                for (int m = gw; m < T; m += NGW) {
                    const int4 rt = route[m]; const int2 sl = slots[m]; const float w1 = __int_as_float(rt.z), w2 = __int_as_float(rt.w);
                    GAS f32x4* xr = (GAS f32x4*)(xres + (size_t)m * D) + lane; const GAS f32x4* gr = (const GAS f32x4*)g_final + lane;
                    const GAS u32x2v* y1 = (const GAS u32x2v*)(HP + (size_t)sl.x * D) + lane; const GAS u32x2v* y2 = (const GAS u32x2v*)(HP + (size_t)sl.y * D) + lane;
                    f32x4 v[4]; float s = 0.f;
#pragma unroll
                    for (int j = 0; j < 4; ++j) { v[j] = xr[64 * j]; const u32x2v a = y1[64 * j], b = y2[64 * j];
                        v[j].x += w1 * __builtin_bit_cast(float, a.x << 16) + w2 * __builtin_bit_cast(float, b.x << 16);
                        v[j].y += w1 * __builtin_bit_cast(float, a.x & 0xffff0000u) + w2 * __builtin_bit_cast(float, b.x & 0xffff0000u);
                        v[j].z += w1 * __builtin_bit_cast(float, a.y << 16) + w2 * __builtin_bit_cast(float, b.y << 16);
                        v[j].w += w1 * __builtin_bit_cast(float, a.y & 0xffff0000u) + w2 * __builtin_bit_cast(float, b.y & 0xffff0000u);
                        s += (v[j].x * v[j].x + v[j].y * v[j].y) + (v[j].z * v[j].z + v[j].w * v[j].w); }
                    const float rstd = 1.0f / sqrtf(wave_sum(s) * (1.f / D) + EPS);
#pragma unroll
                    for (int j = 0; j < 4; ++j) { const f32x4 gg = gr[64 * j]; xr[64 * j] = (f32x4){v[j].x * rstd * gg.x, v[j].y * rstd * gg.y, v[j].z * rstd * gg.z, v[j].w * rstd * gg.w}; }
                }
            PH_END(false)
        }
    }
#ifdef PROBE_CLK
    if (blockIdx.x == 0) { const unsigned long long t0_ = __builtin_amdgcn_s_memrealtime(); const unsigned long long want = (unsigned long long)(probe_cycles / 64); while (__builtin_amdgcn_s_memrealtime() - t0_ < want) __builtin_amdgcn_s_sleep(4); }
#endif
}

extern "C" void kernel_launch(void* const* d_in, const int* in_sizes, int n_in, void* d_out, int out_size, void* d_ws, size_t ws_size, hipStream_t stream) {
    static int grid = 0;
    if (grid == 0) {
        if (n_in != 16 || in_sizes[0] != T * D || out_size != T * D || ws_size < WS_END) { fprintf(stderr, "kernel_launch: unexpected shapes (n_in %d, in0 %d, out %d, ws %zu); nothing launched\n", n_in, n_in > 0 ? in_sizes[0] : -1, out_size, ws_size); grid = -1; return; }
        int dev = 0, cus = 0, per_cu = 0;
        if (hipGetDevice(&dev) != hipSuccess || hipDeviceGetAttribute(&cus, hipDeviceAttributeMultiprocessorCount, dev) != hipSuccess) { grid = -1; return; }
        if (hipFuncSetAttribute((const void*)mega_fwd, hipFuncAttributeMaxDynamicSharedMemorySize, LDS_BYTES) != hipSuccess) { fprintf(stderr, "kernel_launch: hipFuncSetAttribute failed\n"); grid = -1; return; }
        if (hipOccupancyMaxActiveBlocksPerMultiprocessor(&per_cu, (const void*)mega_fwd, NWAVES * 64, LDS_BYTES) != hipSuccess || per_cu < 1) { fprintf(stderr, "kernel_launch: occupancy query reports %d workgroups per CU\n", per_cu); }
        (void)hipGetLastError();
        grid = cus;
        while (grid > 1 && (T % grid) != 0) --grid;
    }
    if (grid < 0) return;
    if (hipMemsetAsync((char*)d_ws + WS_CTL, 0, CTL_ZERO_BYTES, stream) != hipSuccess) return;
    Args a{};
    for (int i = 0; i < 16; ++i) a.in[i] = (const float*)d_in[i];
    a.out = (float*)d_out; a.ws = (unsigned char*)d_ws;
    hipLaunchKernelGGL(mega_fwd, dim3(grid), dim3(NWAVES * 64), LDS_BYTES, stream, a);
}
```

```cpp
#include <hip/hip_runtime.h>
#include <cstdio>
#include <cstdint>
#include <cmath>
#ifndef PG8_RELAX
#define PG8_RELAX 1
#endif
namespace pg8 {
#define PG8_LAS __attribute__((address_space(3)))
typedef unsigned short bf16_t;
typedef short bf16x8 __attribute__((ext_vector_type(8)));
typedef float f32x4 __attribute__((ext_vector_type(4)));
typedef unsigned u32x4 __attribute__((ext_vector_type(4)));
constexpr int BM = 256, BK = 64, HALF = 128, HTB = HALF * BK * 2  , STAGE_BYTES = 8 * HTB, NXCD = 8, WGM = 8;

__host__ __device__ __forceinline__ int lds_byte(int r, int c) { const int st = (r >> 4) * 2 + (c >> 5), rr = r & 15, cc = c & 31, ob = rr * 64 + cc * 2; return st * 1024 + (ob ^ (((ob >> 9) & 1) << 5)); }
__host__ __device__ __forceinline__ void stage_rc(int b, int& R, int& C) { const int st = b / 1024, sb = b % 1024, swz = sb ^ (((sb >> 9) & 1) << 5); R = (st >> 1) * 16 + swz / 64; C = (st & 1) * 32 + (swz % 64) / 2; }
__host__ __device__ __forceinline__ int perm32(int rho) { const int n = rho >> 4, i = rho & 15; return 8 * (i >> 2) + 4 * n + (i & 3); }

struct Unit { int pm, pn, pb; };
struct Gemm { const bf16_t* A; const bf16_t* Bt; int M, N, K; };

struct StaticOrder {
    int nM, nN, nwg, G, c;
    __host__ __device__ void init(int M, int N, int G_, int c_) { nM = M / BM; nN = N / BM; nwg = nM * nN; G = G_; c = c_; }
    __host__ __device__ bool next(int i, Unit& u) const {
        const long L = (long)i * G + c; if (L >= nwg) return false;
        int wgid = (int)L; { const int q = nwg / NXCD, r = nwg % NXCD, xcd = wgid % NXCD, off = wgid / NXCD; wgid = (xcd < r ? xcd * (q + 1) : r * (q + 1) + (xcd - r) * q) + off; }
        const int nig = WGM * nN, gid = wgid / nig, fm = gid * WGM, gsz = (nM - fm) < WGM ? (nM - fm) : WGM;
        u.pm = fm + ((wgid % nig) % gsz); u.pn = (wgid % nig) / gsz; u.pb = u.pn; return true;
    }
    __device__ __forceinline__ void a_ready(const Unit&) const {}
    __device__ __forceinline__ void done(const Unit&) const {}
};

__device__ __forceinline__ unsigned cvt_pk_bf16(float lo, float hi) { unsigned r; asm volatile("v_cvt_pk_bf16_f32 %0, %1, %2" : "=v"(r) : "v"(lo), "v"(hi)); return r; }
typedef float f32x2 __attribute__((ext_vector_type(2)));

__device__ __forceinline__ float sigmoidf_fast(float x) { return __builtin_amdgcn_rcpf(1.0f + __builtin_amdgcn_exp2f(-1.4426950408889634f * x)); }
__device__ __forceinline__ float bf_lo(unsigned w) { return __builtin_bit_cast(float, w << 16); }
__device__ __forceinline__ float bf_hi(unsigned w) { return __builtin_bit_cast(float, w & 0xffff0000u); }
__device__ __forceinline__ void unpack8(const u32x4 w, float (&f)[8]) { f[0] = bf_lo(w.x); f[1] = bf_hi(w.x); f[2] = bf_lo(w.y); f[3] = bf_hi(w.y); f[4] = bf_lo(w.z); f[5] = bf_hi(w.z); f[6] = bf_lo(w.w); f[7] = bf_hi(w.w); }
__device__ __forceinline__ u32x4 pack8(const float (&f)[8]) { u32x4 w; w.x = cvt_pk_bf16(f[0], f[1]); w.y = cvt_pk_bf16(f[2], f[3]); w.z = cvt_pk_bf16(f[4], f[5]); w.w = cvt_pk_bf16(f[6], f[7]); return w; }

constexpr int XS_WAVE_BYTES = 2048;
__device__ __forceinline__ int xs_acc_off(int fr, int fq) { return fr * 64 + (((fq + fr) & 3) << 4); }
__device__ __forceinline__ int xs_lin_off(int lane) { const int r = lane >> 2, p = lane & 3; return r * 64 + (((p + r) & 3) << 4); }
typedef unsigned u32x2 __attribute__((ext_vector_type(2)));
__device__ __forceinline__ int xl_acc(int fr, int q) { return fr * 128 + (((q + fr) & 7) << 4); }
__device__ __forceinline__ int xl_lin(int lane, int t) { const int r = 8 * t + (lane >> 3), q = lane & 7; return r * 128 + (((q + r) & 7) << 4); }
struct EpiProj {
    static constexpr int NVMEM = 16;
    static constexpr bool PERM = true, AFTER_DRAIN = false;
    bf16_t* PA; bf16_t* QF; bf16_t* KF; bf16_t* GT; float qscale; PG8_LAS unsigned char* xs;
    __device__ __forceinline__ void operator()(const f32x4 (&acc)[2][2][4][2], const Unit& u, int wr, int wc, int fr, int fq) const {
        const int row0 = u.pm * BM + wr * 64 + fr;
        if (u.pn >= 6 && u.pn < 10) {
            const bool isq = u.pn < 8; const float sc = isq ? qscale : 1.f; bf16_t* base = isq ? QF : KF;
            const int hc0 = (u.pn - (isq ? 6 : 8)) * BM + wc * 64 + 8 * fq;
#pragma unroll
            for (int ai = 0; ai < 2; ++ai)
#pragma unroll
                for (int m = 0; m < 4; ++m) { const int row = row0 + ai * HALF + m * 16; const int b = row >> 12, t = row & 4095, blk = t >> 5, tl = t & 31;
                    const int li = isq ? tl : ((tl & 19) | ((tl & 4) << 1) | ((tl & 8) >> 1));
#pragma unroll
                    for (int bj = 0; bj < 2; ++bj) { const int hc = hc0 + bj * 32, h = hc >> 6, c = (hc & 63) >> 3, d0 = c >> 1, hg = c & 1;
                        const f32x4 v0 = acc[ai][bj][m][0] * sc, v1 = acc[ai][bj][m][1] * sc;
                        u32x4 w; w.x = cvt_pk_bf16(v0[0], v0[1]); w.y = cvt_pk_bf16(v0[2], v0[3]); w.z = cvt_pk_bf16(v1[0], v1[1]); w.w = cvt_pk_bf16(v1[2], v1[3]);
                        *(u32x4*)(base + ((((size_t)(b * 8 + h) * 128 + blk) * 4 + d0) * 64 + hg * 32 + li) * 8) = w; } }
            return;
        }
        const int lane = fr + 16 * fq;
        if (u.pn >= 10) {
            bf16_t* gb = GT + ((size_t)(u.pm * 8 + (u.pn - 10)) * 8 + (wr * 4 + wc)) * 8192 + lane * 8;
#pragma unroll
            for (int ai = 0; ai < 2; ++ai)
#pragma unroll
                for (int m = 0; m < 4; ++m)
#pragma unroll
                    for (int bj = 0; bj < 2; ++bj) { const f32x4 v0 = acc[ai][bj][m][0], v1 = acc[ai][bj][m][1];
                        u32x4 w; w.x = cvt_pk_bf16(v0[0], v0[1]); w.y = cvt_pk_bf16(v0[2], v0[3]); w.z = cvt_pk_bf16(v1[0], v1[1]); w.w = cvt_pk_bf16(v1[2], v1[3]);
                        *(u32x4*)(gb + ((ai * 4 + m) * 2 + bj) * 512) = w; }
            return;
        }
        bf16_t* base = PA; const int ldc = 1536, colt = u.pn * BM;
        PG8_LAS unsigned char* xw = xs + (wr * 4 + wc) * XS_WAVE_BYTES;
        bf16_t* lbase = base + (size_t)(u.pm * BM + wr * 64 + (lane >> 3)) * ldc + colt + wc * 64 + (lane & 7) * 8;
#pragma unroll
        for (int ai = 0; ai < 2; ++ai)
#pragma unroll
            for (int m = 0; m < 4; ++m) {
#pragma unroll
                for (int bj = 0; bj < 2; ++bj) { const f32x4 v0 = acc[ai][bj][m][0], v1 = acc[ai][bj][m][1];
                    u32x4 w; w.x = cvt_pk_bf16(v0[0], v0[1]); w.y = cvt_pk_bf16(v0[2], v0[3]); w.z = cvt_pk_bf16(v1[0], v1[1]); w.w = cvt_pk_bf16(v1[2], v1[3]);
                    *(PG8_LAS u32x4*)(xw + xl_acc(fr, 4 * bj + fq)) = w; }
#pragma unroll
                for (int t = 0; t < 2; ++t) *(u32x4*)(lbase + (size_t)(ai * HALF + m * 16 + 8 * t) * ldc) = *(const PG8_LAS u32x4*)(xw + xl_lin(lane, t)); }
    }
};
struct EpiVT {
    static constexpr int NVMEM = 16;
    static constexpr bool PERM = true, AFTER_DRAIN = false;
    bf16_t* VF;
    __device__ __forceinline__ void operator()(const f32x4 (&acc)[2][2][4][2], const Unit& u, int wr, int wc, int fr, int fq) const {
        const int row0 = u.pm * BM + wr * 64 + fr, tok0 = u.pn * BM + wc * 64 + 8 * fq;
#pragma unroll
        for (int ai = 0; ai < 2; ++ai)
#pragma unroll
            for (int m = 0; m < 4; ++m) { const int hd = row0 + ai * HALF + m * 16, h = hd >> 6, dblk = (hd >> 5) & 1, dl = hd & 31;
#pragma unroll
                for (int bj = 0; bj < 2; ++bj) { const int tok = tok0 + bj * 32, b = tok >> 12, t = tok & 4095, blk = t >> 5, s = (t >> 4) & 1, hg = (t >> 3) & 1;
                    const f32x4 v0 = acc[ai][bj][m][0], v1 = acc[ai][bj][m][1];
                    u32x4 w; w.x = cvt_pk_bf16(v0[0], v0[1]); w.y = cvt_pk_bf16(v0[2], v0[3]); w.z = cvt_pk_bf16(v1[0], v1[1]); w.w = cvt_pk_bf16(v1[2], v1[3]);
                    *(u32x4*)(VF + ((((size_t)(b * 8 + h) * 128 + blk) * 4 + dblk * 2 + s) * 64 + hg * 32 + dl) * 8) = w; } }
    }
};
struct EpiPlain {
    static constexpr int NVMEM = 16;
    static constexpr bool PERM = true, AFTER_DRAIN = false;
    bf16_t* O; int ldc;
    __device__ __forceinline__ void operator()(const f32x4 (&acc)[2][2][4][2], const Unit& u, int wr, int wc, int fr, int fq) const {
        const int row0 = u.pm * BM + wr * 64 + fr, col0 = u.pn * BM + wc * 32 + 8 * fq;
#pragma unroll
        for (int ai = 0; ai < 2; ++ai)
#pragma unroll
            for (int m = 0; m < 4; ++m) { bf16_t* rowp = O + (size_t)(row0 + ai * HALF + m * 16) * ldc + col0;
#pragma unroll
                for (int bj = 0; bj < 2; ++bj) { const f32x4 v0 = acc[ai][bj][m][0], v1 = acc[ai][bj][m][1];
                    u32x4 w; w.x = cvt_pk_bf16(v0[0], v0[1]); w.y = cvt_pk_bf16(v0[2], v0[3]); w.z = cvt_pk_bf16(v1[0], v1[1]); w.w = cvt_pk_bf16(v1[2], v1[3]);
                    *(u32x4*)(rowp + bj * HALF) = w; } }
    }
};
struct EpiSwiGLU {
    static constexpr int NVMEM = 8;
    static constexpr bool PERM = true, AFTER_DRAIN = false;
    bf16_t* O; int ldc; PG8_LAS unsigned char* xs;
    __device__ __forceinline__ void operator()(const f32x4 (&acc)[2][2][4][2], const Unit& u, int wr, int wc, int fr, int fq) const {
        const int lane = fr + 16 * fq, lr = lane >> 2, lp = lane & 3, oa = xs_acc_off(fr, fq), ol = xs_lin_off(lane);
        PG8_LAS unsigned char* xw = xs + (wr * 4 + wc) * XS_WAVE_BYTES;
        bf16_t* lbase = O + (size_t)(u.pm * BM + wr * 64 + lr) * ldc + u.pn * HALF + wc * 32 + lp * 8;
#pragma unroll
        for (int ai = 0; ai < 2; ++ai)
#pragma unroll
            for (int mp = 0; mp < 2; ++mp) {
#pragma unroll
                for (int mm = 0; mm < 2; ++mm) { const int m = 2 * mp + mm; float o[8];
#pragma unroll
                    for (int n = 0; n < 2; ++n)
#pragma unroll
                        for (int i = 0; i < 4; ++i) { const float g = acc[ai][0][m][n][i], up = acc[ai][1][m][n][i]; o[4 * n + i] = g * sigmoidf_fast(g) * up; }
                    *(PG8_LAS u32x4*)(xw + mm * 1024 + oa) = pack8(o); }
#pragma unroll
                for (int mm = 0; mm < 2; ++mm) *(u32x4*)(lbase + (size_t)(ai * HALF + (2 * mp + mm) * 16) * ldc) = *(const PG8_LAS u32x4*)(xw + mm * 1024 + ol); }
    }
};
struct EpiGateA {
    static constexpr int NVMEM = 32;
    static constexpr bool PERM = true, AFTER_DRAIN = false;
    const bf16_t* GT; bf16_t* TMP; PG8_LAS unsigned char* xs;
    __device__ __forceinline__ void operator()(const f32x4 (&acc)[2][2][4][2], const Unit& u, int wr, int wc, int fr, int fq) const {
        const int lane = fr + 16 * fq;
        const bf16_t* gp = GT + ((size_t)(u.pm * 8 + u.pn) * 8 + (wr * 4 + wc)) * 8192 + lane * 8;
        bf16_t* tp = TMP + ((size_t)(u.pm * 4 + u.pn) * 8 + (wr * 4 + wc)) * 8192 + lane * 8;
#pragma unroll
        for (int ai = 0; ai < 2; ++ai)
#pragma unroll
            for (int m = 0; m < 4; ++m)
#pragma unroll
                for (int bj = 0; bj < 2; ++bj) { const int o = ((ai * 4 + m) * 2 + bj) * 512;
                    float g[8], ov[8]; unpack8(*(const u32x4*)(gp + o), g);
#pragma unroll
                    for (int n = 0; n < 2; ++n)
#pragma unroll
                        for (int i = 0; i < 4; ++i) ov[4 * n + i] = sigmoidf_fast(g[4 * n + i]) * acc[ai][bj][m][n][i];
                    *(u32x4*)(tp + o) = pack8(ov); }
    }
};
struct EpiGateB {
    static constexpr int NVMEM = 48;
    static constexpr bool PERM = true, AFTER_DRAIN = false;
    const bf16_t* GT; const bf16_t* TMP; bf16_t* MIX; PG8_LAS unsigned char* xs;
    __device__ __forceinline__ void operator()(const f32x4 (&acc)[2][2][4][2], const Unit& u, int wr, int wc, int fr, int fq) const {
        const int lane = fr + 16 * fq;
        PG8_LAS unsigned char* xw = xs + (wr * 4 + wc) * XS_WAVE_BYTES;
        const bf16_t* gp = GT + ((size_t)(u.pm * 8 + 4 + u.pn) * 8 + (wr * 4 + wc)) * 8192 + lane * 8;
        const bf16_t* tp = TMP + ((size_t)(u.pm * 4 + u.pn) * 8 + (wr * 4 + wc)) * 8192 + lane * 8;
        bf16_t* lbase = MIX + (size_t)(u.pm * BM + wr * 64 + (lane >> 3)) * 1024 + u.pn * BM + wc * 64 + (lane & 7) * 8;
#pragma unroll
        for (int ai = 0; ai < 2; ++ai)
#pragma unroll
            for (int m = 0; m < 4; ++m) {
#pragma unroll
                for (int bj = 0; bj < 2; ++bj) { const int o = ((ai * 4 + m) * 2 + bj) * 512;
                    float g[8], tv[8], ov[8]; unpack8(*(const u32x4*)(gp + o), g); unpack8(*(const u32x4*)(tp + o), tv);
#pragma unroll
                    for (int n = 0; n < 2; ++n)
#pragma unroll
                        for (int i = 0; i < 4; ++i) ov[4 * n + i] = tv[4 * n + i] + sigmoidf_fast(g[4 * n + i]) * acc[ai][bj][m][n][i];
                    *(PG8_LAS u32x4*)(xw + xl_acc(fr, 4 * bj + fq)) = pack8(ov); }
#pragma unroll
                for (int t = 0; t < 2; ++t) *(u32x4*)(lbase + (size_t)(ai * HALF + m * 16 + 8 * t) * 1024) = *(const PG8_LAS u32x4*)(xw + xl_lin(lane, t)); }
    }
};
struct EpiRes {
    static constexpr int NVMEM = 32;
    static constexpr bool PERM = false, AFTER_DRAIN = false;
    const float* base; float* out; int ldc; float sc; PG8_LAS unsigned char* xs;
    __device__ __forceinline__ void operator()(const f32x4 (&acc)[2][2][4][2], const Unit& u, int wr, int wc, int fr, int fq) const {
        const int lane = fr + 16 * fq;
        PG8_LAS unsigned char* xw = xs + (wr * 4 + wc) * XS_WAVE_BYTES;
        const size_t loff = (size_t)(u.pm * BM + wr * 64 + (lane >> 3)) * ldc + u.pn * BM + wc * 64 + (lane & 7) * 4;
#pragma unroll
        for (int ai = 0; ai < 2; ++ai)
#pragma unroll
            for (int m = 0; m < 4; ++m)
#pragma unroll
                for (int bj = 0; bj < 2; ++bj) { const size_t o0 = loff + (size_t)(ai * HALF + m * 16) * ldc + bj * 32;
#pragma unroll
                    for (int t = 0; t < 2; ++t) *(PG8_LAS f32x4*)(xw + xl_lin(lane, t)) = *(const f32x4*)(base + o0 + (size_t)(8 * t) * ldc);
#pragma unroll
                    for (int n = 0; n < 2; ++n) { const f32x4 bv = *(const PG8_LAS f32x4*)(xw + xl_acc(fr, 4 * n + fq)); *(PG8_LAS f32x4*)(xw + xl_acc(fr, 4 * n + fq)) = bv + acc[ai][bj][m][n] * sc; }
#pragma unroll
                    for (int t = 0; t < 2; ++t) *(f32x4*)(out + o0 + (size_t)(8 * t) * ldc) = *(const PG8_LAS f32x4*)(xw + xl_lin(lane, t)); }
    }
};
__device__ __forceinline__ unsigned pk4_fp8(float a, float b, float c, float d) {
    a = __builtin_amdgcn_fmed3f(a, -448.f, 448.f); b = __builtin_amdgcn_fmed3f(b, -448.f, 448.f); c = __builtin_amdgcn_fmed3f(c, -448.f, 448.f); d = __builtin_amdgcn_fmed3f(d, -448.f, 448.f);
    int w = 0; w = __builtin_amdgcn_cvt_pk_fp8_f32(a, b, w, false); w = __builtin_amdgcn_cvt_pk_fp8_f32(c, d, w, true); return (unsigned)w;
}
struct EpiSwiGLU8 {
    static constexpr int NVMEM = 8;
    static constexpr bool PERM = true, AFTER_DRAIN = false;
    unsigned char* O; int ldc; float wsc, osc; PG8_LAS unsigned char* xs;
    __device__ __forceinline__ void operator()(const f32x4 (&acc)[2][2][4][2], const Unit& u, int wr, int wc, int fr, int fq) const {
        const int lane = fr + 16 * fq, lr = lane >> 2, lp = lane & 3;
        const int oa = fr * 32 + (((fq + (fr >> 1)) & 3) << 3), ol = lr * 32 + (((lp + (lr >> 1)) & 3) << 3);
        PG8_LAS unsigned char* xw = xs + (wr * 4 + wc) * XS_WAVE_BYTES;
        unsigned char* lbase = O + (size_t)(u.pm * BM + wr * 64 + lr) * ldc + u.pn * HALF + wc * 32 + lp * 8;
#pragma unroll
        for (int ai = 0; ai < 2; ++ai) {
#pragma unroll
            for (int m = 0; m < 4; ++m) { float o[8];
#pragma unroll
                for (int n = 0; n < 2; ++n)
#pragma unroll
                    for (int i = 0; i < 4; ++i) { const float g = acc[ai][0][m][n][i] * wsc, up = acc[ai][1][m][n][i] * wsc; o[4 * n + i] = g * sigmoidf_fast(g) * up * osc; }
                u32x2 w; w.x = pk4_fp8(o[0], o[1], o[2], o[3]); w.y = pk4_fp8(o[4], o[5], o[6], o[7]);
                *(PG8_LAS u32x2*)(xw + m * 512 + oa) = w; }
#pragma unroll
            for (int m = 0; m < 4; ++m) *(u32x2*)(lbase + (size_t)(ai * HALF + m * 16) * ldc) = *(const PG8_LAS u32x2*)(xw + m * 512 + ol); }
    }
};
struct EpiPlainS {
    static constexpr int NVMEM = 16;
    static constexpr bool PERM = true, AFTER_DRAIN = false;
    bf16_t* O; int ldc; float sc; PG8_LAS unsigned char* xs;
    __device__ __forceinline__ void operator()(const f32x4 (&acc)[2][2][4][2], const Unit& u, int wr, int wc, int fr, int fq) const {
        const int lane = fr + 16 * fq;
        PG8_LAS unsigned char* xw = xs + (wr * 4 + wc) * XS_WAVE_BYTES;
        bf16_t* lbase = O + (size_t)(u.pm * BM + wr * 64 + (lane >> 3)) * ldc + u.pn * BM + wc * 64 + (lane & 7) * 8;
#pragma unroll
        for (int ai = 0; ai < 2; ++ai)
#pragma unroll
            for (int m = 0; m < 4; ++m) {
#pragma unroll
                for (int bj = 0; bj < 2; ++bj) { const f32x4 v0 = acc[ai][bj][m][0] * sc, v1 = acc[ai][bj][m][1] * sc;
                    u32x4 w; w.x = cvt_pk_bf16(v0[0], v0[1]); w.y = cvt_pk_bf16(v0[2], v0[3]); w.z = cvt_pk_bf16(v1[0], v1[1]); w.w = cvt_pk_bf16(v1[2], v1[3]);
                    *(PG8_LAS u32x4*)(xw + xl_acc(fr, 4 * bj + fq)) = w; }
#pragma unroll
                for (int t = 0; t < 2; ++t) *(u32x4*)(lbase + (size_t)(ai * HALF + m * 16 + 8 * t) * ldc) = *(const PG8_LAS u32x4*)(xw + xl_lin(lane, t)); }
    }
};
struct EpiNull {
    static constexpr int NVMEM = 0;
    static constexpr bool PERM = true, AFTER_DRAIN = false;
    __device__ __forceinline__ void operator()(const f32x4 (&acc)[2][2][4][2], const Unit& u, int wr, int wc, int fr, int fq) const {
#pragma unroll
        for (int ai = 0; ai < 2; ++ai)
#pragma unroll
            for (int bj = 0; bj < 2; ++bj)
#pragma unroll
                for (int m = 0; m < 4; ++m)
#pragma unroll
                    for (int n = 0; n < 2; ++n) asm volatile("" :: "v"(acc[ai][bj][m][n]));
    }
};
struct EpiL2 {
    static constexpr int NVMEM = 16;
    static constexpr bool PERM = true, AFTER_DRAIN = false;
    bf16_t* S; int bx;
    __device__ __forceinline__ void operator()(const f32x4 (&acc)[2][2][4][2], const Unit& u, int wr, int wc, int fr, int fq) const {
        const int row0 = wr * 64 + fr, col0 = wc * 32 + 8 * fq; bf16_t* base = S + (size_t)(bx & 7) * 64;
#pragma unroll
        for (int ai = 0; ai < 2; ++ai)
#pragma unroll
            for (int m = 0; m < 4; ++m) {
#ifdef PROBE_L2W
                bf16_t* rowp = base + (size_t)(((wr * 4 + wc) * 16 + ai * 8 + m * 2) * 8 + ((fr + 16 * fq) >> 3)) * 4608 + ((fr + 16 * fq) & 7) * 8;
#else
                bf16_t* rowp = base + (size_t)(row0 + ai * HALF + m * 16) * 256 + col0;
#endif
#pragma unroll
                for (int bj = 0; bj < 2; ++bj) { const f32x4 v0 = acc[ai][bj][m][0], v1 = acc[ai][bj][m][1];
                    u32x4 w; w.x = cvt_pk_bf16(v0[0], v0[1]); w.y = cvt_pk_bf16(v0[2], v0[3]); w.z = cvt_pk_bf16(v1[0], v1[1]); w.w = cvt_pk_bf16(v1[2], v1[3]);
#ifdef PROBE_L2ONE
                    if (ai == 0 && m == 0 && bj == 0) *(u32x4*)(rowp + bj * HALF) = w; else asm volatile("" :: "v"(w));
#elif defined(PROBE_L2W)
                    *(u32x4*)(rowp + bj * 8 * 4608) = w;
#else
                    *(u32x4*)(rowp + bj * HALF) = w;
#endif
                    } }
    }
};
struct MoeOrder : StaticOrder {
    const volatile PG8_LAS unsigned* offs; int ntn;
    __device__ __forceinline__ bool next(int i, Unit& u) const {
        if (!StaticOrder::next(i, u)) return false;
        const unsigned row = (unsigned)u.pm * BM; int e = 0;
#pragma unroll
        for (int k = 1; k < 8; ++k) e += (row >= offs[k]) ? 1 : 0;
        u.pb = e * ntn + u.pn; return true;
    }
};
typedef int i32x8 __attribute__((ext_vector_type(8))); typedef int i32x4 __attribute__((ext_vector_type(4)));
__device__ __forceinline__ i32x8 cat8(const bf16x8 lo, const bf16x8 hi) { const i32x4 a = __builtin_bit_cast(i32x4, lo), b = __builtin_bit_cast(i32x4, hi); return (i32x8){a.x, a.y, a.z, a.w, b.x, b.y, b.z, b.w}; }
template <class Epi, class Sched, bool ALIGN_EPI = false, bool SP2 = false, bool FP8 = false>
__device__ __forceinline__ void gemm_phase(PG8_LAS unsigned char* lds, const Gemm g, const Sched& S, const Epi& E, const int tid) {
    const int wid = __builtin_amdgcn_readfirstlane(tid >> 6), lane = tid & 63, wr = wid >> 2, wc = wid & 3, fr = lane & 15, fq = lane >> 4;
    const int K = g.K, nt = K / BK;
    unsigned voffA[2], voffB[2];
#pragma unroll
    for (int i = 0; i < 2; ++i) { int R, C; stage_rc(tid * 16 + i * 8192, R, C); const int Rb = 64 * (R >> 5) + (Epi::PERM ? perm32(R & 31) : (R & 31));
        voffA[i] = (unsigned)(R * K + C) * 2u; voffB[i] = (unsigned)(Rb * K + C) * 2u; }
    const size_t kstep = (size_t)(BK * 2);
    const size_t hstep = (size_t)HALF * K * 2;
    const size_t hstepB = (size_t)32 * K * 2;
    const size_t tstep = 2 * hstep;
    const unsigned ldsw = (unsigned)wid * 1024u;
    const int aoff = lds_byte(wr * 64 + fr, fq * 8), boff = lds_byte(wc * 32 + fr, fq * 8);
#define PG8_SA(b, h) (((b) * 2 + (h)) * HTB)
#define PG8_SB(b, h) ((4 + (b) * 2 + (h)) * HTB)
#define PG8_STAGE(bufoff, gbase, voff) do { _Pragma("unroll") for (int _i = 0; _i < 2; ++_i) \
        __builtin_amdgcn_global_load_lds((const unsigned*)((const char*)(gbase) + (voff)[_i]), (PG8_LAS unsigned*)(lds + (bufoff) + ldsw + _i * 8192), 16, 0, 0); } while (0)
#define PG8_LDA(dst, b, h) do { if constexpr (FP8) { _Pragma("unroll") for (int m = 0; m < 4; ++m) { const i32x4 l_ = *(const PG8_LAS i32x4*)(lds + PG8_SA(b, h) + aoff + m * 2048), h_ = *(const PG8_LAS i32x4*)(lds + PG8_SA(b, h) + aoff + m * 2048 + 1024); dst##8[m] = (i32x8){l_.x, l_.y, l_.z, l_.w, h_.x, h_.y, h_.z, h_.w}; } } \
        else { _Pragma("unroll") for (int m = 0; m < 4; ++m) _Pragma("unroll") for (int k = 0; k < 2; ++k) dst[m][k] = *(const PG8_LAS i32x4*)(lds + PG8_SA(b, h) + aoff + m * 2048 + k * 1024); } } while (0)
#define PG8_LDB(dst, b, h) do { if constexpr (FP8) { _Pragma("unroll") for (int n = 0; n < 2; ++n) { const i32x4 l_ = *(const PG8_LAS i32x4*)(lds + PG8_SB(b, h) + boff + n * 2048), h_ = *(const PG8_LAS i32x4*)(lds + PG8_SB(b, h) + boff + n * 2048 + 1024); dst##8[n] = (i32x8){l_.x, l_.y, l_.z, l_.w, h_.x, h_.y, h_.z, h_.w}; } } \
        else { _Pragma("unroll") for (int n = 0; n < 2; ++n) _Pragma("unroll") for (int k = 0; k < 2; ++k) dst[n][k] = *(const PG8_LAS i32x4*)(lds + PG8_SB(b, h) + boff + n * 2048 + k * 1024); } } while (0)
#define PG8_MMA(ai, bj, At, Bt) do { __builtin_amdgcn_s_setprio(1); \
        if constexpr (FP8) { _Pragma("unroll") for (int m = 0; m < 4; ++m) _Pragma("unroll") for (int n = 0; n < 2; ++n) \
            asm volatile("v_mfma_scale_f32_16x16x128_f8f6f4 %0, %1, %2, %0, %3, %3 op_sel_hi:[0,0,0]" : "+v"(acc[ai][bj][m][n]) : "v"(Bt##8[n]), "v"(At##8[m]), "v"(sc1_)); } \
        else { _Pragma("unroll") for (int m = 0; m < 4; ++m) _Pragma("unroll") for (int n = 0; n < 2; ++n) _Pragma("unroll") for (int k = 0; k < 2; ++k) \
            acc[ai][bj][m][n] = __builtin_amdgcn_mfma_f32_16x16x32_bf16(__builtin_bit_cast(bf16x8, Bt[n][k]), __builtin_bit_cast(bf16x8, At[m][k]), acc[ai][bj][m][n], 0, 0, 0); } \
        __builtin_amdgcn_s_setprio(0); } while (0)
#define PG8_WAIT_V(n) asm volatile("s_waitcnt vmcnt(" #n ")" ::: "memory")
#define PG8_WAIT_V8R(rel) asm volatile("s_cmp_lg_u32 %0, 0\n\ts_cbranch_scc1 1\n\ts_waitcnt vmcnt(8)\n\ts_waitcnt vmcnt(%1)" :: "s"(rel), "n"(8 + (Epi::NVMEM > 55 ? 55 : Epi::NVMEM)) : "memory", "scc")
#define PG8_WAIT_L(n) asm volatile("s_waitcnt lgkmcnt(" #n ")" ::: "memory")
#define PG8_BAR __builtin_amdgcn_s_barrier()
#define PG8_SCHED __builtin_amdgcn_sched_barrier(0)
    Unit cur, nxt; int ui = 0;
    if (!S.next(0, cur)) return;
    f32x4 acc[2][2][4][2];
#pragma unroll
    for (int a = 0; a < 2; ++a)
#pragma unroll
        for (int b = 0; b < 2; ++b)
#pragma unroll
            for (int m = 0; m < 4; ++m)
#pragma unroll
                for (int n = 0; n < 2; ++n) acc[a][b][m][n] = (f32x4){0.f, 0.f, 0.f, 0.f};
    int sc1_ = 0x7f7f7f7f; asm volatile("" : "+v"(sc1_));
    typedef i32x4 frag_t; frag_t At[4][2], B0[2][2], B1[2][2]; i32x8 At8[4], B08[2], B18[2];
    const char* cA = (const char*)g.A + (size_t)cur.pm * tstep; const char* cB = (const char*)g.Bt + (size_t)cur.pb * tstep;
    S.a_ready(cur);
    if constexpr (SP2) {
        PG8_STAGE(PG8_SB(0, 0), cB, voffB); PG8_STAGE(PG8_SB(0, 1), cB + hstepB, voffB); PG8_STAGE(PG8_SA(0, 0), cA, voffA); PG8_STAGE(PG8_SA(0, 1), cA + hstep, voffA);
        if (wr == 1) PG8_BAR;
        PG8_WAIT_V(2); PG8_BAR;
        PG8_STAGE(PG8_SB(1, 0), cB + kstep, voffB); PG8_STAGE(PG8_SA(1, 0), cA + kstep, voffA); PG8_STAGE(PG8_SB(1, 1), cB + hstepB + kstep, voffB);
        PG8_WAIT_V(6); PG8_BAR;
    } else {
        PG8_STAGE(PG8_SB(0, 0), cB, voffB); PG8_STAGE(PG8_SA(0, 0), cA, voffA); PG8_STAGE(PG8_SB(0, 1), cB + hstepB, voffB); PG8_STAGE(PG8_SA(0, 1), cA + hstep, voffA);
        if (wr == 1) PG8_BAR;
        PG8_WAIT_V(4); PG8_BAR;
        PG8_STAGE(PG8_SB(1, 0), cB + kstep, voffB); PG8_STAGE(PG8_SA(1, 0), cA + kstep, voffA); PG8_STAGE(PG8_SB(1, 1), cB + hstepB + kstep, voffB);
        PG8_WAIT_V(6); PG8_BAR;
    }
    for (;;) {
        const bool has_next = S.next(ui + 1, nxt);
        const char* nA = has_next ? (const char*)g.A + (size_t)nxt.pm * tstep : cA; const char* nB = has_next ? (const char*)g.Bt + (size_t)nxt.pb * tstep : cB;
        for (int t = 0; t < nt; t += 2) {
            const bool last = (t == nt - 2);
            const int relax = __builtin_amdgcn_readfirstlane((PG8_RELAX && (t == 0) && (ui > 0)) ? 1 : 0);
            const char* a1 = cA + (size_t)(t + 1) * kstep;
            const char* a2 = last ? nA : cA + (size_t)(t + 2) * kstep; const char* b2 = last ? nB : cB + (size_t)(t + 2) * kstep;
            const char* a3 = a2 + kstep; const char* b3 = b2 + kstep;
            if (last && has_next) S.a_ready(nxt);
            if constexpr (SP2) {
            PG8_LDB(B0, 0, 0); PG8_LDB(B1, 0, 1); PG8_SCHED; PG8_LDA(At, 0, 0); PG8_STAGE(PG8_SA(1, 1), a1 + hstep, voffA);
            PG8_WAIT_V8R(relax); PG8_WAIT_L(0); PG8_BAR; PG8_MMA(0, 0, At, B0); PG8_MMA(0, 1, At, B1); PG8_BAR; PG8_SCHED;
            PG8_LDA(At, 0, 1); PG8_STAGE(PG8_SB(0, 0), b2, voffB); PG8_STAGE(PG8_SB(0, 1), b2 + hstepB, voffB); PG8_STAGE(PG8_SA(0, 0), a2, voffA);
            PG8_WAIT_V8R(relax); PG8_WAIT_L(0); PG8_BAR; PG8_MMA(1, 0, At, B0); PG8_MMA(1, 1, At, B1); PG8_BAR; PG8_SCHED;
            PG8_LDB(B0, 1, 0); PG8_LDB(B1, 1, 1); PG8_SCHED; PG8_LDA(At, 1, 0); PG8_STAGE(PG8_SA(0, 1), a2 + hstep, voffA);
            PG8_WAIT_V(8); PG8_WAIT_L(0); PG8_BAR; PG8_MMA(0, 0, At, B0); PG8_MMA(0, 1, At, B1); PG8_BAR; PG8_SCHED;
            PG8_LDA(At, 1, 1); PG8_STAGE(PG8_SB(1, 0), b3, voffB); PG8_STAGE(PG8_SB(1, 1), b3 + hstepB, voffB); PG8_STAGE(PG8_SA(1, 0), a3, voffA);
            PG8_WAIT_V(8); PG8_WAIT_L(0); PG8_BAR; PG8_MMA(1, 0, At, B0); PG8_MMA(1, 1, At, B1); PG8_BAR; PG8_SCHED;
            } else {
            PG8_LDB(B0, 0, 0); PG8_SCHED; PG8_LDA(At, 0, 0); PG8_STAGE(PG8_SA(1, 1), a1 + hstep, voffA);
            PG8_WAIT_L(8); PG8_BAR; PG8_WAIT_L(0); PG8_MMA(0, 0, At, B0); PG8_BAR; PG8_SCHED;
            PG8_LDB(B1, 0, 1); PG8_STAGE(PG8_SB(0, 0), b2, voffB);
            PG8_BAR; PG8_WAIT_L(0); PG8_MMA(0, 1, At, B1); PG8_BAR;
            PG8_LDA(At, 0, 1); PG8_STAGE(PG8_SA(0, 0), a2, voffA);
            PG8_BAR; PG8_WAIT_L(0); PG8_MMA(1, 0, At, B0); PG8_BAR; PG8_SCHED;
            PG8_STAGE(PG8_SB(0, 1), b2 + hstepB, voffB);
            PG8_WAIT_V(6); PG8_BAR; PG8_MMA(1, 1, At, B1); PG8_BAR;
            PG8_LDB(B0, 1, 0); PG8_SCHED; PG8_LDA(At, 1, 0); PG8_STAGE(PG8_SA(0, 1), a2 + hstep, voffA);
            PG8_WAIT_L(8); PG8_BAR; PG8_WAIT_L(0); PG8_MMA(0, 0, At, B0); PG8_BAR; PG8_SCHED;
            PG8_LDB(B1, 1, 1); PG8_STAGE(PG8_SB(1, 0), b3, voffB);
            PG8_BAR; PG8_WAIT_L(0); PG8_MMA(0, 1, At, B1); PG8_BAR;
            PG8_LDA(At, 1, 1); PG8_STAGE(PG8_SA(1, 0), a3, voffA);
            PG8_BAR; PG8_WAIT_L(0); PG8_MMA(1, 0, At, B0); PG8_BAR; PG8_SCHED;
            PG8_STAGE(PG8_SB(1, 1), b3 + hstepB, voffB);
            PG8_WAIT_V(6); PG8_BAR; PG8_MMA(1, 1, At, B1); PG8_BAR;
            }
        }
        if constexpr (FP8) asm volatile("s_nop 15\n\ts_nop 15" ::: "memory");
        if constexpr (ALIGN_EPI) { if (wr == 0) PG8_BAR; }
        if constexpr (!Epi::AFTER_DRAIN) { E(acc, cur, wr, wc, fr, fq); S.done(cur); }
        if (!has_next) break;
#pragma unroll
        for (int a = 0; a < 2; ++a)
#pragma unroll
            for (int b = 0; b < 2; ++b)
#pragma unroll
                for (int m = 0; m < 4; ++m)
#pragma unroll
                    for (int n = 0; n < 2; ++n) acc[a][b][m][n] = (f32x4){0.f, 0.f, 0.f, 0.f};
        cur = nxt; cA = nA; cB = nB; ++ui;
        if constexpr (ALIGN_EPI) { if (wr == 1) PG8_BAR; }
    }
    PG8_WAIT_V(0);
    if constexpr (!ALIGN_EPI) { if (wr == 0) PG8_BAR; }
    PG8_BAR;
    if constexpr (Epi::AFTER_DRAIN) { E.fused(acc, cur, wr, wc, fr, fq, lds, wid, lane); S.done(cur); }
#undef PG8_SA
#undef PG8_SB
#undef PG8_STAGE
#undef PG8_LDA
#undef PG8_LDB
#undef PG8_MMA
#undef PG8_WAIT_V
#undef PG8_WAIT_V8R
#undef PG8_WAIT_L
#undef PG8_BAR
#undef PG8_SCHED
}
}
#define GAS __attribute__((address_space(1)))
#define LAS __attribute__((address_space(3)))
typedef unsigned short bf16;
typedef unsigned v4u __attribute__((ext_vector_type(4)));
typedef float f32x4 __attribute__((ext_vector_type(4)));
typedef short bf16x8 __attribute__((ext_vector_type(8)));
typedef GAS unsigned gu32;
typedef GAS unsigned long long gu64;
#define RLX_AGENT __ATOMIC_RELAXED, __HIP_MEMORY_SCOPE_AGENT
#define LDS_WAIT() asm volatile("s_waitcnt lgkmcnt(0)" ::: "memory")
#define VM_WAIT() asm volatile("s_waitcnt vmcnt(0)" ::: "memory")
__device__ __forceinline__ unsigned long long rt() { return __builtin_amdgcn_s_memrealtime(); }
__device__ __forceinline__ unsigned f2bf(float f) { unsigned u = __builtin_bit_cast(unsigned, f); return (u + 0x7fffu + ((u >> 16) & 1u)) >> 16; }
__device__ __forceinline__ unsigned pk2(float lo, float hi) { return f2bf(lo) | (f2bf(hi) << 16); }

#define XB_TMO      128
#define XB_XCNT(j)  (256  + 64 * (j))
#define XB_XSUB(j)  (1280 + 64 * (j))
#define XB_XGEN(j)  (2304 + 64 * (j))
#define XB_TOP      3328
#define XB_TOPGEN   3392
#define XCD_BAR_WORDS 3456
#define XB_SPIN_CAP (1u << 18)

__device__ __forceinline__ unsigned xb_ld(unsigned* p)              { return __hip_atomic_load(p, __ATOMIC_RELAXED, __HIP_MEMORY_SCOPE_AGENT); }
__device__ __forceinline__ unsigned xb_add(unsigned* p, unsigned v) { return __hip_atomic_fetch_add(p, v, __ATOMIC_RELAXED, __HIP_MEMORY_SCOPE_AGENT); }
__device__ __forceinline__ unsigned xb_xcc_id() { return (unsigned)__builtin_amdgcn_s_getreg((3 << 11) | 20) & 0xFu; }
#define XB_SPIN(cond, bar) do { unsigned _sp = 0; while (cond) { __builtin_amdgcn_s_sleep(1); \
    if ((++_sp & 255u) == 0u) { if (xb_ld(&(bar)[XB_TMO])) break; if (_sp > XB_SPIN_CAP) { atomicAdd(&(bar)[XB_TMO], 1u); break; } } } } while (0)

struct XcdBarrier {
    unsigned* bar; unsigned x;
    volatile LAS unsigned* st;
};

__device__ __forceinline__ XcdBarrier xcd_barrier_post(unsigned* bar, volatile LAS unsigned* st) {
    XcdBarrier b; b.bar = bar; b.x = xb_xcc_id(); b.st = st;
    if (threadIdx.x == 0) (void)xb_add(&bar[XB_XCNT(b.x)], 1u);
    return b;
}
__device__ __forceinline__ void xcd_barrier_complete(unsigned* bar, unsigned x, unsigned& nloc, unsigned& nx) {
    const unsigned G = gridDim.x * gridDim.y * gridDim.z;
    unsigned sum, cnt, mine, sp = 0u;
    for (;;) {
        sum = 0u; cnt = 0u; mine = 0u;
#pragma unroll
        for (unsigned j = 0; j < 16; ++j) { const unsigned c = xb_ld(&bar[XB_XCNT(j)]); sum += c; cnt += (c > 0u) ? 1u : 0u; mine = (j == x) ? c : mine; }
        if (sum == G) break;
        __builtin_amdgcn_s_sleep(1);
        if ((++sp & 255u) == 0u) { if (xb_ld(&bar[XB_TMO])) break; if (sp > XB_SPIN_CAP) { atomicAdd(&bar[XB_TMO], 1u); break; } }
    }
    nloc = mine > 0u ? mine : 1u; nx = cnt > 0u ? cnt : 1u;
}

__device__ __forceinline__ void xcd_barrier(const XcdBarrier& b) {
    asm volatile("s_waitcnt vmcnt(0)" ::: "memory");
    __syncthreads();
    if (threadIdx.x == 0) {
        unsigned* bar = b.bar;
        __builtin_amdgcn_s_waitcnt(0);
        unsigned nloc = b.st[0], nx = b.st[1];
        if (nloc == 0u) { xcd_barrier_complete(bar, b.x, nloc, nx); b.st[0] = nloc; b.st[1] = nx; }
        const unsigned old = xb_add(&bar[XB_XSUB(b.x)], 1u);
        const unsigned gen = old / nloc;
        if (old + 1u == (gen + 1u) * nloc) {
            __builtin_amdgcn_fence(__ATOMIC_RELEASE, "agent");
            asm volatile("s_waitcnt vmcnt(0)" ::: "memory");
            const unsigned og = xb_add(&bar[XB_TOP], 1u);
            const unsigned tg = og / nx;
            if (og + 1u == (tg + 1u) * nx) xb_add(&bar[XB_TOPGEN], 1u);
            else XB_SPIN(xb_ld(&bar[XB_TOPGEN]) == tg, bar);
            __builtin_amdgcn_fence(__ATOMIC_ACQUIRE, "agent");
            xb_add(&bar[XB_XGEN(b.x)], 1u);
            asm volatile("s_waitcnt vmcnt(0)" ::: "memory");
        } else {
            XB_SPIN(xb_ld(&bar[XB_XGEN(b.x)]) == gen, bar);
            __builtin_amdgcn_fence(__ATOMIC_ACQUIRE, "agent");
            asm volatile("s_waitcnt vmcnt(0)" ::: "memory");
        }
    }
    __syncthreads();
}

constexpr int NWAVES = 8;
constexpr int BATCH = 8, SEQ = 4096, D = 1024, T = BATCH * SEQ, DEPTH = 2;
constexpr int DCONV = 512, NHEAD = 8, HD = 64, DATTN = 512, DFF = 2816, NEXP = 8, DFFE = 2048;
constexpr int NIN = 5120, NPA = 1536, NQK = 1024, NGT = 2048, NPROJ = NPA + NQK + NGT;
constexpr float EPS = 1e-6f;
constexpr float QSCALE = 0.125f * 1.4426950408889634f;
constexpr int MPAD = 2 * T + NEXP * 256;
constexpr int VTP = T + 64;

constexpr size_t MiB = 1u << 20;
constexpr size_t WS_CTL = 0, CTL_ZERO_BYTES = 1 * MiB;
constexpr size_t WS_ROUTE = 1 * MiB;
constexpr size_t WS_SLOTS = WS_ROUTE + 512 * 1024, WS_WGCNT = WS_ROUTE + 768 * 1024;
constexpr size_t WS_WL = 4 * MiB, WL_STRIDE = 14 * MiB;
constexpr size_t WL_WIN = 0, WL_WV = 9 * MiB, WL_WA = 10 * MiB, WL_WB = 11 * MiB, WL_WO = 12 * MiB;
constexpr size_t WS_WGU = 32 * MiB, WS_WD = 43 * MiB;
constexpr size_t WS_H = 50 * MiB;
constexpr size_t WS_UA = WS_H, WS_UB = WS_H + 32 * MiB;
constexpr size_t WS_VT = 114 * MiB;
constexpr size_t WS_GT = 146 * MiB;
constexpr size_t WS_PA = 274 * MiB;
constexpr size_t WS_QF = WS_PA + 96 * MiB, WS_KF = WS_PA + 128 * MiB;
constexpr size_t WS_TMP = 274 * MiB, WS_MIX = 338 * MiB;
constexpr size_t WS_G0 = 146 * MiB;
constexpr size_t WS_WEG = 440 * MiB, WS_WED = 472 * MiB;
constexpr size_t WS_HP = 52 * MiB;
constexpr size_t WS_G1 = 118 * MiB;
constexpr size_t WS_Y = 250 * MiB;
constexpr float WSCALE = 32.f, GSCALE = 8.f;
constexpr size_t WS_END = 512 * MiB;
static_assert(WS_G1 + (size_t)MPAD * DFFE <= WS_Y && WS_HP + (size_t)MPAD * D <= WS_G1 && WS_Y + (size_t)MPAD * D * 2 <= WS_END && WS_KF + 32 * MiB <= WS_END, "d_ws map");
constexpr int CW_TMO = 0, CW_CODE = 1, CW_BAR = 4096, CW_CNT = 8192;

constexpr int RING_OFF = 0, RING_BYTES = 131072, LDSCTL_OFF = RING_BYTES, MISC_OFF = LDSCTL_OFF + 320, XS_OFF = RING_BYTES + 1024, LDS_BYTES = XS_OFF + 8 * pg8::XS_WAVE_BYTES;

typedef unsigned u32x2v __attribute__((ext_vector_type(2)));
__device__ __forceinline__ float wave_sum(float v) {
#pragma unroll
    for (int o = 1; o < 64; o <<= 1) v += __shfl_xor(v, o);
    return v;
}
using pg8::cvt_pk_bf16;
__device__ __forceinline__ void tr_block(const float* W, int K, int N, bf16* dst, int drow, int k0, int n0, LAS float* scr, int lane) {
    { f32x4 t[8];
#pragma unroll
      for (int i = 0; i < 8; ++i) t[i] = *(const GAS f32x4*)(W + (size_t)(k0 + 8 * i + (lane >> 3)) * N + n0 + 4 * (lane & 7));
#pragma unroll
      for (int i = 0; i < 8; ++i) { LAS float* p = scr + (8 * i + (lane >> 3)) * 33 + 4 * (lane & 7); p[0] = t[i].x; p[1] = t[i].y; p[2] = t[i].z; p[3] = t[i].w; } }
    LDS_WAIT(); asm volatile("" ::: "memory");
    const int c = lane & 7;
#pragma unroll
    for (int j = 0; j < 4; ++j) { const int n = (lane >> 3) + 8 * j; const LAS float* s = scr + (8 * c) * 33 + n;
        v4u o; o.x = cvt_pk_bf16(s[0 * 33], s[1 * 33]); o.y = cvt_pk_bf16(s[2 * 33], s[3 * 33]); o.z = cvt_pk_bf16(s[4 * 33], s[5 * 33]); o.w = cvt_pk_bf16(s[6 * 33], s[7 * 33]);
        *(GAS v4u*)(dst + (size_t)(drow + n) * K + k0 + 8 * c) = o; }
    LDS_WAIT(); asm volatile("" ::: "memory");
}
__device__ __forceinline__ void tr_block8(const float* W, int K, int N, unsigned char* dst, int drow, int k0, int n0, float sc, LAS float* scr, int lane) {
    { f32x4 t[8];
#pragma unroll
      for (int i = 0; i < 8; ++i) t[i] = *(const GAS f32x4*)(W + (size_t)(k0 + 8 * i + (lane >> 3)) * N + n0 + 4 * (lane & 7));
#pragma unroll
      for (int i = 0; i < 8; ++i) { LAS float* p = scr + (8 * i + (lane >> 3)) * 33 + 4 * (lane & 7); p[0] = t[i].x; p[1] = t[i].y; p[2] = t[i].z; p[3] = t[i].w; } }
    LDS_WAIT(); asm volatile("" ::: "memory");
    const int c = lane & 7;
#pragma unroll
    for (int j = 0; j < 4; ++j) { const int n = (lane >> 3) + 8 * j; const LAS float* s = scr + (8 * c) * 33 + n;
        u32x2v o; o.x = pg8::pk4_fp8(s[0 * 33] * sc, s[1 * 33] * sc, s[2 * 33] * sc, s[3 * 33] * sc); o.y = pg8::pk4_fp8(s[4 * 33] * sc, s[5 * 33] * sc, s[6 * 33] * sc, s[7 * 33] * sc);
        *(GAS u32x2v*)(dst + (size_t)(drow + n) * K + k0 + 8 * c) = o; }
    LDS_WAIT(); asm volatile("" ::: "memory");
}
template <int KIND> __device__ __forceinline__ void tr_item8(const float* W, int K, int N, unsigned char* dst, float sc, LAS float* scr, int item, int lane) {
    const int nblk = N / 32, kb = item / nblk, nb = item % nblk, k0 = 64 * kb, n0 = 32 * nb;
    int drow = n0;
    if (KIND == 2) drow = 256 * (n0 / 128) + 2 * (n0 % 128);
    if (KIND == 3) drow = 256 * (n0 / 128) + 2 * (n0 % 128) + 32;
    tr_block8(W, K, N, dst, drow, k0, n0, sc, scr, lane);
}
template <int KIND> __device__ __forceinline__ void tr_item(const float* W, int K, int N, bf16* dst, bf16* dst2, LAS float* scr, int item, int lane) {
    const int nblk = N / 32, kb = item / nblk, nb = item % nblk, k0 = 64 * kb, n0 = 32 * nb;
    bf16* d = dst; int drow = n0;
    if (KIND == 1) { if (n0 >= 3072) drow = n0 - 512; else if (n0 >= 2560) { d = dst2; drow = n0 - 2560; } }
    if (KIND == 2) drow = 256 * (n0 / 128) + 2 * (n0 % 128);
    if (KIND == 3) drow = 256 * (n0 / 128) + 2 * (n0 % 128) + 32;
    tr_block(W, K, N, d, drow, k0, n0, scr, lane);
}
__device__ __forceinline__ void rms_row_to_bf16(const float* xrow, const float* g, bf16* orow, int lane) {
    const GAS f32x4* xr = (const GAS f32x4*)xrow + lane; const GAS f32x4* gr = (const GAS f32x4*)g + lane;
    f32x4 v[4]; float s = 0.f;
#pragma unroll
    for (int j = 0; j < 4; ++j) { v[j] = xr[64 * j]; s += (v[j].x * v[j].x + v[j].y * v[j].y) + (v[j].z * v[j].z + v[j].w * v[j].w); }
    const float rstd = 1.0f / sqrtf(wave_sum(s) * (1.f / D) + EPS);
    GAS u32x2v* o8 = (GAS u32x2v*)orow + lane;
#pragma unroll
    for (int j = 0; j < 4; ++j) { const f32x4 gg = gr[64 * j]; u32x2v w; w.x = cvt_pk_bf16(v[j].x * rstd * gg.x, v[j].y * rstd * gg.y); w.y = cvt_pk_bf16(v[j].z * rstd * gg.z, v[j].w * rstd * gg.w); o8[64 * j] = w; }
}
__device__ __forceinline__ void rms_row_to_fp8(const float* xrow, const float* g, unsigned char* orow, int lane) {
    const GAS f32x4* xr = (const GAS f32x4*)xrow + lane; const GAS f32x4* gr = (const GAS f32x4*)g + lane;
    f32x4 v[4]; float s = 0.f;
#pragma unroll
    for (int j = 0; j < 4; ++j) { v[j] = xr[64 * j]; s += (v[j].x * v[j].x + v[j].y * v[j].y) + (v[j].z * v[j].z + v[j].w * v[j].w); }
    const float rstd = 1.0f / sqrtf(wave_sum(s) * (1.f / D) + EPS);
    GAS unsigned* o4 = (GAS unsigned*)orow + lane;
#pragma unroll
    for (int j = 0; j < 4; ++j) { const f32x4 gg = gr[64 * j]; o4[64 * j] = pg8::pk4_fp8(v[j].x * rstd * gg.x, v[j].y * rstd * gg.y, v[j].z * rstd * gg.z, v[j].w * rstd * gg.w); }
}
__device__ __forceinline__ void unpack8f(const v4u w, float (&f)[8]) {
    f[0] = __builtin_bit_cast(float, w.x << 16); f[1] = __builtin_bit_cast(float, w.x & 0xffff0000u); f[2] = __builtin_bit_cast(float, w.y << 16); f[3] = __builtin_bit_cast(float, w.y & 0xffff0000u);
    f[4] = __builtin_bit_cast(float, w.z << 16); f[5] = __builtin_bit_cast(float, w.z & 0xffff0000u); f[6] = __builtin_bit_cast(float, w.w << 16); f[7] = __builtin_bit_cast(float, w.w & 0xffff0000u);
}
__device__ __forceinline__ v4u pack8f(const float (&f)[8]) { v4u w; w.x = cvt_pk_bf16(f[0], f[1]); w.y = cvt_pk_bf16(f[2], f[3]); w.z = cvt_pk_bf16(f[4], f[5]); w.w = cvt_pk_bf16(f[6], f[7]); return w; }

__device__ __forceinline__ void conv_phase(const bf16* PA, const float* cw, bf16* UA, int gid, int nthr) {
    for (int it = gid; it < (T / 16) * 64; it += nthr) {
        const int cg = it & 63, t0 = (it >> 6) * 16, c0 = cg * 8;
        float w0[8], w1[8], w2[8];
#pragma unroll
        for (int i = 0; i < 8; ++i) { w0[i] = cw[c0 + i]; w1[i] = cw[DCONV + c0 + i]; w2[i] = cw[2 * DCONV + c0 + i]; }
        float um2[8], um1[8];
        if ((t0 & (SEQ - 1)) == 0) {
#pragma unroll
            for (int i = 0; i < 8; ++i) { um2[i] = 0.f; um1[i] = 0.f; }
        } else {
            float a[8], b[8];
            unpack8f(*(const GAS v4u*)(PA + (size_t)(t0 - 2) * NPA + c0), a); unpack8f(*(const GAS v4u*)(PA + (size_t)(t0 - 2) * NPA + 1024 + c0), b);
#pragma unroll
            for (int i = 0; i < 8; ++i) um2[i] = a[i] * b[i];
            unpack8f(*(const GAS v4u*)(PA + (size_t)(t0 - 1) * NPA + c0), a); unpack8f(*(const GAS v4u*)(PA + (size_t)(t0 - 1) * NPA + 1024 + c0), b);
#pragma unroll
            for (int i = 0; i < 8; ++i) um1[i] = a[i] * b[i];
        }
#pragma unroll 4
        for (int r = 0; r < 16; ++r) {
            const bf16* row = PA + (size_t)(t0 + r) * NPA + c0;
            float xin[8], bg[8], cgv[8], o[8];
            unpack8f(*(const GAS v4u*)(row), xin); unpack8f(*(const GAS v4u*)(row + 512), bg); unpack8f(*(const GAS v4u*)(row + 1024), cgv);
#pragma unroll
            for (int i = 0; i < 8; ++i) { const float u = cgv[i] * xin[i]; o[i] = bg[i] * (w0[i] * um2[i] + w1[i] * um1[i] + w2[i] * u); um2[i] = um1[i]; um1[i] = u; }
            *(GAS v4u*)(UA + (size_t)(t0 + r) * DCONV + c0) = pack8f(o);
        }
    }
}

typedef float f32x16 __attribute__((ext_vector_type(16)));
__device__ __forceinline__ void attn_mfma(const bf16* QF, const bf16* KF, const bf16* VF, bf16* UB, int gw, int NGW, int lane) {
    const int q = lane & 31, hh = lane >> 5;
    constexpr int NU = BATCH * NHEAD * (SEQ / 32);
    bf16x8 qf[4];
    if (gw < NU) {
        const size_t o = (size_t)gw * 2048 + lane * 8;
#pragma unroll
        for (int i = 0; i < 4; ++i) qf[i] = *(const GAS bf16x8*)(QF + o + i * 512);
    }
#pragma unroll 1
    for (int u = gw; u < NU; u += NGW) {
        const int qb = u & 127, bh = u >> 7, h = bh & 7, b = bh >> 3;
        const size_t rowb = (size_t)b * SEQ;
        const bf16* const kbase = KF + (size_t)(bh * 128) * 2048 + lane * 8;
        const bf16* const vbase = VF + (size_t)(bh * 128) * 2048 + lane * 8;
        bf16x8 k0[4], v0[4], k1[4], v1[4], k2[4], v2[4];
        auto fill = [&](bf16x8 (&KB)[4], bf16x8 (&VB)[4], int kbn) __attribute__((always_inline)) {
            kbn = kbn > 0 ? kbn : 0;
            const bf16* kp = kbase + (size_t)kbn * 2048; const bf16* vp = vbase + (size_t)kbn * 2048;
#pragma unroll
            for (int i = 0; i < 4; ++i) { KB[i] = *(const GAS bf16x8*)(kp + i * 512); VB[i] = *(const GAS bf16x8*)(vp + i * 512); }
        };
        fill(k0, v0, qb); fill(k1, v1, qb - 1); fill(k2, v2, qb - 2);
        bf16x8 qN[4];
        {
            const int un = (u + NGW < NU) ? u + NGW : u; const size_t o = (size_t)un * 2048 + lane * 8;
#pragma unroll
            for (int i = 0; i < 4; ++i) qN[i] = *(const GAS bf16x8*)(QF + o + i * 512);
        }
        __builtin_amdgcn_sched_barrier(0);
        f32x16 o0, o1;
#pragma unroll
        for (int r = 0; r < 16; ++r) { o0[r] = 0.f; o1[r] = 0.f; }
        float R = 1.f;
        const bf16x8 (&qfr)[4] = qf;
        auto block = [&](bf16x8 (&KB)[4], bf16x8 (&VB)[4], const int kb) __attribute__((always_inline)) -> bool {
            f32x16 p;
#pragma unroll
            for (int r = 0; r < 16; ++r) p[r] = 0.f;
#pragma unroll
            for (int d0 = 0; d0 < 4; ++d0) p = __builtin_amdgcn_mfma_f32_32x32x16_bf16(KB[d0], qfr[d0], p, 0, 0, 0);
            float rr[16];
            const bool diag = (kb == qb);
#pragma unroll
            for (int r = 0; r < 16; ++r) {
                float e = __builtin_amdgcn_exp2f(p[r]);
                if (diag) { const int kl = (r & 7) + 8 * hh + 16 * (r >> 3); e = (kl < q) ? e : 0.f; }
                rr[r] = __builtin_amdgcn_rcpf(1.0f + e);
            }
            bf16x8 af[2];
#pragma unroll
            for (int s = 1; s >= 0; --s) {
                float g = rr[8 * s];
#pragma unroll
                for (int j = 1; j < 8; ++j) g *= rr[8 * s + j];
                const auto sw = __builtin_amdgcn_permlane32_swap(__float_as_uint(g), __float_as_uint(g), false, false);
                const float g_lo = __uint_as_float(sw[0]), g_hi = __uint_as_float(sw[1]);
                float c = hh ? R : R * g_hi;
                float a[8];
#pragma unroll
                for (int j = 7; j >= 0; --j) { const float cn = c * rr[8 * s + j]; a[j] = c - cn; c = cn; }
                R = R * (g_lo * g_hi);
                typedef unsigned u4 __attribute__((ext_vector_type(4)));
                u4 w; w.x = cvt_pk_bf16(a[0], a[1]); w.y = cvt_pk_bf16(a[2], a[3]); w.z = cvt_pk_bf16(a[4], a[5]); w.w = cvt_pk_bf16(a[6], a[7]);
                af[s] = __builtin_bit_cast(bf16x8, w);
            }
            o0 = __builtin_amdgcn_mfma_f32_32x32x16_bf16(VB[0], af[0], o0, 0, 0, 0);
            o0 = __builtin_amdgcn_mfma_f32_32x32x16_bf16(VB[1], af[1], o0, 0, 0, 0);
            o1 = __builtin_amdgcn_mfma_f32_32x32x16_bf16(VB[2], af[0], o1, 0, 0, 0);
            o1 = __builtin_amdgcn_mfma_f32_32x32x16_bf16(VB[3], af[1], o1, 0, 0, 0);
            if (kb == 0 || __builtin_amdgcn_ballot_w64(R != 0.f) == 0ull) return true;
            fill(KB, VB, kb - 3);
            __builtin_amdgcn_sched_barrier(0);
            return false;
        };
#pragma unroll 1
        for (int kb = qb;; kb -= 3) {
            if (block(k0, v0, kb)) break;
            if (block(k1, v1, kb - 1)) break;
            if (block(k2, v2, kb - 2)) break;
        }
        bf16* op = UB + (rowb + 32 * qb + q) * DATTN + h * 64 + 4 * hh;
#pragma unroll
        for (int g4 = 0; g4 < 4; ++g4) {
            u32x2v w0, w1;
            w0.x = cvt_pk_bf16(o0[4 * g4], o0[4 * g4 + 1]); w0.y = cvt_pk_bf16(o0[4 * g4 + 2], o0[4 * g4 + 3]);
            w1.x = cvt_pk_bf16(o1[4 * g4], o1[4 * g4 + 1]); w1.y = cvt_pk_bf16(o1[4 * g4 + 2], o1[4 * g4 + 3]);
            *(GAS u32x2v*)(op + 8 * g4) = w0; *(GAS u32x2v*)(op + 32 + 8 * g4) = w1;
        }
#pragma unroll
        for (int i = 0; i < 4; ++i) qf[i] = qN[i];
    }
}

#ifndef FFN8
#define FFN8 0
#endif
#ifndef REP_P0
#define REP_P0 1
#endif
#ifndef REP_P1
#define REP_P1 1
#endif
#ifndef REP_P2
#define REP_P2 1
#endif
#ifndef REP_ATT
#define REP_ATT 1
#endif
#ifndef REP_R1A
#define REP_R1A 1
#endif
struct Args { const float* in[16]; float* out; unsigned char* ws; };
typedef const __attribute__((address_space(4))) Args* KArgP;
__device__ __forceinline__ KArgP launder_k(KArgP p) { asm volatile("" : "+s"(p)); return p; }
__device__ __forceinline__ int launder_s(int v) { asm volatile("" : "+s"(v)); return v; }
__device__ __forceinline__ int launder_v(int v) { asm volatile("" : "+v"(v)); return v; }
#ifndef STG_TICKS
#define STG_TICKS 150
#endif
__device__ __forceinline__ void stagger(int bx) { const unsigned long long t0 = __builtin_amdgcn_s_memrealtime(); const unsigned long long want = (unsigned long long)(((bx >> 3) & 3) * STG_TICKS); while (__builtin_amdgcn_s_memrealtime() - t0 < want) __builtin_amdgcn_s_sleep(2); }
#ifndef STG_ON
#define STG_ON 0
#endif
#define STG(b_) do { if (STG_ON) stagger(b_); } while (0)
#define PH_BEGIN { const KArgP ap = launder_k(kp0); unsigned char* const ws = ap->ws; const int bx = launder_s(bx0), G = launder_s(G0); const int tid = launder_v(tid0), lane = tid & 63, wave = __builtin_amdgcn_readfirstlane(tid >> 6); \
    const int gid = bx * (NWAVES * 64) + tid, nthr = G * NWAVES * 64, gw = bx * NWAVES + wave, NGW = G * NWAVES; (void)gid; (void)nthr; (void)gw; (void)NGW; (void)lane; \
    LAS float* const scr = (LAS float*)(lds + RING_OFF + wave * 16384); (void)scr; (void)ws;
#define PH_END(BARRIER) if (BARRIER) { XcdBarrier bl_ = bar; asm volatile("" : "+s"(bl_.bar), "+s"(bl_.x)); xcd_barrier(bl_); } }
#define WSP(T_, off) ((T_*)(ws + (off)))

__global__ void __launch_bounds__(NWAVES * 64, 2) mega_fwd(Args args) {
    extern __shared__ __attribute__((aligned(16))) unsigned char lds_raw[];
    LAS unsigned char* const lds = (LAS unsigned char*)lds_raw;
    volatile LAS unsigned* const MISC = (volatile LAS unsigned*)(lds + MISC_OFF);
    const KArgP kp0 = (KArgP)__builtin_amdgcn_kernarg_segment_ptr();
    const int tid0 = threadIdx.x, G0 = gridDim.x, bx0 = blockIdx.x;
    for (int u = tid0; u < 1024 / 4; u += NWAVES * 64) ((LAS unsigned*)(lds + LDSCTL_OFF))[u] = 0u;
    __syncthreads();
#ifdef PROBE_CLK
    long long probe_cycles = 0;
#endif
    XcdBarrier bar = xcd_barrier_post((unsigned*)(args.ws + WS_CTL) + CW_BAR, MISC + 8);

    constexpr int I_IN = 16 * 160, I_BR = 8 * 32, I_O = 16 * 32, I_GU = 16 * 88, I_D = 44 * 32, I_E = 16 * 64;
    constexpr int PER_L = I_IN + 2 * I_BR + I_O, N_FFN = 2 * I_GU + I_D, N_EXPW = NEXP * 3 * I_E;
#define MIXER_W_ITEM(l_, r_) do { int r = (r_); unsigned char* wl = ws + WS_WL + (size_t)(l_) * WL_STRIDE; \
        if (r < I_IN) { tr_item<1>(ap->in[2] + (size_t)(l_) * D * NIN, D, NIN, (bf16*)(wl + WL_WIN), (bf16*)(wl + WL_WV), scr, r, lane); break; } r -= I_IN; \
        if (r < I_BR) { tr_item<0>(ap->in[4] + (size_t)(l_) * DCONV * D, DCONV, D, (bf16*)(wl + WL_WA), nullptr, scr, r, lane); break; } r -= I_BR; \
        if (r < I_BR) { tr_item<0>(ap->in[5] + (size_t)(l_) * DATTN * D, DATTN, D, (bf16*)(wl + WL_WB), nullptr, scr, r, lane); break; } r -= I_BR; \
        tr_item<0>(ap->in[6] + (size_t)(l_) * D * D, D, D, (bf16*)(wl + WL_WO), nullptr, scr, r, lane); } while (0)
#define FFN_W_ITEM(r_) do { int r = (r_); \
        if (r < I_GU) { tr_item<2>(ap->in[8], D, DFF, WSP(bf16, WS_WGU), nullptr, scr, r, lane); break; } r -= I_GU; \
        if (r < I_GU) { tr_item<3>(ap->in[9], D, DFF, WSP(bf16, WS_WGU), nullptr, scr, r, lane); break; } r -= I_GU; \
        tr_item<0>(ap->in[10], DFF, D, WSP(bf16, WS_WD), nullptr, scr, r, lane); } while (0)
#define EXPERT_W_ITEM(it_) do { const int e = (it_) / (3 * I_E); int r = (it_) - e * 3 * I_E; \
        if (r < I_E) { tr_item8<2>(ap->in[12] + (size_t)e * D * DFFE, D, DFFE, WSP(unsigned char, WS_WEG) + (size_t)e * 2 * DFFE * D, WSCALE, scr, r, lane); break; } r -= I_E; \
        if (r < I_E) { tr_item8<3>(ap->in[13] + (size_t)e * D * DFFE, D, DFFE, WSP(unsigned char, WS_WEG) + (size_t)e * 2 * DFFE * D, WSCALE, scr, r, lane); break; } r -= I_E; \
        tr_item8<0>(ap->in[14] + (size_t)e * DFFE * D, DFFE, D, WSP(unsigned char, WS_WED) + (size_t)e * D * DFFE, WSCALE, scr, r, lane); } while (0)

    PH_BEGIN
#pragma unroll 1
        for (int it = gw; it < PER_L; it += NGW) MIXER_W_ITEM(0, it);
#pragma unroll 1
        for (int m = gw; m < T; m += NGW) rms_row_to_bf16(ap->in[0] + (size_t)m * D, ap->in[1], WSP(bf16, WS_H) + (size_t)m * D, lane);
    PH_END(true)

#pragma unroll 1
    for (int l = 0; l < DEPTH; ++l) {
#pragma unroll 1
        for (int rep = 2 - REP_P1; rep < 2; ++rep) {
        PH_BEGIN
            unsigned char* wl = ws + WS_WL + (size_t)l * WL_STRIDE;
            pg8::Gemm g{WSP(bf16, WS_H), (const bf16*)(wl + WL_WIN), T, NPROJ, D}; pg8::StaticOrder S; S.init(T, NPROJ, G, bx);
#ifdef PROBE_NULL
            if (rep == 0) { pg8::EpiNull E0; STG(bx); pg8::gemm_phase<pg8::EpiNull, pg8::StaticOrder, true, true>(lds + RING_OFF, g, S, E0, tid); } else
#endif
#ifdef PROBE_L2
            if (rep == 0) { pg8::EpiL2 E0{WSP(bf16, 440 * MiB), bx}; STG(bx); pg8::gemm_phase<pg8::EpiL2, pg8::StaticOrder, true, true>(lds + RING_OFF, g, S, E0, tid); } else
#endif
            {
#ifdef PROBE_CLK
            long long c0_ = clock64();
#endif
            pg8::EpiProj E{WSP(bf16, WS_PA), WSP(bf16, WS_QF), WSP(bf16, WS_KF), WSP(bf16, WS_GT), QSCALE, lds + XS_OFF};
            STG(bx); pg8::gemm_phase<pg8::EpiProj, pg8::StaticOrder, true, true>(lds + RING_OFF, g, S, E, tid);
#ifdef PROBE_CLK
            if (l == 0) probe_cycles = clock64() - c0_;
#endif
            }
        PH_END(false)
        PH_BEGIN
            unsigned char* wl = ws + WS_WL + (size_t)l * WL_STRIDE;
            pg8::Gemm g{(const bf16*)(wl + WL_WV), WSP(bf16, WS_H), DATTN, T, D}; pg8::StaticOrder S; S.init(DATTN, T, G, bx);
            if (rep == 1) { pg8::EpiVT E{WSP(bf16, WS_VT)};
            STG(bx); pg8::gemm_phase<pg8::EpiVT, pg8::StaticOrder, true, true>(lds + RING_OFF, g, S, E, tid); }
        PH_END(true)
        }
        PH_BEGIN
            conv_phase(WSP(bf16, WS_PA), ap->in[3] + (size_t)l * 3 * DCONV, WSP(bf16, WS_UA), gid, nthr);
        PH_END(false)
        PH_BEGIN
            if (wave < 4) attn_mfma(WSP(bf16, WS_QF), WSP(bf16, WS_KF), WSP(bf16, WS_VT), WSP(bf16, WS_UB), gw, NGW, lane);
        PH_END(false)
        PH_BEGIN
            if (l == 0) {
#pragma unroll 1
                for (int it = gw; it < PER_L + N_FFN; it += NGW) { if (it < PER_L) MIXER_W_ITEM(1, it); else FFN_W_ITEM(it - PER_L); }
            } else {
#pragma unroll 1
                for (int it = gw; it < N_EXPW; it += NGW) EXPERT_W_ITEM(it);
            }
        PH_END(false)
        PH_BEGIN
            if (wave >= 4) attn_mfma(WSP(bf16, WS_QF), WSP(bf16, WS_KF), WSP(bf16, WS_VT), WSP(bf16, WS_UB), gw, NGW, lane);
        PH_END(true)
        PH_BEGIN
            unsigned char* wl = ws + WS_WL + (size_t)l * WL_STRIDE;
            pg8::Gemm g{WSP(bf16, WS_UA), (const bf16*)(wl + WL_WA), T, D, DCONV}; pg8::StaticOrder S; S.init(T, D, G, bx);
            pg8::EpiGateA E{WSP(bf16, WS_GT), WSP(bf16, WS_TMP), lds + XS_OFF};
            STG(bx); pg8::gemm_phase<pg8::EpiGateA, pg8::StaticOrder, true, true>(lds + RING_OFF, g, S, E, tid);
        PH_END(false)
        PH_BEGIN
            unsigned char* wl = ws + WS_WL + (size_t)l * WL_STRIDE;
            pg8::Gemm g{WSP(bf16, WS_UB), (const bf16*)(wl + WL_WB), T, D, DATTN}; pg8::StaticOrder S; S.init(T, D, G, bx);
            pg8::EpiGateB E{WSP(bf16, WS_GT), WSP(bf16, WS_TMP), WSP(bf16, WS_MIX), lds + XS_OFF};
            STG(bx); pg8::gemm_phase<pg8::EpiGateB, pg8::StaticOrder, true, true>(lds + RING_OFF, g, S, E, tid);
        PH_END(true)
        PH_BEGIN
            unsigned char* wl = ws + WS_WL + (size_t)l * WL_STRIDE;
            pg8::Gemm g{WSP(bf16, WS_MIX), (const bf16*)(wl + WL_WO), T, D, D}; pg8::StaticOrder S; S.init(T, D, G, bx);
            pg8::EpiRes E{l == 0 ? ap->in[0] : (const float*)ap->out, ap->out, D, 1.f, lds + XS_OFF};
            STG(bx); pg8::gemm_phase<pg8::EpiRes, pg8::StaticOrder, true, true>(lds + RING_OFF, g, S, E, tid);
        PH_END(true)
        if (l == 0) {
            PH_BEGIN
#pragma unroll 1
#if FFN8
                for (int m = gw; m < T; m += NGW) rms_row_to_fp8(ap->out + (size_t)m * D, ap->in[7], WSP(unsigned char, WS_H) + (size_t)m * D, lane);
#else
                for (int m = gw; m < T; m += NGW) rms_row_to_bf16(ap->out + (size_t)m * D, ap->in[7], WSP(bf16, WS_H) + (size_t)m * D, lane);
#endif
            PH_END(true)
            PH_BEGIN
#if FFN8
                pg8::Gemm g{WSP(bf16, WS_H), WSP(bf16, WS_WGU), T, 2 * DFF, D / 2}; pg8::StaticOrder S; S.init(T, 2 * DFF, G, bx);
                pg8::EpiSwiGLU8 E{WSP(unsigned char, WS_G0), DFF, 1.0f / WSCALE, GSCALE, lds + XS_OFF};
                STG(bx); pg8::gemm_phase<pg8::EpiSwiGLU8, pg8::StaticOrder, true, true, true>(lds + RING_OFF, g, S, E, tid);
#else
                pg8::Gemm g{WSP(bf16, WS_H), WSP(bf16, WS_WGU), T, 2 * DFF, D}; pg8::StaticOrder S; S.init(T, 2 * DFF, G, bx);
                pg8::EpiSwiGLU E{WSP(bf16, WS_G0), DFF, lds + XS_OFF};
                STG(bx); pg8::gemm_phase<pg8::EpiSwiGLU, pg8::StaticOrder, true, true>(lds + RING_OFF, g, S, E, tid);
#endif
            PH_END(true)
            PH_BEGIN
#if FFN8
                pg8::Gemm g{WSP(bf16, WS_G0), WSP(bf16, WS_WD), T, D, DFF / 2}; pg8::StaticOrder S; S.init(T, D, G, bx);
                pg8::EpiRes E{ap->out, ap->out, D, 1.0f / (WSCALE * GSCALE), lds + XS_OFF};
                STG(bx); pg8::gemm_phase<pg8::EpiRes, pg8::StaticOrder, true, true, true>(lds + RING_OFF, g, S, E, tid);
#else
                pg8::Gemm g{WSP(bf16, WS_G0), WSP(bf16, WS_WD), T, D, DFF}; pg8::StaticOrder S; S.init(T, D, G, bx);
                pg8::EpiRes E{ap->out, ap->out, D, 1.f, lds + XS_OFF};
                STG(bx); pg8::gemm_phase<pg8::EpiRes, pg8::StaticOrder, true, true>(lds + RING_OFF, g, S, E, tid);
#endif
            PH_END(true)
            PH_BEGIN
#pragma unroll 1
                for (int m = gw; m < T; m += NGW) rms_row_to_bf16(ap->out + (size_t)m * D, ap->in[1] + D, WSP(bf16, WS_H) + (size_t)m * D, lane);
            PH_END(true)
        } else {
            volatile LAS int* const lcnt = (volatile LAS int*)(MISC + 32);
            volatile LAS unsigned* const loff = MISC + 16;
            volatile LAS int* const lbase = (volatile LAS int*)(MISC + 48);
            PH_BEGIN
                int4* route = WSP(int4, WS_ROUTE); int* wgcnt = WSP(int, WS_WGCNT); gu32* ctl = (gu32*)(ws + WS_CTL);
                const int rpw = T / G, r0 = bx * rpw, r1 = r0 + rpw;
                const float* xres = ap->out; const float* gf = ap->in[7] + D; const float* w_router = ap->in[11];
                if (tid < 8) lcnt[tid] = 0;
                __syncthreads();
#pragma unroll 1
                for (int m = r0 + wave; m < r1; m += NWAVES) {
                    const GAS f32x4* xr = (const GAS f32x4*)(xres + (size_t)m * D) + lane; const GAS f32x4* gr = (const GAS f32x4*)gf + lane;
                    f32x4 v[4]; float s = 0.f;
#pragma unroll
                    for (int j = 0; j < 4; ++j) { v[j] = xr[64 * j]; s += (v[j].x * v[j].x + v[j].y * v[j].y) + (v[j].z * v[j].z + v[j].w * v[j].w); }
                    const float rstd = 1.0f / sqrtf(wave_sum(s) * (1.f / D) + EPS);
                    float lg[8];
#pragma unroll
                    for (int e = 0; e < 8; ++e) lg[e] = 0.f;
#pragma unroll
                    for (int j = 0; j < 4; ++j) { const f32x4 gg = gr[64 * j];
#pragma unroll
                        for (int c = 0; c < 4; ++c) { const float hn = v[j][c] * rstd * gg[c]; const int i = 256 * j + 4 * lane + c;
                            const f32x4 wa = *(const GAS f32x4*)(w_router + (size_t)i * 8), wb = *(const GAS f32x4*)(w_router + (size_t)i * 8 + 4);
                            lg[0] += hn * wa.x; lg[1] += hn * wa.y; lg[2] += hn * wa.z; lg[3] += hn * wa.w; lg[4] += hn * wb.x; lg[5] += hn * wb.y; lg[6] += hn * wb.z; lg[7] += hn * wb.w; } }
#pragma unroll
                    for (int e = 0; e < 8; ++e) lg[e] = wave_sum(lg[e]);
                    int e1 = 0; float v1 = lg[0];
#pragma unroll
                    for (int e = 1; e < 8; ++e) if (lg[e] > v1) { v1 = lg[e]; e1 = e; }
                    int e2 = -1; float v2 = -INFINITY;
#pragma unroll
                    for (int e = 0; e < 8; ++e) if (e != e1 && lg[e] > v2) { v2 = lg[e]; e2 = e; }
                    if (e2 < 0) e2 = (e1 + 1) & 7;
                    const float ex = __expf(v2 - v1), w1 = 1.0f / (1.0f + ex), w2 = ex * w1;
                    if (lane == 0) { route[m] = make_int4(e1, e2, __float_as_int(w1), __float_as_int(w2)); atomicAdd((int*)(lcnt + e1), 1); atomicAdd((int*)(lcnt + e2), 1); }
                }
                __syncthreads();
                if (tid < 8) { const int c = lcnt[tid]; wgcnt[bx * 8 + tid] = c; __hip_atomic_fetch_add((unsigned*)(ctl + CW_CNT + tid), (unsigned)c, RLX_AGENT); }
            PH_END(true)
            PH_BEGIN
                int4* route = WSP(int4, WS_ROUTE); int2* slots = WSP(int2, WS_SLOTS); int* wgcnt = WSP(int, WS_WGCNT); gu32* ctl = (gu32*)(ws + WS_CTL); unsigned char* HP = WSP(unsigned char, WS_HP);
                const int rpw = T / G, r0 = bx * rpw, r1 = r0 + rpw;
                const float* xres = ap->out; const float* gf = ap->in[7] + D;
                { int s = 0; for (int w = lane; w < bx; w += 64) s += wgcnt[w * 8 + wave]; s = (int)wave_sum((float)s);
                  if (lane == 0) { lbase[wave] = s; lcnt[wave] = 0; } }
                if (tid == 0) { unsigned off = 0; for (int e = 0; e < 8; ++e) { loff[e] = off; off += (__hip_atomic_load((unsigned*)(ctl + CW_CNT + e), RLX_AGENT) + 255u) & ~255u; } loff[8] = off; }
                __syncthreads();
#pragma unroll 1
                for (int m = r0 + wave; m < r1; m += NWAVES) {
                    int s1 = 0, s2 = 0;
                    if (lane == 0) { const int4 rt = route[m]; s1 = (int)loff[rt.x] + lbase[rt.x] + atomicAdd((int*)(lcnt + rt.x), 1); s2 = (int)loff[rt.y] + lbase[rt.y] + atomicAdd((int*)(lcnt + rt.y), 1); slots[m] = make_int2(s1, s2); }
                    s1 = __builtin_amdgcn_readfirstlane(s1); s2 = __builtin_amdgcn_readfirstlane(s2);
                    const GAS f32x4* xr = (const GAS f32x4*)(xres + (size_t)m * D) + lane; const GAS f32x4* gr = (const GAS f32x4*)gf + lane;
                    f32x4 v[4]; float s = 0.f;
#pragma unroll
                    for (int j = 0; j < 4; ++j) { v[j] = xr[64 * j]; s += (v[j].x * v[j].x + v[j].y * v[j].y) + (v[j].z * v[j].z + v[j].w * v[j].w); }
                    const float rstd = 1.0f / sqrtf(wave_sum(s) * (1.f / D) + EPS);
                    GAS unsigned* o1 = (GAS unsigned*)(HP + (size_t)s1 * D) + lane; GAS unsigned* o2 = (GAS unsigned*)(HP + (size_t)s2 * D) + lane;
#pragma unroll
                    for (int j = 0; j < 4; ++j) { const f32x4 gg = gr[64 * j]; const unsigned w = pg8::pk4_fp8(v[j].x * rstd * gg.x, v[j].y * rstd * gg.y, v[j].z * rstd * gg.z, v[j].w * rstd * gg.w); o1[64 * j] = w; o2[64 * j] = w; }
                }
            PH_END(true)
            PH_BEGIN
                const int mrows = (int)loff[8];
                pg8::Gemm g{WSP(bf16, WS_HP), WSP(bf16, WS_WEG), mrows, 2 * DFFE, D / 2}; pg8::MoeOrder S; S.init(mrows, 2 * DFFE, G, bx); S.offs = loff; S.ntn = 2 * DFFE / 256;
                pg8::EpiSwiGLU8 E{WSP(unsigned char, WS_G1), DFFE, 1.0f / WSCALE, GSCALE, lds + XS_OFF};
                STG(bx); pg8::gemm_phase<pg8::EpiSwiGLU8, pg8::MoeOrder, true, true, true>(lds + RING_OFF, g, S, E, tid);
            PH_END(true)
            PH_BEGIN
                const int mrows = (int)loff[8];
                pg8::Gemm g{WSP(bf16, WS_G1), WSP(bf16, WS_WED), mrows, D, DFFE / 2}; pg8::MoeOrder S; S.init(mrows, D, G, bx); S.offs = loff; S.ntn = D / 256;
                pg8::EpiPlainS E{WSP(bf16, WS_Y), D, 1.0f / (WSCALE * GSCALE), lds + XS_OFF};
                STG(bx); pg8::gemm_phase<pg8::EpiPlainS, pg8::MoeOrder, true, true, true>(lds + RING_OFF, g, S, E, tid);
            PH_END(true)
            PH_BEGIN
                const int4* route = WSP(int4, WS_ROUTE); const int2* slots = WSP(int2, WS_SLOTS); const bf16* HP = WSP(bf16, WS_Y); float* xres = ap->out; const float* g_final = ap->in[15];
#pragma unroll 1
                for (int m = gw; m < T; m += NGW) {
                    const int4 rt = route[m]; const int2 sl = slots[m]; const float w1 = __int_as_float(rt.z), w2 = __int_as_float(rt.w);
                    GAS f32x4* xr = (GAS f32x4*)(xres + (size_t)m * D) + lane; const GAS f32x4* gr = (const GAS f32x4*)g_final + lane;
                    const GAS u32x2v* y1 = (const GAS u32x2v*)(HP + (size_t)sl.x * D) + lane; const GAS u32x2v* y2 = (const GAS u32x2v*)(HP + (size_t)sl.y * D) + lane;
                    f32x4 v[4]; float s = 0.f;
#pragma unroll
                    for (int j = 0; j < 4; ++j) { v[j] = xr[64 * j]; const u32x2v a = y1[64 * j], b = y2[64 * j];
                        v[j].x += w1 * __builtin_bit_cast(float, a.x << 16) + w2 * __builtin_bit_cast(float, b.x << 16);
                        v[j].y += w1 * __builtin_bit_cast(float, a.x & 0xffff0000u) + w2 * __builtin_bit_cast(float, b.x & 0xffff0000u);
                        v[j].z += w1 * __builtin_bit_cast(float, a.y << 16) + w2 * __builtin_bit_cast(float, b.y << 16);
                        v[j].w += w1 * __builtin_bit_cast(float, a.y & 0xffff0000u) + w2 * __builtin_bit_cast(float, b.y & 0xffff0000u);
                        s += (v[j].x * v[j].x + v[j].y * v[j].y) + (v[j].z * v[j].z + v[j].w * v[j].w); }
                    const float rstd = 1.0f / sqrtf(wave_sum(s) * (1.f / D) + EPS);
#pragma unroll
                    for (int j = 0; j < 4; ++j) { const f32x4 gg = gr[64 * j]; xr[64 * j] = (f32x4){v[j].x * rstd * gg.x, v[j].y * rstd * gg.y, v[j].z * rstd * gg.z, v[j].w * rstd * gg.w}; }
                }
            PH_END(false)
        }
    }
#ifdef PROBE_CLK
    if (blockIdx.x == 0) { const unsigned long long t0_ = __builtin_amdgcn_s_memrealtime(); const unsigned long long want = (unsigned long long)(probe_cycles / 64); while (__builtin_amdgcn_s_memrealtime() - t0_ < want) __builtin_amdgcn_s_sleep(4); }
#endif
}

extern "C" void kernel_launch(void* const* d_in, const int* in_sizes, int n_in, void* d_out, int out_size, void* d_ws, size_t ws_size, hipStream_t stream) {
    static int grid = 0;
    if (grid == 0) {
        if (n_in != 16 || in_sizes[0] != T * D || out_size != T * D || ws_size < WS_END) { fprintf(stderr, "kernel_launch: unexpected shapes (n_in %d, in0 %d, out %d, ws %zu); nothing launched\n", n_in, n_in > 0 ? in_sizes[0] : -1, out_size, ws_size); grid = -1; return; }
        int dev = 0, cus = 0, per_cu = 0;
        if (hipGetDevice(&dev) != hipSuccess || hipDeviceGetAttribute(&cus, hipDeviceAttributeMultiprocessorCount, dev) != hipSuccess) { grid = -1; return; }
        if (hipFuncSetAttribute((const void*)mega_fwd, hipFuncAttributeMaxDynamicSharedMemorySize, LDS_BYTES) != hipSuccess) { fprintf(stderr, "kernel_launch: hipFuncSetAttribute failed\n"); grid = -1; return; }
        if (hipOccupancyMaxActiveBlocksPerMultiprocessor(&per_cu, (const void*)mega_fwd, NWAVES * 64, LDS_BYTES) != hipSuccess || per_cu < 1) { fprintf(stderr, "kernel_launch: occupancy query reports %d workgroups per CU\n", per_cu); }
        (void)hipGetLastError();
        grid = cus;
        while (grid > 1 && (T % grid) != 0) --grid;
    }
    if (grid < 0) return;
    if (hipMemsetAsync((char*)d_ws + WS_CTL, 0, CTL_ZERO_BYTES, stream) != hipSuccess) return;
    Args a{};
    for (int i = 0; i < 16; ++i) a.in[i] = (const float*)d_in[i];
    a.out = (float*)d_out; a.ws = (unsigned char*)d_ws;
    hipLaunchKernelGGL(mega_fwd, dim3(grid), dim3(NWAVES * 64), LDS_BYTES, stream, a);
}
```
